# Optimizing an MI355X kernel written in HIP

```python
import jax
import jax.numpy as jnp
from jax import lax
import numpy as np

D_MODEL = 1024
BATCH = 4
SEQ = 8192
DEPTH = 4

GRID_W = 64
CTX_LEN = 256

MLA_HEADS = 4
MLA_NOPE = 128
MLA_ROPE = 64
MLA_V = 128
MLA_Q_LORA = 384
MLA_KV_LORA = 256
MLA_QK = MLA_NOPE + MLA_ROPE
MLA_SCALE = MLA_QK ** -0.5
ROPE_BASE = 10000.0
ROPE_AXIS_FREQS = MLA_ROPE // 4
Q_BLOCK = 128

SG_GROUPS = 4
SG_WIDTH = 256
SG_CHUNK = 128

RET_HEADS = 4
RET_QK = 32
RET_V = 64
RET_CHUNK = 128
RET_ROPE_BASE = 10000.0

N_EXPERTS = 32
TOP_K = 4
D_EXPERT = 1024
SWIGLU_LIMIT = 7.0
SWIGLU_ALPHA = 1.702
MOE_BLOCK = 256

MLA_OUT = MLA_HEADS * MLA_V
RET_OUT = RET_HEADS * RET_V
MIX_WIDTH = MLA_OUT + SG_WIDTH + RET_OUT
IN_SIZES = (MLA_Q_LORA, MLA_KV_LORA, MLA_ROPE, SG_WIDTH, SG_WIDTH,
            RET_HEADS * RET_QK, RET_HEADS * RET_QK, RET_OUT, RET_OUT)
IN_WIDTH = sum(IN_SIZES)
N_MOD = 6
LN_EPS = 1e-5
RMS_EPS = 1e-6
DEEPNORM_ALPHA = (2 * DEPTH) ** 0.25
DEEPNORM_BETA = (8 * DEPTH) ** -0.25

kernel_name = "hybrid_mla_sgmlp_retention_moe_dit"

F32 = jnp.float32


def _layer_norm(x, g=None, b=None):
    xf = x.astype(F32)
    xc = xf - jnp.mean(xf, axis=-1, keepdims=True)
    y = xc * lax.rsqrt(jnp.mean(xc * xc, axis=-1, keepdims=True) + LN_EPS)
    if g is not None:
        y = y * g.astype(F32) + b.astype(F32)
    return y.astype(x.dtype)


def _rms_norm(x, g):
    xf = x.astype(F32)
    y = xf * lax.rsqrt(jnp.mean(xf * xf, axis=-1, keepdims=True) + RMS_EPS) * g.astype(F32)
    return y.astype(x.dtype)


def _split_cols(a, sizes):
    out, off = [], 0
    for s in sizes:
        out.append(a[..., off:off + s])
        off += s
    return out


def _axial_tables(seq_len):
    rows = seq_len // GRID_W
    row = jnp.broadcast_to(jnp.arange(rows, dtype=F32)[:, None], (rows, GRID_W)).reshape(-1)
    col = jnp.broadcast_to(jnp.arange(GRID_W, dtype=F32)[None, :], (rows, GRID_W)).reshape(-1)
    inv = ROPE_BASE ** (-jnp.arange(ROPE_AXIS_FREQS, dtype=F32) / ROPE_AXIS_FREQS)
    ang = jnp.stack([row[:, None] * inv, col[:, None] * inv], axis=1)
    return jnp.cos(ang), jnp.sin(ang)


def _axial_rope(x, cos, sin):
    xr = x.reshape(x.shape[:-1] + (2, 2, ROPE_AXIS_FREQS)).astype(F32)
    x1, x2 = xr[..., 0, :], xr[..., 1, :]
    out = jnp.stack([x1 * cos - x2 * sin, x2 * cos + x1 * sin], axis=-2)
    return out.reshape(x.shape).astype(x.dtype)


def _ret_rope(x, pos):
    half = RET_QK // 2
    inv = 1.0 / (RET_ROPE_BASE ** jnp.linspace(0.0, 1.0, half, dtype=F32))
    ang = pos[:, None] * inv
    c, s = jnp.cos(ang)[:, None, :], jnp.sin(ang)[:, None, :]
    xf = x.astype(F32)
    x1, x2 = xf[..., :half], xf[..., half:]
    return jnp.concatenate([x1 * c - x2 * s, x2 * c + x1 * s], axis=-1).astype(x.dtype)


def _attend(q, k, v):
    s = jnp.einsum('bqhd,bkhd->bhqk', q, k).astype(F32) * MLA_SCALE
    p = jax.nn.softmax(s, axis=-1).astype(v.dtype)
    return jnp.einsum('bhqk,bkhd->bqhd', p, v)


def _mla_qkv(cq, ckv, krope, q_norm_g, kv_norm_g, w_uq, w_ukv, cos, sin, with_q):
    b, t = ckv.shape[:2]
    kv = (_rms_norm(ckv, kv_norm_g) @ w_ukv).reshape(b, t, MLA_HEADS, MLA_NOPE + MLA_V)
    k_nope, v = kv[..., :MLA_NOPE], kv[..., MLA_NOPE:]
    if cos is not None:
        krope = _axial_rope(krope, cos, sin)
    k = jnp.concatenate(
        [k_nope, jnp.broadcast_to(krope[:, :, None, :], (b, t, MLA_HEADS, MLA_ROPE))], axis=-1)
    q = None
    if with_q:
        q = (_rms_norm(cq, q_norm_g) @ w_uq).reshape(b, t, MLA_HEADS, MLA_QK)
        if cos is not None:
            q = jnp.concatenate(
                [q[..., :MLA_NOPE], _axial_rope(q[..., MLA_NOPE:], cos[:, None], sin[:, None])], axis=-1)
    return q, k, v


def mla_mixer(lat3, ctx3, q_norm_g, kv_norm_g, w_uq, w_ukv, cos, sin, with_ctx_out):
    q, k, v = _mla_qkv(*lat3, q_norm_g, kv_norm_g, w_uq, w_ukv, cos, sin, True)
    qc, kc, vc = _mla_qkv(*ctx3, q_norm_g, kv_norm_g, w_uq, w_ukv, None, None, with_ctx_out)
    k_all = jnp.concatenate([kc, k], axis=1)
    v_all = jnp.concatenate([vc, v], axis=1)
    b, s = q.shape[:2]
    nq = s // Q_BLOCK
    qb = q.reshape(b, nq, Q_BLOCK, MLA_HEADS, MLA_QK).swapaxes(0, 1)
    ob = lax.map(lambda blk: _attend(blk, k_all, v_all), qb)
    out = ob.swapaxes(0, 1).reshape(b, s, MLA_OUT)
    out_c = _attend(qc, kc, vc).reshape(b, -1, MLA_OUT) if with_ctx_out else None
    return out, out_c


def spatial_gate(u, v, norm_g, norm_b, w_s, b_s):
    b, t, _ = u.shape
    u = jax.nn.gelu(u, approximate=False)
    v = _layer_norm(jax.nn.gelu(v, approximate=False), norm_g, norm_b)
    vr = v.reshape(b, t // SG_CHUNK, SG_CHUNK, SG_GROUPS, SG_WIDTH // SG_GROUPS)
    mixed = jnp.einsum('gpq,bnqgc->bnpgc', w_s, vr) + b_s.T[:, :, None]
    return u * mixed.reshape(b, t, SG_WIDTH)


def _retention_chunks(q, k, v, log_gamma, state0, inclusive, emit):
    b, h, t, _ = q.shape
    dv = v.shape[-1]
    n = t // RET_CHUNK

    def to_chunks(a):
        return a.reshape(b, h, n, RET_CHUNK, a.shape[-1]).transpose(2, 0, 1, 3, 4)

    idx = jnp.arange(RET_CHUNK, dtype=F32)
    diff = idx[:, None] - idx[None, :]
    mask = (diff >= 0) if inclusive else (diff > 0)
    inner_decay = jnp.where(mask, jnp.exp(log_gamma[:, None, None] * jnp.where(mask, diff, 0.0)), 0.0)
    q_decay = jnp.exp(log_gamma[:, None] * (idx + 1.0))[None, :, :, None]
    k_decay = jnp.exp(log_gamma[:, None] * (RET_CHUNK - 1.0 - idx))[None, :, :, None]
    chunk_decay = jnp.exp(log_gamma * RET_CHUNK)[None, :, None, None]

    def step(state, blk):
        qb, kb, vb = (a.astype(F32) for a in blk)
        new_state = state * chunk_decay + jnp.einsum('bhjd,bhjv->bhdv', kb * k_decay, vb)
        if not emit:
            return new_state, None
        inner = jnp.einsum('bhij,bhjv->bhiv', jnp.einsum('bhid,bhjd->bhij', qb, kb) * inner_decay, vb)
        cross = jnp.einsum('bhid,bhdv->bhiv', qb, state) * q_decay
        return new_state, inner + cross

    state, out = lax.scan(step, state0, (to_chunks(q), to_chunks(k), to_chunks(v)))
    if emit:
        out = out.transpose(1, 2, 0, 3, 4).reshape(b, h, t, dv)
    return state, out


def _ret_heads(q, k, v, pos):
    b, t = q.shape[:2]
    q = _ret_rope(q.reshape(b, t, RET_HEADS, RET_QK), pos) * (RET_QK ** -0.5)
    k = _ret_rope(k.reshape(b, t, RET_HEADS, RET_QK), pos)
    v = v.reshape(b, t, RET_HEADS, RET_V)
    return q.transpose(0, 2, 1, 3), k.transpose(0, 2, 1, 3), v.transpose(0, 2, 1, 3)


def _ret_out(o, g):
    b, h, t, dv = o.shape
    o = _layer_norm(o.transpose(0, 2, 1, 3))
    return (o.reshape(b, t, h * dv) * jax.nn.silu(g.astype(F32))).astype(g.dtype)


def retention_mixer(lat4, ctx4, logit_fwd, logit_bwd, pos_lat, pos_ctx, with_ctx_out):
    q, k, v, g = lat4
    qc, kc, vc, gc = ctx4
    ql, kl, vl = _ret_heads(q, k, v, pos_lat)
    qcc, kcc, vcc = _ret_heads(qc, kc, vc, pos_ctx)
    lg_f = jax.nn.log_sigmoid(logit_fwd.astype(F32))
    lg_b = jax.nn.log_sigmoid(logit_bwd.astype(F32))
    zero = jnp.zeros((ql.shape[0], RET_HEADS, RET_QK, RET_V), F32)

    def flip(a):
        return a[:, :, ::-1]

    st_f, oc_f = _retention_chunks(qcc, kcc, vcc, lg_f, zero, True, with_ctx_out)
    st_b, oc_b = _retention_chunks(flip(qcc), flip(kcc), flip(vcc), lg_b, zero, False, with_ctx_out)
    _, ol_f = _retention_chunks(ql, kl, vl, lg_f, st_f, True, True)
    _, ol_b = _retention_chunks(flip(ql), flip(kl), flip(vl), lg_b, st_b, False, True)
    out = _ret_out(ol_f + flip(ol_b), g)
    out_c = _ret_out(oc_f + flip(oc_b), gc) if with_ctx_out else None
    return out, out_c


def _clamped_swiglu(h):
    x_glu = jnp.minimum(h[..., ::2], SWIGLU_LIMIT)
    x_lin = jnp.clip(h[..., 1::2], -SWIGLU_LIMIT, SWIGLU_LIMIT)
    return x_glu * jax.nn.sigmoid(SWIGLU_ALPHA * x_glu) * (x_lin + 1.0)


def moe_ffn(tokens, router_w, router_b, w_gu, b_gu, w_down, b_down):
    n, d = tokens.shape
    logits = (tokens @ router_w + router_b).astype(F32)
    top_val, top_idx = lax.top_k(logits, TOP_K)
    gates = jax.nn.softmax(top_val, axis=-1)
    n_assign = n * TOP_K
    flat_e = top_idx.reshape(-1)
    flat_tok = jnp.repeat(jnp.arange(n, dtype=jnp.int32), TOP_K)
    order = jnp.argsort(flat_e)
    sorted_e = flat_e[order]
    counts = jnp.bincount(flat_e, length=N_EXPERTS)
    starts = jnp.cumsum(counts) - counts
    padded = (counts + MOE_BLOCK - 1) // MOE_BLOCK * MOE_BLOCK
    pad_end = jnp.cumsum(padded)
    dest = (pad_end - padded)[sorted_e] + jnp.arange(n_assign, dtype=jnp.int32) - starts[sorted_e]
    n_blocks = -(-(n_assign + N_EXPERTS * (MOE_BLOCK - 1)) // MOE_BLOCK)
    cap = n_blocks * MOE_BLOCK
    tok_buf = jnp.full((cap,), n, jnp.int32).at[dest].set(flat_tok[order])
    gate_buf = jnp.zeros((cap,), F32).at[dest].set(gates.reshape(-1)[order])
    block_e = jnp.minimum(
        jnp.searchsorted(pad_end, jnp.arange(n_blocks, dtype=jnp.int32) * MOE_BLOCK, side='right'),
        N_EXPERTS - 1)
    x_pad = jnp.concatenate([tokens, jnp.zeros((1, d), tokens.dtype)], axis=0)

    def expert_block(args):
        idx, e = args
        h = x_pad[idx] @ w_gu[e] + b_gu[e]
        return _clamped_swiglu(h) @ w_down[e] + b_down[e]

    y_blocks = lax.map(expert_block, (tok_buf.reshape(n_blocks, MOE_BLOCK), block_e))
    y = jnp.zeros((n + 1, d), F32).at[tok_buf].add(
        y_blocks.reshape(cap, d).astype(F32) * gate_buf[:, None])
    return y[:n].astype(tokens.dtype)


def hybrid_layer(x, ctx, silu_c, silu_cc, p, rope_cos, rope_sin, pos_lat, pos_ctx, with_ctx_out):
    b, s, d = x.shape
    mod = (silu_c @ p['ada_w'] + p['ada_b']).reshape(b, N_MOD, 1, d)
    mod_c = (silu_cc @ p['ada_w'] + p['ada_b']).reshape(N_MOD, 1, 1, d)
    sh1, sc1, g1, sh2, sc2, g2 = (mod[:, i] for i in range(N_MOD))
    csh1, csc1, cg1, csh2, csc2, cg2 = (mod_c[i] for i in range(N_MOD))

    lat = _split_cols((x * (1.0 + sc1) + sh1) @ p['w_in'], IN_SIZES)
    cpr = _split_cols((ctx * (1.0 + csc1) + csh1) @ p['w_in'], IN_SIZES)

    mla_l, mla_c = mla_mixer(lat[0:3], cpr[0:3], p['mla_q_norm_g'], p['mla_kv_norm_g'],
                             p['mla_w_uq'], p['mla_w_ukv'], rope_cos, rope_sin, with_ctx_out)
    sg_l = spatial_gate(lat[3], lat[4], p['sg_norm_g'], p['sg_norm_b'], p['sg_w'], p['sg_b'])
    ret_l, ret_c = retention_mixer(lat[5:9], cpr[5:9], p['ret_decay_fwd'], p['ret_decay_bwd'],
                                   pos_lat, pos_ctx, with_ctx_out)
    y = jnp.concatenate([mla_l, sg_l, ret_l], axis=-1) @ p['w_o']
    x = _layer_norm(DEEPNORM_ALPHA * x + g1 * y, p['ln1_g'], p['ln1_b'])
    h2 = x * (1.0 + sc2) + sh2
    moe_args = (p['router_w'], p['router_b'], p['w_gate_up'], p['b_gate_up'], p['w_down'], p['b_down'])

    if not with_ctx_out:
        f = moe_ffn(h2.reshape(b * s, d), *moe_args).reshape(b, s, d)
        return _layer_norm(DEEPNORM_ALPHA * x + g2 * f, p['ln2_g'], p['ln2_b']), None

    sg_c = spatial_gate(cpr[3], cpr[4], p['sg_norm_g'], p['sg_norm_b'], p['sg_w'], p['sg_b'])
    yc = jnp.concatenate([mla_c, sg_c, ret_c], axis=-1) @ p['w_o']
    ctx = _layer_norm(DEEPNORM_ALPHA * ctx + cg1 * yc, p['ln1_g'], p['ln1_b'])
    h2c = ctx * (1.0 + csc2) + csh2
    lc = ctx.shape[1]
    f = moe_ffn(jnp.concatenate([h2c.reshape(b * lc, d), h2.reshape(b * s, d)], axis=0), *moe_args)
    f_c = f[:b * lc].reshape(b, lc, d)
    f_l = f[b * lc:].reshape(b, s, d)
    x = _layer_norm(DEEPNORM_ALPHA * x + g2 * f_l, p['ln2_g'], p['ln2_b'])
    ctx = _layer_norm(DEEPNORM_ALPHA * ctx + cg2 * f_c, p['ln2_g'], p['ln2_b'])
    return x, ctx


def setup_inputs(seed: int = 0) -> dict:
    key = jax.random.key(seed)
    k = jax.random.split(key, 28)
    L, D = DEPTH, D_MODEL

    def nrm(i, shape, scale):
        return jax.random.normal(k[i], shape, F32) * scale

    gamma0 = 1.0 - 2.0 ** (-5.0 - np.arange(RET_HEADS, dtype=np.float32))
    logit0 = jnp.asarray(np.log(gamma0 / (1.0 - gamma0)), F32)
    return {
        'x': nrm(0, (BATCH, SEQ, D), 1.0),
        'c': nrm(1, (BATCH, D), 1.0),
        'ctx': nrm(2, (BATCH, CTX_LEN, D), 1.0),
        'c_ctx': nrm(3, (D,), 1.0),
        'ada_w': nrm(4, (L, D, N_MOD * D), D ** -0.5),
        'ada_b': nrm(5, (L, N_MOD * D), 0.02),
        'w_in': nrm(6, (L, D, IN_WIDTH), D ** -0.5),
        'mla_q_norm_g': 1.0 + nrm(7, (L, MLA_Q_LORA), 0.02),
        'mla_kv_norm_g': 1.0 + nrm(8, (L, MLA_KV_LORA), 0.02),
        'mla_w_uq': nrm(9, (L, MLA_Q_LORA, MLA_HEADS * MLA_QK), MLA_Q_LORA ** -0.5),
        'mla_w_ukv': nrm(10, (L, MLA_KV_LORA, MLA_HEADS * (MLA_NOPE + MLA_V)), MLA_KV_LORA ** -0.5),
        'sg_norm_g': 1.0 + nrm(11, (L, SG_WIDTH), 0.02),
        'sg_norm_b': nrm(12, (L, SG_WIDTH), 0.02),
        'sg_w': nrm(13, (L, SG_GROUPS, SG_CHUNK, SG_CHUNK), SG_CHUNK ** -0.5),
        'sg_b': 1.0 + nrm(14, (L, SG_GROUPS, SG_CHUNK), 0.02),
        'ret_decay_fwd': logit0 + nrm(15, (L, RET_HEADS), 0.05),
        'ret_decay_bwd': logit0 + nrm(16, (L, RET_HEADS), 0.05),
        'w_o': nrm(17, (L, MIX_WIDTH, D), DEEPNORM_BETA * MIX_WIDTH ** -0.5),
        'ln1_g': 1.0 + nrm(18, (L, D), 0.02),
        'ln1_b': nrm(19, (L, D), 0.02),
        'router_w': nrm(20, (L, D, N_EXPERTS), D ** -0.5),
        'router_b': nrm(21, (L, N_EXPERTS), 0.01),
        'w_gate_up': nrm(22, (L, N_EXPERTS, D, 2 * D_EXPERT), D ** -0.5),
        'b_gate_up': nrm(23, (L, N_EXPERTS, 2 * D_EXPERT), 0.02),
        'w_down': nrm(24, (L, N_EXPERTS, D_EXPERT, D), DEEPNORM_BETA * D_EXPERT ** -0.5),
        'b_down': nrm(25, (L, N_EXPERTS, D), 0.02),
        'ln2_g': 1.0 + nrm(26, (L, D), 0.02),
        'ln2_b': nrm(27, (L, D), 0.02),
    }


def reference(x, c, ctx, c_ctx, ada_w, ada_b, w_in, mla_q_norm_g, mla_kv_norm_g, mla_w_uq,
              mla_w_ukv, sg_norm_g, sg_norm_b, sg_w, sg_b, ret_decay_fwd, ret_decay_bwd, w_o,
              ln1_g, ln1_b, router_w, router_b, w_gate_up, b_gate_up, w_down, b_down, ln2_g, ln2_b):
    s = x.shape[1]
    lc = ctx.shape[1]
    rope_cos, rope_sin = _axial_tables(s)
    pos_ctx = jnp.arange(lc, dtype=F32)
    pos_lat = lc + jnp.arange(s, dtype=F32)
    silu_c = jax.nn.silu(c)
    silu_cc = jax.nn.silu(c_ctx)
    for i in range(DEPTH):
        p = {
            'ada_w': ada_w[i], 'ada_b': ada_b[i], 'w_in': w_in[i],
            'mla_q_norm_g': mla_q_norm_g[i], 'mla_kv_norm_g': mla_kv_norm_g[i],
            'mla_w_uq': mla_w_uq[i], 'mla_w_ukv': mla_w_ukv[i],
            'sg_norm_g': sg_norm_g[i], 'sg_norm_b': sg_norm_b[i], 'sg_w': sg_w[i], 'sg_b': sg_b[i],
            'ret_decay_fwd': ret_decay_fwd[i], 'ret_decay_bwd': ret_decay_bwd[i],
            'w_o': w_o[i], 'ln1_g': ln1_g[i], 'ln1_b': ln1_b[i],
            'router_w': router_w[i], 'router_b': router_b[i],
            'w_gate_up': w_gate_up[i], 'b_gate_up': b_gate_up[i],
            'w_down': w_down[i], 'b_down': b_down[i], 'ln2_g': ln2_g[i], 'ln2_b': ln2_b[i],
        }
        x, ctx = hybrid_layer(x, ctx, silu_c, silu_cc, p, rope_cos, rope_sin, pos_lat, pos_ctx,
                              i < DEPTH - 1)
    return x
```

```cpp
#include <hip/hip_runtime.h>
#include <cstdio>
#include <cstdint>

#ifndef MK_PER_PHASE
#define MK_PER_PHASE 0
#endif

#define GAS __attribute__((address_space(1)))
#define LAS __attribute__((address_space(3)))
typedef unsigned short bf16_t;
typedef short bf16x8 __attribute__((ext_vector_type(8)));
typedef short s16x4 __attribute__((ext_vector_type(4)));
typedef float f32x2 __attribute__((ext_vector_type(2)));
typedef float f32x4 __attribute__((ext_vector_type(4)));
typedef float f32x16 __attribute__((ext_vector_type(16)));
typedef unsigned u32x2 __attribute__((ext_vector_type(2)));
typedef unsigned u32x4 __attribute__((ext_vector_type(4)));
typedef int v8i __attribute__((ext_vector_type(8)));
typedef int v4i __attribute__((ext_vector_type(4)));

constexpr int DM = 1024, NB = 4, SEQ = 8192, NLAYER = 4, CTXL = 256;
constexpr int NCTX = NB * CTXL;
constexpr int NTOK = NCTX + NB * SEQ;
constexpr int KEYS = CTXL + SEQ;
constexpr int PROJW = 2048;
constexpr int NEXP = 32, TOPK = 4;
constexpr int CAP_TILES = 560, CAP_ROWS = CAP_TILES * 256;
constexpr float LN_EPS = 1e-5f, RMS_EPS = 1e-6f;
constexpr float DN_ALPHA = 1.681792830507429f;
constexpr float MLA_SCALE = 0.07216878364870322f;
constexpr float RET_QSCALE = 0.1767766952966369f;
constexpr float ACT_Q = 4.f;      constexpr int ACT_E = 0x7d7d7d7d;
constexpr float WGU_Q = 128.f;    constexpr int WGU_E = 0x78787878;
constexpr float WDN_Q = 256.f;    constexpr int WDN_E = 0x77777777;
constexpr float QK_Q = 8.f;       constexpr int QK_E = 0x7c7c7c7c;
constexpr float QC_Q = 16.f * 0.07216878364870322f * 1.4426950408889634f;   constexpr int QC_E = 0x7b7b7b7b;
constexpr float PV_Q = 8.f;       constexpr int PV_E = 0x7c7c7c7c;
constexpr int VT_ROW = 80, VT_TILE = 128 * VT_ROW;
constexpr float DO_Q = 64.f;
constexpr int C_CQ = 0, C_CKV = 384, C_KR = 640, C_SGU = 704, C_SGV = 960, C_RQ = 1216, C_RK = 1344, C_RV = 1472, C_RG = 1728;

constexpr size_t MiB = 1u << 20;
constexpr size_t WS_CTL = 0, CTL_ZERO_BYTES = 1 * MiB;
constexpr size_t WS_MOD = 1 * MiB;
constexpr size_t WS_ATAB = 2 * MiB;
constexpr size_t WS_RTAB = 2 * MiB + 65536;
constexpr size_t WS_WIN = 4 * MiB;
constexpr size_t WS_WUQ = 20 * MiB;
constexpr size_t WS_WUKV = 23 * MiB;
constexpr size_t WS_WO = 25 * MiB;
constexpr size_t WS_SGWB = 34 * MiB;
constexpr size_t WS_WGU = 64 * MiB;
constexpr size_t WS_WDN = 576 * MiB;
constexpr size_t WS_XRES = 832 * MiB;
constexpr size_t WS_XH = 964 * MiB;
constexpr size_t WS_PROJ = 1030 * MiB;
constexpr size_t WS_CQN = 1162 * MiB;
constexpr size_t WS_CKVN = 1187 * MiB;
constexpr size_t WS_QB = 1204 * MiB;
constexpr size_t WS_KB = 1254 * MiB;
constexpr size_t WS_VB = 1304 * MiB;
constexpr size_t WS_SGU = 1337 * MiB;
constexpr size_t WS_SGV = 1354 * MiB;
constexpr size_t WS_RQ = 1371 * MiB;
constexpr size_t WS_RK = 1388 * MiB;
constexpr size_t WS_OF = 1405 * MiB;
constexpr size_t WS_OB = 1438 * MiB;
constexpr size_t WS_MIX = 1471 * MiB;
constexpr size_t WS_Y = 1537 * MiB;
constexpr size_t WS_TOPI = 1669 * MiB;
constexpr size_t WS_GATE = 1670 * MiB;
constexpr size_t WS_DEST = 1671 * MiB;
constexpr size_t WS_ROWTOK = 1672 * MiB;
constexpr size_t WS_ACT = 1673 * MiB;
constexpr size_t WS_XH8 = 1830 * MiB;
constexpr size_t WS_DOUT = 1953 * MiB;
constexpr size_t WS_END = 2233 * MiB;
constexpr int CW_BAR = 4096;
constexpr int CW_BLKCNT = 16384;
constexpr int CW_NT = 32768;
constexpr int CW_TILE_E = 32832;

constexpr int LDS_BYTES = 147456;
constexpr int RING_BYTES = 131072;
constexpr int MISC_OFF = LDS_BYTES - 256;

#define RLX_AGENT __ATOMIC_RELAXED, __HIP_MEMORY_SCOPE_AGENT
__device__ __forceinline__ unsigned f2bf(float f) { unsigned u = __builtin_bit_cast(unsigned, f); return (u + 0x7fffu + ((u >> 16) & 1u)) >> 16; }
__device__ __forceinline__ unsigned pk2(float lo, float hi) { return f2bf(lo) | (f2bf(hi) << 16); }
__device__ __forceinline__ float bf2f(unsigned short h) { return __builtin_bit_cast(float, (unsigned)h << 16); }
__device__ __forceinline__ float bflo(unsigned w) { return __builtin_bit_cast(float, w << 16); }
__device__ __forceinline__ float bfhi(unsigned w) { return __builtin_bit_cast(float, w & 0xffff0000u); }
__device__ __forceinline__ unsigned cvt_pk_bf16(float lo, float hi) { unsigned r; asm volatile("v_cvt_pk_bf16_f32 %0, %1, %2" : "=v"(r) : "v"(lo), "v"(hi)); return r; }
__device__ __forceinline__ unsigned pk4_fp8(float x0, float x1, float x2, float x3) { int w = 0; w = __builtin_amdgcn_cvt_pk_fp8_f32(x0, x1, w, false); w = __builtin_amdgcn_cvt_pk_fp8_f32(x2, x3, w, true); return (unsigned)w; }
template <int CTRL> __device__ __forceinline__ float dpp_f(float v) { return __builtin_bit_cast(float, __builtin_amdgcn_update_dpp(0, __builtin_bit_cast(int, v), CTRL, 0xf, 0xf, true)); }
template <int CTRL> __device__ __forceinline__ int dpp_i(int v) { return __builtin_amdgcn_update_dpp(0, v, CTRL, 0xf, 0xf, true); }
__device__ __forceinline__ float wave_sum(float v) {
    v += dpp_f<0xB1>(v);
    v += dpp_f<0x4E>(v);
    v += dpp_f<0x141>(v);
    v += dpp_f<0x140>(v);
    { const int b_ = __builtin_bit_cast(int, v);
      const float r0 = __builtin_bit_cast(float, __builtin_amdgcn_readlane(b_, 0)), r1 = __builtin_bit_cast(float, __builtin_amdgcn_readlane(b_, 16)), r2 = __builtin_bit_cast(float, __builtin_amdgcn_readlane(b_, 32)), r3 = __builtin_bit_cast(float, __builtin_amdgcn_readlane(b_, 48));
      v = (r0 + r1) + (r2 + r3); }
    return v;
}
__device__ __forceinline__ int lane_id() { int l; asm volatile("v_mbcnt_lo_u32_b32 %0, -1, 0\n\tv_mbcnt_hi_u32_b32 %0, -1, %0" : "=v"(l)); return l; }
__device__ __forceinline__ int ld_ctl(const unsigned* p) { return (int)__hip_atomic_load(p, RLX_AGENT); }
__device__ __forceinline__ float gelu1(float v) {
    const float av = fabsf(v), d = av * 0.2316418882f + 1.0f, t = __builtin_amdgcn_rcpf(d);
    float q = t * 0.5307027145f + (-0.7265760135f); q = q * t + 0.7107068705f; q = q * t + (-0.142248368f); q = q * t + 0.127414796f; q = q * t;
    const float e = __builtin_amdgcn_exp2f((v * v) * (-0.72134752044f));
    const float m = v * (q * e), r = v - m;
    return v < 0.f ? m : r;
}
__device__ __forceinline__ float sigmoidf_(float x) { return __builtin_amdgcn_rcpf(1.f + __builtin_amdgcn_exp2f(-1.4426950408889634f * x)); }
__device__ __forceinline__ int modset(int n) { return (n < NCTX) ? 4 : ((n - NCTX) >> 13); }

__device__ const double INV_R[16] = {1.0, 0.5411695265464637, 0.2928644564625237, 0.15848931924611134, 0.08576958985908942, 0.046415888336127795, 0.025118864315095794, 0.013593563908785255,
                                     0.007356422544596414, 0.003981071705534973, 0.0021544346900318843, 0.0011659144011798323, 0.000630957344480193, 0.0003414548873833601, 0.00018478497974222906, 0.0001};
__device__ const double INV_A[16] = {1.0, 0.5623413251903491, 0.31622776601683794, 0.1778279410038923, 0.1, 0.05623413251903491, 0.03162277660168379, 0.01778279410038923,
                                     0.01, 0.005623413251903491, 0.0031622776601683794, 0.0017782794100389228, 0.001, 0.0005623413251903491, 0.00031622776601683794, 0.00017782794100389227};
__device__ __forceinline__ void sincos_d(double x, float& s, float& c) {
    const double k = rint(x * 0.15915494309189535);
    double r = fma(-k, 6.283185307179586, x); r = fma(-k, 2.4492935982947064e-16, r);
    const double r2 = r * r;
    double ps = -1.0 / 51090942171709440000.0;
    ps = fma(ps, r2, 1.0 / 121645100408832000.0);
    ps = fma(ps, r2, -1.0 / 355687428096000.0);
    ps = fma(ps, r2, 1.0 / 1307674368000.0);
    ps = fma(ps, r2, -1.0 / 6227020800.0);
    ps = fma(ps, r2, 1.0 / 39916800.0);
    ps = fma(ps, r2, -1.0 / 362880.0);
    ps = fma(ps, r2, 1.0 / 5040.0);
    ps = fma(ps, r2, -1.0 / 120.0);
    ps = fma(ps, r2, 1.0 / 6.0);
    ps = fma(ps, r2, -1.0);
    ps = -ps * r;
    double pc = 1.0 / 2432902008176640000.0;
    pc = fma(pc, r2, -1.0 / 6402373705728000.0);
    pc = fma(pc, r2, 1.0 / 20922789888000.0);
    pc = fma(pc, r2, -1.0 / 87178291200.0);
    pc = fma(pc, r2, 1.0 / 479001600.0);
    pc = fma(pc, r2, -1.0 / 3628800.0);
    pc = fma(pc, r2, 1.0 / 40320.0);
    pc = fma(pc, r2, -1.0 / 720.0);
    pc = fma(pc, r2, 1.0 / 24.0);
    pc = fma(pc, r2, -0.5);
    pc = fma(pc, r2, 1.0);
    s = (float)ps; c = (float)pc;
}

#define XB_TMO      128
#define XB_XCNT(j)  (256  + 64 * (j))
#define XB_XSUB(j)  (1280 + 64 * (j))
#define XB_XGEN(j)  (2304 + 64 * (j))
#define XB_TOP      3328
#define XB_TOPGEN   3392
#define XCD_BAR_WORDS 3456
#define XB_SPIN_CAP (1u << 24)
__device__ __forceinline__ unsigned xb_ld(unsigned* p)              { return __hip_atomic_load(p, __ATOMIC_RELAXED, __HIP_MEMORY_SCOPE_AGENT); }
__device__ __forceinline__ unsigned xb_add(unsigned* p, unsigned v) { return __hip_atomic_fetch_add(p, v, __ATOMIC_RELAXED, __HIP_MEMORY_SCOPE_AGENT); }
__device__ __forceinline__ unsigned xb_xcc_id() { return (unsigned)__builtin_amdgcn_s_getreg((3 << 11) | 20) & 0xFu; }
#define XB_SPIN(cond, bar) do { unsigned _sp = 0; while (cond) { __builtin_amdgcn_s_sleep(1); \
    if ((++_sp & 255u) == 0u) { if (xb_ld(&(bar)[XB_TMO])) break; if (_sp > XB_SPIN_CAP) { atomicAdd(&(bar)[XB_TMO], 1u); break; } } } } while (0)
struct XcdBarrier { unsigned* bar; unsigned x; volatile LAS unsigned* st; int wave; };
__device__ __forceinline__ XcdBarrier xcd_barrier_post(unsigned* bar, volatile LAS unsigned* st) {
    XcdBarrier b; b.bar = bar; b.x = xb_xcc_id(); b.st = st; b.wave = 0;
    if (threadIdx.x == 0) (void)xb_add(&bar[XB_XCNT(b.x)], 1u);
    return b;
}
__device__ __forceinline__ void xcd_barrier_complete(unsigned* bar, unsigned x, unsigned& nloc, unsigned& nx) {
    const unsigned G = gridDim.x * gridDim.y * gridDim.z;
    unsigned sum, cnt, mine, sp = 0u;
    for (;;) {
        sum = 0u; cnt = 0u; mine = 0u;
#pragma unroll
        for (unsigned j = 0; j < 16; ++j) { const unsigned c = xb_ld(&bar[XB_XCNT(j)]); sum += c; cnt += (c > 0u) ? 1u : 0u; mine = (j == x) ? c : mine; }
        if (sum == G) break;
        __builtin_amdgcn_s_sleep(1);
        if ((++sp & 255u) == 0u) { if (xb_ld(&bar[XB_TMO])) break; if (sp > XB_SPIN_CAP) { atomicAdd(&bar[XB_TMO], 1u); break; } }
    }
    nloc = mine > 0u ? mine : 1u; nx = cnt > 0u ? cnt : 1u;
}
__device__ __forceinline__ void xcd_barrier(const XcdBarrier& b) {
    asm volatile("s_waitcnt vmcnt(0)" ::: "memory");
    __syncthreads();
    if (b.wave == 0 && lane_id() == 0) {
        unsigned* bar = b.bar;
        __builtin_amdgcn_s_waitcnt(0);
        unsigned nloc = b.st[0], nx = b.st[1];
        if (nloc == 0u) { xcd_barrier_complete(bar, b.x, nloc, nx); b.st[0] = nloc; b.st[1] = nx; }
        const unsigned old = xb_add(&bar[XB_XSUB(b.x)], 1u);
        const unsigned gen = old / nloc;
        if (old + 1u == (gen + 1u) * nloc) {
            __builtin_amdgcn_fence(__ATOMIC_RELEASE, "agent");
            asm volatile("s_waitcnt vmcnt(0)" ::: "memory");
            const unsigned og = xb_add(&bar[XB_TOP], 1u);
            const unsigned tg = og / nx;
            if (og + 1u == (tg + 1u) * nx) xb_add(&bar[XB_TOPGEN], 1u);
            else XB_SPIN(xb_ld(&bar[XB_TOPGEN]) == tg, bar);
            __builtin_amdgcn_fence(__ATOMIC_ACQUIRE, "agent");
            xb_add(&bar[XB_XGEN(b.x)], 1u);
            asm volatile("s_waitcnt vmcnt(0)" ::: "memory");
        } else {
            XB_SPIN(xb_ld(&bar[XB_XGEN(b.x)]) == gen, bar);
            __builtin_amdgcn_fence(__ATOMIC_ACQUIRE, "agent");
            asm volatile("s_waitcnt vmcnt(0)" ::: "memory");
        }
    }
    __syncthreads();
}

namespace pg8 {
constexpr int BM = 256, BK = 64, HALF = 128, HTB = HALF * BK * 2, NXCD = 8, WGM = 8;
__host__ __device__ __forceinline__ int lds_byte(int r, int c) { const int st = (r >> 4) * 2 + (c >> 5), rr = r & 15, cc = c & 31, ob = rr * 64 + cc * 2; return st * 1024 + (ob ^ (((ob >> 9) & 1) << 5)); }
__host__ __device__ __forceinline__ void stage_rc(int b, int& R, int& C) { const int st = b / 1024, sb = b % 1024, swz = sb ^ (((sb >> 9) & 1) << 5); R = (st >> 1) * 16 + swz / 64; C = (st & 1) * 32 + (swz % 64) / 2; }
__host__ __device__ __forceinline__ int perm32(int rho) { const int n = rho >> 4, i = rho & 15; return 8 * (i >> 2) + 4 * n + (i & 3); }
struct Unit { int pm, pn; };
struct Gemm { const void* A; const void* Bt; int lda, K; const LAS unsigned short* rowlds; int scaleA, scaleB; };

struct StaticOrder {
    int nM, nN, nwg, G, c;
    __device__ __forceinline__ void init(int nM_, int nN_, int G_, int c_) { nM = nM_; nN = nN_; nwg = nM * nN; G = G_; c = c_; }
    __device__ __forceinline__ bool next(int i, Unit& u) const {
        const long L = (long)i * G + c; if (L >= nwg) return false;
        int wgid = (int)L; { const int q = nwg / NXCD, r = nwg % NXCD, xcd = wgid % NXCD, off = wgid / NXCD; wgid = (xcd < r ? xcd * (q + 1) : r * (q + 1) + (xcd - r) * q) + off; }
        const int nig = WGM * nN, gid = wgid / nig, fm = gid * WGM, gsz = (nM - fm) < WGM ? (nM - fm) : WGM;
        u.pm = fm + ((wgid % nig) % gsz); u.pn = (wgid % nig) / gsz; return true;
    }
};
struct MoeOrder {
    StaticOrder so; const LAS unsigned char* tile_e;
    __device__ __forceinline__ bool next(int i, Unit& u) const {
        if (!so.next(i, u)) return false;
        const int e = __builtin_amdgcn_readfirstlane((int)tile_e[u.pm]);
        u.pn = e * so.nN + u.pn; return true;
    }
};

template <class Epi, class Sched, bool GATHER, bool FP8 = false>
__device__ __forceinline__ void gemm_phase(LAS unsigned char* lds, const Gemm g, const Sched& S, const Epi& E, const int wave_s) {
    int tid_ = wave_s * 64 + lane_id(); asm volatile("" : "+v"(tid_));
    const int tid = tid_, wid = __builtin_amdgcn_readfirstlane(tid >> 6), lane = tid & 63, wr = wid >> 2, wc = wid & 3, fr = lane & 15, fq = lane >> 4;
    constexpr int ESZ = FP8 ? 1 : 2;
    const int K = g.K, nt = K * ESZ / (BK * 2);
    int RA[2]; unsigned CA2[2], voffB[2];
#pragma unroll
    for (int i = 0; i < 2; ++i) { int R, C; stage_rc(tid * 16 + i * 8192, R, C); const int Rb = Epi::PERM ? ((R & ~31) + perm32(R & 31)) : R;
        RA[i] = R; CA2[i] = (unsigned)C * 2u; voffB[i] = (unsigned)(Rb * K * ESZ + C * 2); }
    const unsigned lda2 = (unsigned)g.lda * ESZ;
    const size_t kstep = (size_t)(BK * 2);
    const size_t hstepB = (size_t)HALF * K * ESZ, tstepB = 2 * hstepB;
    const unsigned ldsw = (unsigned)wid * 1024u;
    const int aoff = lds_byte(wr * 64 + fr, fq * 8), boff = lds_byte(wc * 32 + fr, fq * 8);
#define PG8_SA(b, h) (((b) * 2 + (h)) * HTB)
#define PG8_SB(b, h) ((4 + (b) * 2 + (h)) * HTB)
#define PG8_STAGE_B(bufoff, gbase) do { _Pragma("unroll") for (int _i = 0; _i < 2; ++_i) \
        __builtin_amdgcn_global_load_lds((const unsigned*)((const char*)(gbase) + voffB[_i]), (LAS unsigned*)(lds + (bufoff) + ldsw + _i * 8192), 16, 0, 0); } while (0)
#define PG8_STAGE_A(bufoff, gbase, UA) do { _Pragma("unroll") for (int _i = 0; _i < 2; ++_i) \
        __builtin_amdgcn_global_load_lds((const unsigned*)((const char*)(gbase) + (UA)[_i]), (LAS unsigned*)(lds + (bufoff) + ldsw + _i * 8192), 16, 0, 0); } while (0)
#define PG8_LD8(base) __builtin_shufflevector(*(const LAS v4i*)(base), *(const LAS v4i*)((base) + 1024), 0, 1, 2, 3, 4, 5, 6, 7)
#define PG8_LDA(dst, b, h) do { _Pragma("unroll") for (int m = 0; m < 4; ++m) dst[m] = PG8_LD8(lds + PG8_SA(b, h) + aoff + m * 2048); } while (0)
#define PG8_LDB(dst, b, h) do { _Pragma("unroll") for (int n = 0; n < 2; ++n) dst[n] = PG8_LD8(lds + PG8_SB(b, h) + boff + n * 2048); } while (0)
#define PG8_HALF(F, k) __builtin_bit_cast(bf16x8, (k) ? __builtin_shufflevector(F, F, 4, 5, 6, 7) : __builtin_shufflevector(F, F, 0, 1, 2, 3))
#define PG8_MMA(ai, bj, At, Bt) do { __builtin_amdgcn_s_setprio(1); \
        if constexpr (FP8) { _Pragma("unroll") for (int m = 0; m < 4; ++m) _Pragma("unroll") for (int n = 0; n < 2; ++n) \
            asm volatile("v_mfma_scale_f32_16x16x128_f8f6f4 %0, %1, %2, %0, %3, %4 op_sel_hi:[0,0,0]" : "+v"(acc[ai][bj][m][n]) : "v"(Bt[n]), "v"(At[m]), "v"(scB), "v"(scA)); } \
        else { _Pragma("unroll") for (int m = 0; m < 4; ++m) _Pragma("unroll") for (int n = 0; n < 2; ++n) _Pragma("unroll") for (int k = 0; k < 2; ++k) \
            acc[ai][bj][m][n] = __builtin_amdgcn_mfma_f32_16x16x32_bf16(PG8_HALF(Bt[n], k), PG8_HALF(At[m], k), acc[ai][bj][m][n], 0, 0, 0); } \
        __builtin_amdgcn_s_setprio(0); } while (0)
#define PG8_WAIT_V(n) asm volatile("s_waitcnt vmcnt(" #n ")" ::: "memory")
#define PG8_WAIT_L(n) asm volatile("s_waitcnt lgkmcnt(" #n ")" ::: "memory")
#define PG8_BAR __builtin_amdgcn_s_barrier()
#define PG8_SCHED __builtin_amdgcn_sched_barrier(0)
#define PG8_CALC_UA(dst, un, uord) do { _Pragma("unroll") for (int _h = 0; _h < 2; ++_h) _Pragma("unroll") for (int _i = 0; _i < 2; ++_i) { \
        int _rr = (un).pm * BM + _h * HALF + RA[_i]; if (GATHER) _rr = (int)g.rowlds[(uord) * 256 + _h * HALF + RA[_i]]; dst[_h][_i] = (unsigned)_rr * lda2 + CA2[_i]; } } while (0)
    Unit cur, nxt; int ui = 0;
    if (!S.next(0, cur)) return;
    const int scA = g.scaleA, scB = g.scaleB; (void)scA; (void)scB;
    if constexpr (Epi::BIAS_LDS) { if (wid == 0) __builtin_amdgcn_global_load_lds((const unsigned*)(E.bias_src(cur) + lane_id() * 4), (LAS unsigned*)(lds + Epi::BIAS_OFF), 16, 0, 0); }
    unsigned uAc[2][2], uAn[2][2];
    const size_t tstepA = (size_t)BM * lda2;
    if constexpr (GATHER) { PG8_CALC_UA(uAc, cur, 0); }
    else {
#pragma unroll
        for (int h = 0; h < 2; ++h)
#pragma unroll
            for (int i = 0; i < 2; ++i) { uAc[h][i] = (unsigned)(h * HALF + RA[i]) * lda2 + CA2[i]; uAn[h][i] = uAc[h][i]; } }
    f32x4 acc[2][2][4][2];
#pragma unroll
    for (int a = 0; a < 2; ++a)
#pragma unroll
        for (int b = 0; b < 2; ++b)
#pragma unroll
            for (int m = 0; m < 4; ++m)
#pragma unroll
                for (int n = 0; n < 2; ++n) acc[a][b][m][n] = (f32x4){0.f, 0.f, 0.f, 0.f};
    v8i At[4], B0[2], B1[2];
    const char* cA = GATHER ? (const char*)g.A : (const char*)g.A + (size_t)cur.pm * tstepA;
    const char* cB = (const char*)g.Bt + (size_t)cur.pn * tstepB;
    PG8_STAGE_B(PG8_SB(0, 0), cB); PG8_STAGE_B(PG8_SB(0, 1), cB + hstepB); PG8_STAGE_A(PG8_SA(0, 0), cA, uAc[0]); PG8_STAGE_A(PG8_SA(0, 1), cA, uAc[1]);
    if (wr == 1) PG8_BAR;
    PG8_WAIT_V(2); PG8_BAR;
    PG8_STAGE_B(PG8_SB(1, 0), cB + kstep); PG8_STAGE_A(PG8_SA(1, 0), cA + kstep, uAc[0]); PG8_STAGE_B(PG8_SB(1, 1), cB + hstepB + kstep);
    PG8_WAIT_V(6); PG8_BAR;
    for (;;) {
        const bool has_next = S.next(ui + 1, nxt);
        const char* nB = has_next ? (const char*)g.Bt + (size_t)nxt.pn * tstepB : cB;
        const char* nA = (GATHER || !has_next) ? cA : (const char*)g.A + (size_t)nxt.pm * tstepA;
        if constexpr (GATHER) {
            if (has_next) { PG8_CALC_UA(uAn, nxt, ui + 1); }
            else {
#pragma unroll
                for (int h = 0; h < 2; ++h)
#pragma unroll
                    for (int i = 0; i < 2; ++i) uAn[h][i] = uAc[h][i]; } }
#pragma unroll 1
        for (int t = 0; t < nt; t += 2) {
            const bool last = (t == nt - 2);
            const char* a1 = cA + (size_t)(t + 1) * kstep;
            const char* a2 = last ? nA : cA + (size_t)(t + 2) * kstep; const char* b2 = last ? nB : cB + (size_t)(t + 2) * kstep;
            const char* a3 = a2 + kstep; const char* b3 = b2 + kstep;
            unsigned u2[2][2];
#pragma unroll
            for (int h = 0; h < 2; ++h)
#pragma unroll
                for (int i = 0; i < 2; ++i) u2[h][i] = (GATHER && last) ? uAn[h][i] : uAc[h][i];
            PG8_LDB(B0, 0, 0); PG8_LDB(B1, 0, 1); PG8_SCHED; PG8_LDA(At, 0, 0); PG8_STAGE_A(PG8_SA(1, 1), a1, uAc[1]);
            PG8_WAIT_V(8); PG8_WAIT_L(0); PG8_BAR; PG8_MMA(0, 0, At, B0); PG8_MMA(0, 1, At, B1); PG8_BAR; PG8_SCHED;
            PG8_LDA(At, 0, 1); PG8_STAGE_B(PG8_SB(0, 0), b2); PG8_STAGE_B(PG8_SB(0, 1), b2 + hstepB); PG8_STAGE_A(PG8_SA(0, 0), a2, u2[0]);
            PG8_WAIT_V(8); PG8_WAIT_L(0); PG8_BAR; PG8_MMA(1, 0, At, B0); PG8_MMA(1, 1, At, B1); PG8_BAR; PG8_SCHED;
            PG8_LDB(B0, 1, 0); PG8_LDB(B1, 1, 1); PG8_SCHED; PG8_LDA(At, 1, 0); PG8_STAGE_A(PG8_SA(0, 1), a2, u2[1]);
            PG8_WAIT_V(8); PG8_WAIT_L(0); PG8_BAR; PG8_MMA(0, 0, At, B0); PG8_MMA(0, 1, At, B1); PG8_BAR; PG8_SCHED;
            PG8_LDA(At, 1, 1); PG8_STAGE_B(PG8_SB(1, 0), b3); PG8_STAGE_B(PG8_SB(1, 1), b3 + hstepB); PG8_STAGE_A(PG8_SA(1, 0), a3, u2[0]);
            PG8_WAIT_V(8); PG8_WAIT_L(0); PG8_BAR; PG8_MMA(1, 0, At, B0); PG8_MMA(1, 1, At, B1); PG8_BAR; PG8_SCHED;
        }
        if (wr == 0) PG8_BAR;
        if constexpr (FP8) { asm volatile("s_nop 15\n\ts_nop 15" ::: "memory"); PG8_SCHED; }
        if constexpr (Epi::BIAS_LDS) E(acc, cur, wr, wc, fr, fq, (const LAS float*)(lds + Epi::BIAS_OFF + (ui & 1) * 1024)); else E(acc, cur, wr, wc, fr, fq);
        if (!has_next) break;
#pragma unroll
        for (int a = 0; a < 2; ++a)
#pragma unroll
            for (int b = 0; b < 2; ++b)
#pragma unroll
                for (int m = 0; m < 4; ++m)
#pragma unroll
                    for (int n = 0; n < 2; ++n) acc[a][b][m][n] = (f32x4){0.f, 0.f, 0.f, 0.f};
        cur = nxt; cB = nB; cA = nA; ++ui;
        if constexpr (Epi::BIAS_LDS) { if (wid == 0) __builtin_amdgcn_global_load_lds((const unsigned*)(E.bias_src(cur) + lane_id() * 4), (LAS unsigned*)(lds + Epi::BIAS_OFF + (ui & 1) * 1024), 16, 0, 0); }
        if constexpr (GATHER) {
#pragma unroll
            for (int h = 0; h < 2; ++h)
#pragma unroll
                for (int i = 0; i < 2; ++i) uAc[h][i] = uAn[h][i]; }
        if (wr == 1) PG8_BAR;
    }
    PG8_WAIT_V(0);
    PG8_BAR;
#undef PG8_SA
#undef PG8_SB
#undef PG8_STAGE_A
#undef PG8_STAGE_B
#undef PG8_LDA
#undef PG8_LDB
#undef PG8_MMA
#undef PG8_LD8
#undef PG8_HALF
#undef PG8_WAIT_V
#undef PG8_WAIT_L
#undef PG8_BAR
#undef PG8_SCHED
#undef PG8_CALC_UA
}

struct EpiF32 { static constexpr bool BIAS_LDS = false; static constexpr int BIAS_OFF = 0;
    static constexpr bool PERM = false;
    float* C; int ldc;
    __device__ __forceinline__ void operator()(const f32x4 (&acc)[2][2][4][2], const Unit& u, int wr, int wc, int fr, int fq) const {
        const int row0 = u.pm * BM + wr * 64 + fr, col0 = u.pn * BM + wc * 32 + 4 * fq;
#pragma unroll
        for (int ai = 0; ai < 2; ++ai)
#pragma unroll
            for (int m = 0; m < 4; ++m) { float* rowp = C + (size_t)(row0 + ai * HALF + m * 16) * ldc + col0;
#pragma unroll
                for (int bj = 0; bj < 2; ++bj)
#pragma unroll
                    for (int n = 0; n < 2; ++n) *(f32x4*)(rowp + bj * HALF + n * 16) = acc[ai][bj][m][n]; }
    }
};
struct EpiBf16 {
    static constexpr bool PERM = true, BIAS_LDS = false; static constexpr int BIAS_OFF = 0;
    bf16_t* O; int ldc;
    __device__ __forceinline__ void operator()(const f32x4 (&acc)[2][2][4][2], const Unit& u, int wr, int wc, int fr, int fq) const {
        const int row0 = u.pm * BM + wr * 64 + fr, col0 = u.pn * BM + wc * 32 + 8 * fq;
#pragma unroll
        for (int ai = 0; ai < 2; ++ai)
#pragma unroll
            for (int m = 0; m < 4; ++m) { bf16_t* rowp = O + (size_t)(row0 + ai * HALF + m * 16) * ldc + col0;
#pragma unroll
                for (int bj = 0; bj < 2; ++bj) { const f32x4 v0 = acc[ai][bj][m][0], v1 = acc[ai][bj][m][1];
                    u32x4 w; w.x = cvt_pk_bf16(v0[0], v0[1]); w.y = cvt_pk_bf16(v0[2], v0[3]); w.z = cvt_pk_bf16(v1[0], v1[1]); w.w = cvt_pk_bf16(v1[2], v1[3]);
                    *(u32x4*)(rowp + bj * HALF) = w; } }
    }
};
struct EpiK {
    static constexpr bool PERM = true, BIAS_LDS = false; static constexpr int BIAS_OFF = 0;
    unsigned char* KB;
    __device__ __forceinline__ void operator()(const f32x4 (&acc)[2][2][4][2], const Unit& u, int wr, int wc, int fr, int fq) const {
        const int row0 = u.pm * BM + wr * 64 + fr, cw = wc * 32 + 8 * fq;
        unsigned char* base = KB + (u.pn * 2) * 192 + cw;
#pragma unroll
        for (int ai = 0; ai < 2; ++ai)
#pragma unroll
            for (int m = 0; m < 4; ++m) { unsigned char* rowp = base + (size_t)(row0 + ai * HALF + m * 16) * 768;
#pragma unroll
                for (int bj = 0; bj < 2; ++bj) { const f32x4 v0 = acc[ai][bj][m][0] * QK_Q, v1 = acc[ai][bj][m][1] * QK_Q;
                    u32x2 w; w.x = pk4_fp8(v0[0], v0[1], v0[2], v0[3]); w.y = pk4_fp8(v1[0], v1[1], v1[2], v1[3]);
                    *(u32x2*)(rowp + bj * 192) = w; } }
    }
};
struct EpiVT {
    static constexpr bool PERM = true, BIAS_LDS = false; static constexpr int BIAS_OFF = 0;
    unsigned char* VT;
    __device__ __forceinline__ void operator()(const f32x4 (&acc)[2][2][4][2], const Unit& u, int wr, int wc, int fr, int fq) const {
        const int row0 = u.pm * BM + wr * 64 + fr, col0 = u.pn * BM + wc * 32 + 8 * fq;
#pragma unroll
        for (int bj = 0; bj < 2; ++bj) {
            const int n = col0 + bj * HALF;
            const int b = (n < NCTX) ? (n >> 8) : ((n - NCTX) >> 13); const int key = (n < NCTX) ? (n & 255) : CTXL + ((n - NCTX) & 8191);
            const int tile = key >> 6, kk0 = key & 63; const int boff = (kk0 >> 5) * 16 + 4 * ((kk0 & 31) >> 3);
#pragma unroll
            for (int ai = 0; ai < 2; ++ai)
#pragma unroll
                for (int m = 0; m < 4; ++m) { const int vc = row0 + ai * HALF + m * 16; const int hh = vc >> 7, v = vc & 127;
                    unsigned char* p = VT + ((size_t)((b * 4 + hh) * (KEYS / 64) + tile)) * VT_TILE + v * VT_ROW + boff;
                    const f32x4 v0 = acc[ai][bj][m][0] * PV_Q, v1 = acc[ai][bj][m][1] * PV_Q;
                    *(unsigned*)p = pk4_fp8(v0[0], v0[1], v0[2], v0[3]); *(unsigned*)(p + 32) = pk4_fp8(v1[0], v1[1], v1[2], v1[3]); } }
    }
};
struct EpiSwiglu {
    static constexpr bool PERM = true, BIAS_LDS = true; static constexpr int BIAS_OFF = RING_BYTES + 12288;
    unsigned char* ACT; const float* bias;
    __device__ __forceinline__ const float* bias_src(const Unit& u) const { return bias + (u.pn >> 3) * 2048 + (u.pn & 7) * BM; }
    __device__ __forceinline__ void operator()(const f32x4 (&acc)[2][2][4][2], const Unit& u, int wr, int wc, int fr, int fq, const LAS float* bl) const {
        const int pnl = u.pn & 7;
        const int row0 = u.pm * BM + wr * 64 + fr, cl = wc * 32 + 8 * fq, col0 = pnl * BM + cl;
#pragma unroll
        for (int ai = 0; ai < 2; ++ai)
#pragma unroll
            for (int m = 0; m < 4; ++m) { unsigned char* rowp = ACT + (size_t)(row0 + ai * HALF + m * 16) * 1024 + (col0 >> 1);
#pragma unroll
                for (int bj = 0; bj < 2; ++bj) { const f32x4 v0 = acc[ai][bj][m][0] + *(const LAS f32x4*)(bl + cl + bj * HALF), v1 = acc[ai][bj][m][1] + *(const LAS f32x4*)(bl + cl + bj * HALF + 4);
                    float o[4];
#pragma unroll
                    for (int i = 0; i < 4; ++i) { const float hg = (i < 2) ? v0[2 * i] : v1[2 * i - 4], hl = (i < 2) ? v0[2 * i + 1] : v1[2 * i - 3];
                        const float glu = fminf(hg, 7.f), lin = fminf(fmaxf(hl, -7.f), 7.f);
                        o[i] = glu * sigmoidf_(1.702f * glu) * (lin + 1.f); }
                    *(unsigned*)(rowp + bj * (HALF / 2)) = pk4_fp8(o[0] * ACT_Q, o[1] * ACT_Q, o[2] * ACT_Q, o[3] * ACT_Q); } }
    }
};
struct EpiDown {
    static constexpr bool PERM = true, BIAS_LDS = true; static constexpr int BIAS_OFF = RING_BYTES + 12288;
    unsigned char* O; const float* bias;
    __device__ __forceinline__ const float* bias_src(const Unit& u) const { return bias + (u.pn >> 2) * 1024 + (u.pn & 3) * BM; }
    __device__ __forceinline__ void operator()(const f32x4 (&acc)[2][2][4][2], const Unit& u, int wr, int wc, int fr, int fq, const LAS float* bl) const {
        const int pnl = u.pn & 3;
        const int row0 = u.pm * BM + wr * 64 + fr, cl = wc * 32 + 8 * fq, col0 = pnl * BM + cl;
#pragma unroll
        for (int ai = 0; ai < 2; ++ai)
#pragma unroll
            for (int m = 0; m < 4; ++m) { unsigned char* rowp = O + (size_t)(row0 + ai * HALF + m * 16) * 1024 + col0;
#pragma unroll
                for (int bj = 0; bj < 2; ++bj) { const f32x4 v0 = (acc[ai][bj][m][0] + *(const LAS f32x4*)(bl + cl + bj * HALF)) * DO_Q, v1 = (acc[ai][bj][m][1] + *(const LAS f32x4*)(bl + cl + bj * HALF + 4)) * DO_Q;
                    u32x2 w; w.x = pk4_fp8(v0[0], v0[1], v0[2], v0[3]); w.y = pk4_fp8(v1[0], v1[1], v1[2], v1[3]);
                    *(u32x2*)(rowp + bj * HALF) = w; } }
    }
};
}

namespace att {
constexpr int DQK = 192, DV = 128, NW = 8, QBLK = 32, KVBLK = 64;
constexpr int LDQ = 768, LDK = 768, LDV = 512, LDO = 1024;
constexpr float THR = 4.f;
constexpr int KROWB = 208;
constexpr int SHM_V = VT_TILE, SHM_K = KVBLK * KROWB;
constexpr int SHM_QR = 2 * SHM_V + 2 * SHM_K + NW * 64 * 4;
constexpr int SHM_ATTN = SHM_QR + NW * 4096;
#define KSWZ192(row, colB) ((row) * KROWB + (colB))
#define SBAR() __builtin_amdgcn_sched_barrier(0)
__device__ __forceinline__ int crow(int r, int hi) { return (r & 3) + 8 * (r >> 2) + 4 * hi; }
__device__ __forceinline__ float max3f(float a, float b, float c) { return fmaxf(fmaxf(a, b), c); }
__device__ __forceinline__ unsigned cvtpk(float lo, float hi) { unsigned r; asm volatile("v_cvt_pk_bf16_f32 %0, %1, %2" : "=v"(r) : "v"(lo), "v"(hi)); return r; }
constexpr float PSH = 3.f, THR2 = THR * 1.4426950408889634f;
__device__ __forceinline__ void partialSM(f32x16& p0, f32x16& p1, float& m_reg, float& alpha, const bool first) {
    float ma = max3f(p0[0], p0[1], p0[2]), mb = max3f(p0[3], p0[4], p0[5]), mc = max3f(p0[6], p0[7], p0[8]), md = max3f(p0[9], p0[10], p0[11]);
    ma = max3f(ma, p0[12], p0[13]); mb = max3f(mb, p0[14], p0[15]); mc = max3f(mc, p1[0], p1[1]); md = max3f(md, p1[2], p1[3]);
    ma = max3f(ma, p1[4], p1[5]); mb = max3f(mb, p1[6], p1[7]); mc = max3f(mc, p1[8], p1[9]); md = max3f(md, p1[10], p1[11]);
    ma = max3f(ma, p1[12], p1[13]); mb = max3f(mb, p1[14], p1[15]);
    float pmax = fmaxf(max3f(ma, mb, mc), md);
    { auto rr = __builtin_amdgcn_permlane32_swap(__float_as_uint(pmax), __float_as_uint(pmax), false, false);
      pmax = fmaxf(__uint_as_float(rr[0]), __uint_as_float(rr[1])); }
    const float u = pmax - PSH;
    if (__builtin_expect(!first && __all(u <= THR2), 1)) { alpha = 1.f; }
    else { const float dl = first ? u : fmaxf(u, 0.f); alpha = __builtin_amdgcn_exp2f(-dl); m_reg += dl;
#pragma unroll
        for (int r = 0; r < 16; ++r) { p0[r] -= dl; p1[r] -= dl; } }
#pragma unroll
    for (int r = 0; r < 16; ++r) p0[r] = __builtin_amdgcn_exp2f(p0[r]);
}
__device__ __forceinline__ void finishSM(f32x16& p0, f32x16& p1, float alpha, float& l_reg, v8i& pa) {
#pragma unroll
    for (int r = 0; r < 16; ++r) p1[r] = __builtin_amdgcn_exp2f(p1[r]);
    float sa = p0[0] + p0[1], sb = p0[2] + p0[3], sc = p0[4] + p0[5], sd = p0[6] + p0[7];
    sa += p0[8]; sb += p0[9]; sc += p0[10]; sd += p0[11]; sa += p0[12]; sb += p0[13]; sc += p0[14]; sd += p0[15];
#pragma unroll
    for (int r = 0; r < 16; r += 4) { sa += p1[r]; sb += p1[r + 1]; sc += p1[r + 2]; sd += p1[r + 3]; }
    float ps = (sa + sb) + (sc + sd);
    { auto rr = __builtin_amdgcn_permlane32_swap(__float_as_uint(ps), __float_as_uint(ps), false, false);
      ps = __uint_as_float(rr[0]) + __uint_as_float(rr[1]); }
    l_reg = l_reg * alpha + ps;
#pragma unroll
    for (int c = 0; c < 4; ++c) { pa[c] = (int)pk4_fp8(p0[4 * c], p0[4 * c + 1], p0[4 * c + 2], p0[4 * c + 3]);
        pa[4 + c] = (int)pk4_fp8(p1[4 * c], p1[4 * c + 1], p1[4 * c + 2], p1[4 * c + 3]); }
}
__device__ __forceinline__ void qkt(f32x16& p0, f32x16& p1, const float m_reg, const char* Ks, const v8i* q8, int r32, int hi) {
    { const float ini = PSH - m_reg;
#pragma unroll
      for (int r = 0; r < 16; ++r) { p0[r] = ini; p1[r] = ini; } }
#pragma unroll
    for (int ks = 0; ks < 3; ++ks) { const char* kp = Ks + r32 * KROWB + ks * 64 + hi * 32;
        const v8i a0 = __builtin_shufflevector(*reinterpret_cast<const v4i*>(kp), *reinterpret_cast<const v4i*>(kp + 16), 0, 1, 2, 3, 4, 5, 6, 7);
        const v8i a1 = __builtin_shufflevector(*reinterpret_cast<const v4i*>(kp + 32 * KROWB), *reinterpret_cast<const v4i*>(kp + 32 * KROWB + 16), 0, 1, 2, 3, 4, 5, 6, 7);
        p0 = __builtin_amdgcn_mfma_scale_f32_32x32x64_f8f6f4(a0, q8[ks], p0, 0, 0, 0, QK_E, 0, QC_E);
        p1 = __builtin_amdgcn_mfma_scale_f32_32x32x64_f8f6f4(a1, q8[ks], p1, 0, 0, 0, QK_E, 0, QC_E); }
}
__device__ __forceinline__ void pv_d0(f32x16* o, const char* Vs, const v8i pa, int r32, int hi) {
#pragma unroll
    for (int d0 = 0; d0 < 4; ++d0) { const char* vp = Vs + (d0 * 32 + r32) * VT_ROW + hi * 32;
        const v8i bv = __builtin_shufflevector(*reinterpret_cast<const v4i*>(vp), *reinterpret_cast<const v4i*>(vp + 16), 0, 1, 2, 3, 4, 5, 6, 7);
        o[d0] = __builtin_amdgcn_mfma_scale_f32_32x32x64_f8f6f4(pa, bv, o[d0], 0, 0, 0, PV_E, 0, PV_E); }
}
constexpr int ABUF = SHM_K + SHM_V;
constexpr int SHM_ATTN3 = 3 * ABUF + NW * 64 * 4;
__device__ __forceinline__ void attn_unit(const bf16_t* Qb, const unsigned char* Kh, const unsigned char* Vh, bf16_t* Ob, int seq, int cbase, int lbase, int t0, const f32x2* atab, char* lds, const int wave_s) {
    int tid_ = wave_s * 64 + lane_id(); asm volatile("" : "+v"(tid_));
    const int tid = tid_, wid = wave_s, lane = tid & 63, r32 = lane & 31, hi = lane >> 5;
    float* ws = (float*)(lds + 3 * ABUF) + wid * 64; float* li_l = ws; float* al_l = ws + 32;
    float m_reg = 0.f, l_reg = 0; f32x16 o[4] = {}; v8i qr[3];
    const bf16_t* Qw = Qb + (long)(wid * QBLK + r32) * LDQ + hi * 32;
#pragma unroll
    for (int ks = 0; ks < 3; ++ks) {
        float x[32];
#pragma unroll
        for (int c4 = 0; c4 < 4; ++c4) { const u32x4 w = *reinterpret_cast<const u32x4*>(Qw + ks * 64 + c4 * 8);
            x[8 * c4 + 0] = bflo(w.x); x[8 * c4 + 1] = bfhi(w.x); x[8 * c4 + 2] = bflo(w.y); x[8 * c4 + 3] = bfhi(w.y); x[8 * c4 + 4] = bflo(w.z); x[8 * c4 + 5] = bfhi(w.z); x[8 * c4 + 6] = bflo(w.w); x[8 * c4 + 7] = bfhi(w.w); }
        if (ks == 2 && t0 >= 0) { const int t = t0 + wid * QBLK + r32; const int pos = hi ? (t & 63) : (t >> 6); const f32x2* tb = atab + pos * 16;
#pragma unroll
            for (int f = 0; f < 16; ++f) { const f32x2 cs = tb[f]; const float a = x[2 * f], b = x[2 * f + 1]; x[2 * f] = a * cs.x - b * cs.y; x[2 * f + 1] = b * cs.x + a * cs.y; } }
        v8i q;
#pragma unroll
        for (int c = 0; c < 8; ++c) q[c] = (int)pk4_fp8(x[4 * c] * QC_Q, x[4 * c + 1] * QC_Q, x[4 * c + 2] * QC_Q, x[4 * c + 3] * QC_Q);
        qr[ks] = q; }
    unsigned kq[2];
#pragma unroll
    for (int i = 0; i < 2; ++i) { const int c = (i * 8 + wid) * 64 + lane; const int r = c / 13, cc = c % 13; kq[i] = (unsigned)((r < 64 ? r : 63) * LDK + (cc < 12 ? cc : 11) * 16); }
    const unsigned vq0 = (unsigned)(wid * 1024 + lane * 16);
    LAS unsigned char* ldsl = (LAS unsigned char*)(uintptr_t)(unsigned)(uintptr_t)lds;
#define DMA_TILE(jt, buf) do { const int kr_ = ((jt) < 4) ? cbase + 64 * (jt) : lbase + 64 * ((jt) - 4); const char* kp_ = (const char*)Kh + (size_t)kr_ * LDK; const char* vp_ = (const char*)Vh + (size_t)(jt) * VT_TILE + vq0; \
    LAS unsigned char* kb_ = ldsl + (buf) * ABUF + wid * 1024; LAS unsigned char* vb_ = kb_ + SHM_K; \
    __builtin_amdgcn_global_load_lds((const unsigned*)(kp_ + kq[0]), (LAS unsigned*)(kb_), 16, 0, 0); \
    if (wid < 5) __builtin_amdgcn_global_load_lds((const unsigned*)(kp_ + kq[1]), (LAS unsigned*)(kb_ + 8192), 16, 0, 0); \
    __builtin_amdgcn_global_load_lds((const unsigned*)(vp_), (LAS unsigned*)(vb_), 16, 0, 0); \
    if (wid < 2) __builtin_amdgcn_global_load_lds((const unsigned*)(vp_ + 8192), (LAS unsigned*)(vb_ + 8192), 16, 0, 0); } while (0)
#define WAITBAR() do { asm volatile("s_waitcnt vmcnt(0)" ::: "memory"); __syncthreads(); } while (0)
#define RESC(a) do { if (__any((a) < 1.f)) { if (hi == 0) al_l[r32] = (a); asm volatile("s_waitcnt lgkmcnt(0)" ::: "memory"); \
    _Pragma("unroll") for (int d = 0; d < 4; ++d) _Pragma("unroll") for (int r = 0; r < 16; ++r) o[d][r] *= al_l[crow(r, hi)]; } } while (0)
#define KBUF(b) (lds + (b) * ABUF)
#define VBASE(b) (lds + (b) * ABUF + SHM_K)
    f32x16 pA0, pA1, pB0, pB1; float alA, alB; v8i pa; const int NT = seq / KVBLK;
    DMA_TILE(0, 0); DMA_TILE(1, 1); WAITBAR();
    qkt(pA0, pA1, m_reg, KBUF(0), qr, r32, hi); partialSM(pA0, pA1, m_reg, alA, true);
    int bprev = 0, bj = 1;
    for (int j = 1; j + 1 < NT; j += 2) {
        { const int bn = 3 - bprev - bj; DMA_TILE(j + 1, bn);
          SBAR(); qkt(pB0, pB1, m_reg, KBUF(bj), qr, r32, hi);
          finishSM(pA0, pA1, alA, l_reg, pa); SBAR();
          pv_d0(o, VBASE(bprev), pa, r32, hi); partialSM(pB0, pB1, m_reg, alB, false);
          RESC(alB); WAITBAR(); bprev = bj; bj = bn; }
        { const int bn = 3 - bprev - bj; if (j + 2 < NT) DMA_TILE(j + 2, bn);
          SBAR(); qkt(pA0, pA1, m_reg, KBUF(bj), qr, r32, hi);
          finishSM(pB0, pB1, alB, l_reg, pa); SBAR();
          pv_d0(o, VBASE(bprev), pa, r32, hi); partialSM(pA0, pA1, m_reg, alA, false);
          RESC(alA); WAITBAR(); bprev = bj; bj = bn; }
    }
    SBAR(); qkt(pB0, pB1, m_reg, KBUF(bj), qr, r32, hi);
    finishSM(pA0, pA1, alA, l_reg, pa); SBAR();
    pv_d0(o, VBASE(bprev), pa, r32, hi); partialSM(pB0, pB1, m_reg, alB, false);
    RESC(alB);
    finishSM(pB0, pB1, alB, l_reg, pa); SBAR();
    pv_d0(o, VBASE(bj), pa, r32, hi);
    if (hi == 0) li_l[r32] = l_reg; asm volatile("s_waitcnt lgkmcnt(0)" ::: "memory");
    float rli[16];
#pragma unroll
    for (int r = 0; r < 16; ++r) rli[r] = 8.f * __builtin_amdgcn_rcpf(li_l[crow(r, hi)]);
    bf16_t* Ow = Ob + (long)(wid * QBLK) * LDO;
#pragma unroll
    for (int r = 0; r < 16; ++r) { const int orow = crow(r, hi);
#pragma unroll
        for (int d0 = 0; d0 < 4; ++d0) Ow[(long)orow * LDO + d0 * 32 + r32] = (bf16_t)f2bf(o[d0][r] * rli[r]); }
    __syncthreads();
#undef DMA_TILE
#undef WAITBAR
#undef RESC
#undef KBUF
#undef VBASE
}
}

struct Args { const float* in[28]; float* out; unsigned char* ws; int ph_lo, ph_hi; };
enum { I_X = 0, I_C, I_CTX, I_CCTX, I_ADAW, I_ADAB, I_WIN, I_QNG, I_KVNG, I_WUQ, I_WUKV, I_SGNG, I_SGNB, I_SGW, I_SGB, I_RDF, I_RDB, I_WO, I_LN1G, I_LN1B, I_RW, I_RB, I_WGU, I_BGU, I_WDN, I_BDN, I_LN2G, I_LN2B };

template <int QPERM>
__device__ __forceinline__ void transpose_item(const float* W, int K, int N, bf16_t* WT, LAS float* scr, int item, int lane) {
    const int nblk = N / 32, kb = item / nblk, nb = item % nblk, k0 = 64 * kb, n0 = 32 * nb;
#pragma unroll 8
    for (int i = 0; i < 32; ++i) { const int kk = 2 * i + (lane >> 5); scr[kk * 33 + (lane & 31)] = W[(size_t)(k0 + kk) * N + n0 + (lane & 31)]; }
    asm volatile("s_waitcnt lgkmcnt(0)" ::: "memory");
    const int c = lane & 7;
#pragma unroll
    for (int j = 0; j < 4; ++j) { const int n = (lane >> 3) + 8 * j; const LAS float* s = scr + (8 * c) * 33 + n;
        u32x4 o; o.x = pk2(s[0 * 33], s[1 * 33]); o.y = pk2(s[2 * 33], s[3 * 33]); o.z = pk2(s[4 * 33], s[5 * 33]); o.w = pk2(s[6 * 33], s[7 * 33]);
        int dn = n0 + n;
        if (QPERM == 1) { const int h = dn / 192, d = dn % 192; if (d >= 128) { const int jj = d - 128, a = jj >> 5, p = (jj >> 4) & 1, f = jj & 15; dn = h * 192 + 128 + 2 * (a * 16 + f) + p; } }
        if (QPERM == 2) { const int h = dn >> 8, j = dn & 255; dn = (j < 128) ? h * 128 + j : 512 + h * 128 + (j - 128); }
        *(u32x4*)(WT + (size_t)dn * K + k0 + 8 * c) = o; }
    asm volatile("s_waitcnt lgkmcnt(0)" ::: "memory");
}

__device__ __forceinline__ void transpose_item_fp8(const float* W, int K, int N, unsigned char* WT, float q, LAS float* scr, int item, int lane) {
    const int nblk = N / 32, kb = item / nblk, nb = item % nblk, k0 = 64 * kb, n0 = 32 * nb;
#pragma unroll 8
    for (int i = 0; i < 32; ++i) { const int kk = 2 * i + (lane >> 5); scr[kk * 33 + (lane & 31)] = W[(size_t)(k0 + kk) * N + n0 + (lane & 31)]; }
    asm volatile("s_waitcnt lgkmcnt(0)" ::: "memory");
    const int c = lane & 7;
#pragma unroll
    for (int j = 0; j < 4; ++j) { const int n = (lane >> 3) + 8 * j; const LAS float* s = scr + (8 * c) * 33 + n;
        u32x2 o; o.x = pk4_fp8(s[0 * 33] * q, s[1 * 33] * q, s[2 * 33] * q, s[3 * 33] * q); o.y = pk4_fp8(s[4 * 33] * q, s[5 * 33] * q, s[6 * 33] * q, s[7 * 33] * q);
        *(u32x2*)(WT + (size_t)(n0 + n) * K + k0 + 8 * c) = o; }
    asm volatile("s_waitcnt lgkmcnt(0)" ::: "memory");
}

__device__ __forceinline__ void transpose_item_fp8w(const float* W, int K, int N, unsigned char* WT, float q, LAS unsigned char* scr, int item, int lane) {
    const int nblk = N / 128, kb = item / nblk, nb = item % nblk, k0 = 64 * kb, n0 = 128 * nb;
    const int l5 = lane & 31, h = lane >> 5;
    const float* src = W + (size_t)(k0 + 16 * h) * N + n0 + 4 * l5;
#pragma unroll
    for (int b = 0; b < 2; ++b) {
        f32x4 x[16];
#pragma unroll
        for (int s_ = 0; s_ < 16; ++s_) x[s_] = *(const f32x4*)(src + (size_t)(32 * b + s_) * N);
#pragma unroll
        for (int i = 0; i < 4; ++i) {
            u32x4 o;
            o.x = pk4_fp8(x[0][i] * q, x[1][i] * q, x[2][i] * q, x[3][i] * q); o.y = pk4_fp8(x[4][i] * q, x[5][i] * q, x[6][i] * q, x[7][i] * q);
            o.z = pk4_fp8(x[8][i] * q, x[9][i] * q, x[10][i] * q, x[11][i] * q); o.w = pk4_fp8(x[12][i] * q, x[13][i] * q, x[14][i] * q, x[15][i] * q);
            *(LAS u32x4*)(scr + (l5 + 32 * i) * 80 + (2 * b + h) * 16) = o; }
    }
    asm volatile("s_waitcnt lgkmcnt(0)" ::: "memory");
#pragma unroll
    for (int qd = 0; qd < 8; ++qd) {
        const int rho = 16 * qd + (lane >> 2), piece = lane & 3;
        const u32x4 o = *(const LAS u32x4*)(scr + rho * 80 + piece * 16);
        const int nl = 4 * (rho & 31) + (rho >> 5);
        *(u32x4*)(WT + (size_t)(n0 + nl) * K + k0 + piece * 16) = o; }
    asm volatile("s_waitcnt lgkmcnt(0)" ::: "memory");
}

__global__ void __launch_bounds__(512, 2) mega(Args a) {
    extern __shared__ __attribute__((aligned(16))) unsigned char lds_raw[];
    LAS unsigned char* lds = (LAS unsigned char*)lds_raw;
    const int G = gridDim.x, bx = blockIdx.x;
    const int wave_s = __builtin_amdgcn_readfirstlane(threadIdx.x >> 6);
    const int vcu = (G % 8 == 0) ? (bx % 8) * (G / 8) + bx / 8 : bx;
    const int NGW = G * 8;
#define PH_IDS() int lane_ = lane_id(); asm volatile("" : "+v"(lane_)); const int lane = lane_; const int wave = wave_s; const int tid = wave * 64 + lane; const int gw = vcu * 8 + wave; (void)lane; (void)gw; (void)tid
    unsigned char* ws = a.ws;
    unsigned* ctl = (unsigned*)(ws + WS_CTL);
    volatile LAS unsigned* MISC = (volatile LAS unsigned*)(lds + MISC_OFF);
    for (int u = threadIdx.x; u < (LDS_BYTES - RING_BYTES) / 4; u += 512) ((LAS unsigned*)(lds + RING_BYTES))[u] = 0u;
    __syncthreads();
    const int lo = a.ph_lo, hi = a.ph_hi;
    XcdBarrier bar; bar.bar = ctl + CW_BAR; bar.x = 0; bar.st = MISC + 8;
    if (hi - lo > 1) bar = xcd_barrier_post(ctl + CW_BAR, MISC + 8);
    bar.wave = wave_s;
#ifndef MK_ONLY
#define MK_ONLY -1
#endif
#ifndef MK_MASK
#define MK_MASK 0xFFF
#endif
#define EN(q) ((MK_ONLY < 0 || MK_ONLY == (q)) && ((MK_MASK >> (q)) & 1))
#ifndef MK_REP_PHASE
#define MK_REP_PHASE -1
#endif
#ifndef MK_REP_N
#define MK_REP_N 1
#endif
#define REPS(q) ((MK_REP_PHASE == (q)) ? MK_REP_N : 1)
#ifndef MK_SUB
#define MK_SUB 15
#endif
#define SUB(m) ((MK_SUB & (m)) != 0)
#define XROW0(n_) (((n_) < NCTX) ? a.in[I_CTX] + (size_t)(n_) * DM : a.in[I_X] + (size_t)((n_) - NCTX) * DM)
#define XLOAD(dst_, l_, n_, j_) do { if ((l_) == 0) dst_ = *((const f32x4*)XROW0(n_) + lane + 64 * (j_)); else { const u32x2 w_ = *((const u32x2*)(XRB + (size_t)(n_) * DM) + lane + 64 * (j_)); dst_ = (f32x4){__uint_as_float(w_.x), __uint_as_float(w_.y), 0.f, 0.f}; } } while (0)
#define XVAL(src_, l_) (((l_) == 0) ? (src_) : (f32x4){bflo(__float_as_uint((src_).x)), bfhi(__float_as_uint((src_).x)), bflo(__float_as_uint((src_).y)), bfhi(__float_as_uint((src_).y))})
#define IN(k) (lo <= (k) && (k) < hi)
#define SEAM(k) do { if (IN(k) && IN((k) + 1)) xcd_barrier(bar); } while (0)

    float* MOD = (float*)(ws + WS_MOD);
    f32x2* ATAB = (f32x2*)(ws + WS_ATAB);
    f32x2* RTAB = (f32x2*)(ws + WS_RTAB);
    unsigned char* WIN8 = ws + WS_WIN; bf16_t* WUQ = (bf16_t*)(ws + WS_WUQ); bf16_t* WUKV = (bf16_t*)(ws + WS_WUKV); bf16_t* WOT = (bf16_t*)(ws + WS_WO);
    unsigned char* WGU = ws + WS_WGU; unsigned char* WDN = ws + WS_WDN; unsigned char* XH8 = ws + WS_XH8; bf16_t* SGWB = (bf16_t*)(ws + WS_SGWB);
    bf16_t* XRB = (bf16_t*)(ws + WS_XRES); unsigned char* XHF = ws + WS_XH; bf16_t* PROJ = (bf16_t*)(ws + WS_PROJ);
    bf16_t* CQN = (bf16_t*)(ws + WS_CQN); bf16_t* CKVN = (bf16_t*)(ws + WS_CKVN);
    bf16_t* QB = (bf16_t*)(ws + WS_QB); unsigned char* KB = ws + WS_KB; unsigned char* VT8 = ws + WS_VB;
    float* SLOC = (float*)(ws + WS_SGU); float* SIN = (float*)(ws + WS_SGV);
    float* RQ = (float*)(ws + WS_RQ); float* RK = (float*)(ws + WS_RK); float* OF = (float*)(ws + WS_OF); float* OB = (float*)(ws + WS_OB);
    bf16_t* MIX = (bf16_t*)(ws + WS_MIX); bf16_t* YB = (bf16_t*)(ws + WS_Y);
    int* TOPI = (int*)(ws + WS_TOPI); float* GATE = (float*)(ws + WS_GATE); int* DEST = (int*)(ws + WS_DEST); int* ROWTOK = (int*)(ws + WS_ROWTOK);
    unsigned char* ACT = ws + WS_ACT; unsigned char* DOUT = ws + WS_DOUT;

    constexpr int IT_IN = 16 * 62, IT_UQ = 6 * 24, IT_UKV = 4 * 32, IT_O = 16 * 32, IT_SMALL = IT_IN + IT_UQ + IT_UKV + IT_O, IT_GU = 16 * 16, IT_DN = 16 * 8;
    constexpr int IT_LAYER = IT_SMALL + 32 * IT_GU + 32 * IT_DN;
#define CONVERT_ITEM(L_, it_) do { int r_ = (it_); const int cl_ = (L_); \
        if (r_ < IT_IN) { transpose_item_fp8(a.in[I_WIN] + (size_t)cl_ * 1024 * 1984, 1024, 1984, WIN8 + (size_t)cl_ * 2048 * 1024, WGU_Q, scr, r_, lane); break; } r_ -= IT_IN; \
        if (r_ < IT_UQ) { transpose_item<1>(a.in[I_WUQ] + (size_t)cl_ * 384 * 768, 384, 768, WUQ + (size_t)cl_ * 768 * 384, scr, r_, lane); break; } r_ -= IT_UQ; \
        if (r_ < IT_UKV) { transpose_item<2>(a.in[I_WUKV] + (size_t)cl_ * 256 * 1024, 256, 1024, WUKV + (size_t)cl_ * 1024 * 256, scr, r_, lane); break; } r_ -= IT_UKV; \
        if (r_ < IT_O) { transpose_item<0>(a.in[I_WO] + (size_t)cl_ * 1024 * 1024, 1024, 1024, WOT + (size_t)cl_ * 1024 * 1024, scr, r_, lane); break; } r_ -= IT_O; \
        if (r_ < 32 * IT_GU) { const int mtx_ = cl_ * 32 + r_ / IT_GU; r_ %= IT_GU; transpose_item_fp8w(a.in[I_WGU] + (size_t)mtx_ * 1024 * 2048, 1024, 2048, WGU + (size_t)mtx_ * 2048 * 1024, WGU_Q, (LAS unsigned char*)scr, r_, lane); break; } r_ -= 32 * IT_GU; \
        { const int mtx_ = cl_ * 32 + r_ / IT_DN; r_ %= IT_DN; transpose_item_fp8w(a.in[I_WDN] + (size_t)mtx_ * 1024 * 1024, 1024, 1024, WDN + (size_t)mtx_ * 1024 * 1024, WDN_Q, (LAS unsigned char*)scr, r_, lane); } } while (0)

    for (int rep_ = 0; rep_ < REPS(10); ++rep_) if (EN(10) && IN(0)) { PH_IDS();
        {
            LAS float* sc = (LAS float*)lds;
            LAS float* red = (LAS float*)(lds + 20480);
            { float cv_[10];
#pragma unroll
              for (int u_ = 0; u_ < 10; ++u_) { const int i = tid + 512 * u_; const int s = i >> 10, k = i & 1023; cv_[u_] = (s < 4) ? a.in[I_C][s * 1024 + k] : a.in[I_CCTX][k]; }
#pragma unroll
              for (int u_ = 0; u_ < 10; ++u_) sc[tid + 512 * u_] = cv_[u_] * sigmoidf_(cv_[u_]); }
            __syncthreads();
            for (int it = bx; it < 4 * 96; it += G) {
                const int l = it / 96, j0 = (it % 96) * 64;
                const float* wp = a.in[I_ADAW] + (size_t)l * 1024 * 6144 + j0 + lane;
                float s0 = 0, s1 = 0, s2 = 0, s3 = 0, s4 = 0;
#pragma unroll 8
                for (int kk = 0; kk < 128; ++kk) { const int k = wave * 128 + kk; const float w = wp[(size_t)k * 6144];
                    s0 += sc[k] * w; s1 += sc[1024 + k] * w; s2 += sc[2048 + k] * w; s3 += sc[3072 + k] * w; s4 += sc[4096 + k] * w; }
                red[(wave * 5 + 0) * 64 + lane] = s0; red[(wave * 5 + 1) * 64 + lane] = s1; red[(wave * 5 + 2) * 64 + lane] = s2; red[(wave * 5 + 3) * 64 + lane] = s3; red[(wave * 5 + 4) * 64 + lane] = s4;
                __syncthreads();
                if (tid < 320) { const int s = tid >> 6, jl = tid & 63; float v = 0;
#pragma unroll
                    for (int w = 0; w < 8; ++w) v += red[(w * 5 + s) * 64 + jl];
                    MOD[((size_t)l * 5 + s) * 6144 + j0 + jl] = v + a.in[I_ADAB][l * 6144 + j0 + jl]; }
                __syncthreads();
            }
        }
        for (int i = bx * 512 + tid; i < 128 * 16; i += G * 512) { float s, c; sincos_d((double)(i >> 4) * INV_A[i & 15], s, c); ATAB[i] = (f32x2){c, s}; }
        for (int i = bx * 512 + tid; i < KEYS * 16; i += G * 512) { float s, c; sincos_d((double)(i >> 4) * INV_R[i & 15], s, c); RTAB[i] = (f32x2){c, s}; }
        for (int i = bx * 512 + tid; i < 4 * 4 * 128 * 128 / 4; i += G * 512) { const f32x4 w = *((const f32x4*)a.in[I_SGW] + i); u32x2 o; o.x = pk2(w.x, w.y); o.y = pk2(w.z, w.w); *((u32x2*)SGWB + i) = o; }
        for (int i = bx * 512 + tid; i < 4 * 64 * 1024 / 16; i += G * 512) { const int l = i / (64 * 1024 / 16), r = i % (64 * 1024 / 16);
            *(u32x4*)(WIN8 + ((size_t)l * 2048 + 1984) * 1024 + (size_t)r * 16) = (u32x4){0u, 0u, 0u, 0u}; }
        {
            __syncthreads();
            LAS float* scr = (LAS float*)(lds + wave * 16384);
            for (int it = gw; it < IT_LAYER; it += NGW) CONVERT_ITEM(0, it);
            __syncthreads();
        }
    }
    SEAM(0);
    if (EN(11) && IN(1)) { PH_IDS();
        for (int n = gw; n < NTOK; n += 2 * NGW) {
            const int nn[2] = {n, (n + NGW < NTOK) ? n + NGW : n};
            f32x4 xv_[2][4], sh_[2][4], sc_[2][4];
#pragma unroll
            for (int t = 0; t < 2; ++t) { const float* md = MOD + (size_t)modset(nn[t]) * 6144; const f32x4* xr = (const f32x4*)XROW0(nn[t]) + lane;
#pragma unroll
                for (int j = 0; j < 4; ++j) { xv_[t][j] = xr[64 * j]; sh_[t][j] = *((const f32x4*)(md) + lane + 64 * j); sc_[t][j] = *((const f32x4*)(md + 1024) + lane + 64 * j); } }
#pragma unroll
            for (int t = 0; t < 2; ++t) { unsigned* o8 = (unsigned*)(XHF + (size_t)nn[t] * DM) + lane;
#pragma unroll
                for (int j = 0; j < 4; ++j) { const f32x4 v = xv_[t][j], sh = sh_[t][j], scl = sc_[t][j];
                    o8[64 * j] = pk4_fp8((v.x * (1.f + scl.x) + sh.x) * ACT_Q, (v.y * (1.f + scl.y) + sh.y) * ACT_Q, (v.z * (1.f + scl.z) + sh.z) * ACT_Q, (v.w * (1.f + scl.w) + sh.w) * ACT_Q); } }
        }
    }
    SEAM(1);

#pragma unroll 1
    for (int l = 0; l < NLAYER; ++l) {
        const int pb = 2 + 10 * l;
        const float* MODL = MOD + (size_t)l * 5 * 6144;
        for (int rep_ = 0; rep_ < REPS(0); ++rep_) if (EN(0) && IN(pb + 0)) { PH_IDS();
            pg8::Gemm g{XHF, WIN8 + (size_t)l * 2048 * 1024, 1024, 1024, nullptr, ACT_E, WGU_E};
            pg8::StaticOrder S; S.init(NTOK / 256, PROJW / 256, G, bx);
            pg8::EpiBf16 E{PROJ, PROJW};
            pg8::gemm_phase<pg8::EpiBf16, pg8::StaticOrder, false, true>(lds, g, S, E, wave_s);
        }
        SEAM(pb + 0);
        for (int rep_ = 0; rep_ < REPS(1); ++rep_) if (EN(1) && IN(pb + 1)) { PH_IDS();
            const float* qg = a.in[I_QNG] + l * 384; const float* kvg = a.in[I_KVNG] + l * 256;
            const float* sgg = a.in[I_SGNG] + l * 256; const float* sgb = a.in[I_SGNB] + l * 256;
            const float* sb = a.in[I_SGB] + l * 4 * 128;
            LAS float* ksr = (LAS float*)lds;
            LAS bf16_t* vsT = (LAS bf16_t*)(lds + 65536);
            constexpr int VST = 136;
            for (int T = vcu; T < NTOK / 128; T += G) {
                const int n0 = T * 128;
                float qgv[6];
#pragma unroll
                for (int j = 0; j < 3; ++j) { qgv[2 * j] = qg[lane * 2 + 128 * j]; qgv[2 * j + 1] = qg[lane * 2 + 128 * j + 1]; }
                const f32x4 kvgv = *(const f32x4*)(kvg + lane * 4), sggv = *(const f32x4*)(sgg + lane * 4), sgbv = *(const f32x4*)(sgb + lane * 4);
                const bool kvonly = (l == NLAYER - 1) && (n0 < NCTX);
                __syncthreads();
                for (int hb = 0; hb < 2; ++hb) {
                    unsigned cqw[8][3]; u32x2 ckw[8], sgw[8]; unsigned short krw[8], q1w[8], q2w[8], k1w[8], k2w[8]; f32x2 rcs[8], acs[8];
#pragma unroll
                    for (int k = 0; k < 8; ++k) {
                        const int n = n0 + wave * 16 + hb * 8 + k;
                        const bf16_t* pr = PROJ + (size_t)n * PROJW;
                        const bool lat = n >= NCTX; const int t = (n - NCTX) & 8191; const int upos = lat ? CTXL + t : (n & 255);
#pragma unroll
                        for (int j = 0; j < 3; ++j) cqw[k][j] = *(const unsigned*)(pr + C_CQ + lane * 2 + 128 * j);
                        ckw[k] = *(const u32x2*)(pr + C_CKV + lane * 4); sgw[k] = *(const u32x2*)(pr + C_SGV + lane * 4);
                        krw[k] = pr[C_KR + lane];
                        { const int h = lane >> 4, i = lane & 15; q1w[k] = pr[C_RQ + h * 32 + i]; q2w[k] = pr[C_RQ + h * 32 + 16 + i]; k1w[k] = pr[C_RK + h * 32 + i]; k2w[k] = pr[C_RK + h * 32 + 16 + i]; rcs[k] = RTAB[upos * 16 + i]; }
                        { const int aa = lane >> 5, f = lane & 15; const int pos = lat ? (aa ? (t & 63) : (t >> 6)) : 0; acs[k] = ATAB[pos * 16 + f]; }
                    }
                    __builtin_amdgcn_sched_barrier(0);
#pragma unroll
                    for (int k = 0; k < 8; ++k) {
                        __builtin_amdgcn_sched_barrier(0);
                        const int tl = wave * 16 + hb * 8 + k, n = n0 + tl;
                        if (!kvonly) {
                            float v[6]; float ss = 0;
#pragma unroll
                            for (int j = 0; j < 3; ++j) { const unsigned w = cqw[k][j]; v[2 * j] = bflo(w); v[2 * j + 1] = bfhi(w); ss += v[2 * j] * v[2 * j] + v[2 * j + 1] * v[2 * j + 1]; }
                            const float rs = rsqrtf(wave_sum(ss) * (1.f / 384.f) + RMS_EPS);
#pragma unroll
                            for (int j = 0; j < 3; ++j) { const int c = lane * 2 + 128 * j; *(unsigned*)(CQN + (size_t)n * 384 + c) = pk2(v[2 * j] * rs * qgv[2 * j], v[2 * j + 1] * rs * qgv[2 * j + 1]); }
                        }
                        {
                            const u32x2 w = ckw[k];
                            const float v0 = bflo(w.x), v1 = bfhi(w.x), v2 = bflo(w.y), v3 = bfhi(w.y);
                            const float rs = rsqrtf(wave_sum(v0 * v0 + v1 * v1 + v2 * v2 + v3 * v3) * (1.f / 256.f) + RMS_EPS);
                            const f32x4 gg = kvgv;
                            u32x2 o; o.x = pk2(v0 * rs * gg.x, v1 * rs * gg.y); o.y = pk2(v2 * rs * gg.z, v3 * rs * gg.w);
                            *(u32x2*)(CKVN + (size_t)n * 256 + lane * 4) = o;
                        }
                        {
                            const float x = bf2f(krw[k]); const float xp = __shfl_xor(x, 16);
                            const int aa = lane >> 5, p = (lane >> 4) & 1, f = lane & 15; const f32x2 cs = acs[k];
                            const float o = p ? (x * cs.x + xp * cs.y) : (x * cs.x - xp * cs.y);
                            const int dd = 128 + 2 * (aa * 16 + f) + p; const unsigned char ob = (unsigned char)(pk4_fp8(o * QK_Q, 0.f, 0.f, 0.f) & 0xffu);
                            unsigned char* kd = KB + (size_t)n * 768 + dd;
                            kd[0] = ob; kd[192] = ob; kd[384] = ob; kd[576] = ob;
                        }
                        if (!kvonly) {
                            const u32x2 w = sgw[k];
                            float v0 = gelu1(bflo(w.x)), v1 = gelu1(bfhi(w.x)), v2 = gelu1(bflo(w.y)), v3 = gelu1(bfhi(w.y));
                            const float mean = wave_sum(v0 + v1 + v2 + v3) * (1.f / 256.f);
                            v0 -= mean; v1 -= mean; v2 -= mean; v3 -= mean;
                            const float rs = rsqrtf(wave_sum(v0 * v0 + v1 * v1 + v2 * v2 + v3 * v3) * (1.f / 256.f) + LN_EPS);
                            const f32x4 gg = sggv, bb = sgbv;
                            LAS bf16_t* vd = vsT + (lane * 4) * VST + tl;
                            vd[0] = (bf16_t)f2bf(v0 * rs * gg.x + bb.x); vd[VST] = (bf16_t)f2bf(v1 * rs * gg.y + bb.y); vd[2 * VST] = (bf16_t)f2bf(v2 * rs * gg.z + bb.z); vd[3 * VST] = (bf16_t)f2bf(v3 * rs * gg.w + bb.w);
                        }
                        {
                            const int h = lane >> 4, i = lane & 15; const f32x2 cs = rcs[k];
                            if (!kvonly) { const float q1 = bf2f(q1w[k]), q2 = bf2f(q2w[k]);
                                RQ[(size_t)n * 128 + h * 32 + i] = (q1 * cs.x - q2 * cs.y) * RET_QSCALE; RQ[(size_t)n * 128 + h * 32 + 16 + i] = (q2 * cs.x + q1 * cs.y) * RET_QSCALE; }
                            const float k1 = bf2f(k1w[k]), k2 = bf2f(k2w[k]);
                            const float ka = k1 * cs.x - k2 * cs.y, kb = k2 * cs.x + k1 * cs.y;
                            RK[(size_t)n * 128 + h * 32 + i] = ka; RK[(size_t)n * 128 + h * 32 + 16 + i] = kb;
                            ksr[tl * 128 + h * 32 + i] = ka; ksr[tl * 128 + h * 32 + 16 + i] = kb;
                        }
                    }
                }
                __syncthreads();
                {
                    const int h = wave >> 1, dir = wave & 1, hi = lane >> 5, il = lane & 31;
                    const float logit = a.in[dir ? I_RDB : I_RDF][l * 4 + h];
                    const float lg2 = log2f(1.f / (1.f + expf(-logit)));
                    f32x16 acc0 = {}, acc1 = {};
                    const bf16_t* vp = PROJ + (size_t)n0 * PROJW + C_RV + h * 64 + 2 * il;
                    for (int sb = 0; sb < 4; ++sb) {
                        unsigned bw[16];
#pragma unroll
                        for (int s = 0; s < 16; ++s) { const int tok = 2 * (sb * 16 + s) + hi; bw[s] = *(const unsigned*)(vp + (size_t)tok * PROJW); }
#pragma unroll
                        for (int s = 0; s < 16; ++s) { const int tok = 2 * (sb * 16 + s) + hi;
                            const float fac = __builtin_amdgcn_exp2f(lg2 * (float)(dir ? tok : 127 - tok));
                            const float av = ksr[tok * 128 + h * 32 + il] * fac;
                            acc0 = __builtin_amdgcn_mfma_f32_32x32x2f32(av, bflo(bw[s]), acc0, 0, 0, 0);
                            acc1 = __builtin_amdgcn_mfma_f32_32x32x2f32(av, bfhi(bw[s]), acc1, 0, 0, 0); }
                    }
                    float* so = SLOC + ((size_t)(T * 2 + dir) * 4 + h) * 2048 + 2 * il;
#pragma unroll
                    for (int r = 0; r < 16; ++r) { const int d = (r & 3) + 8 * (r >> 2) + 4 * hi; *(f32x2*)(so + d * 64) = (f32x2){acc0[r], acc1[r]}; }
                }
                if (!kvonly) {
                    const int g = wave >> 1, mh = wave & 1, hi = lane >> 5, il = lane & 31, c0 = g * 64 + 2 * il;
                    bf16x8 bfr[2][8];
#pragma unroll
                    for (int e = 0; e < 2; ++e)
#pragma unroll
                        for (int kk = 0; kk < 8; ++kk) bfr[e][kk] = *(const LAS bf16x8*)(vsT + (c0 + e) * VST + kk * 16 + hi * 8);
                    const bf16_t* wg = SGWB + ((size_t)(l * 4 + g) * 128) * 128;
                    for (int mt = 2 * mh; mt < 2 * mh + 2; ++mt) {
                        f32x16 acc0 = {}, acc1 = {};
                        const bf16_t* wr = wg + (size_t)(mt * 32 + il) * 128 + hi * 8;
#pragma unroll
                        for (int kk = 0; kk < 8; ++kk) { const bf16x8 af = *(const bf16x8*)(wr + kk * 16); acc0 = __builtin_amdgcn_mfma_f32_32x32x16_bf16(af, bfr[0][kk], acc0, 0, 0, 0); acc1 = __builtin_amdgcn_mfma_f32_32x32x16_bf16(af, bfr[1][kk], acc1, 0, 0, 0); }
#pragma unroll
                        for (int rb = 0; rb < 16; rb += 8) {
                            unsigned uw_[8];
#pragma unroll
                            for (int r8 = 0; r8 < 8; ++r8) { const int r = rb + r8; const int p = mt * 32 + (r & 3) + 8 * (r >> 2) + 4 * hi; uw_[r8] = *(const unsigned*)(PROJ + (size_t)(n0 + p) * PROJW + C_SGU + c0); }
#pragma unroll
                            for (int r8 = 0; r8 < 8; ++r8) { const int r = rb + r8; const int p = mt * 32 + (r & 3) + 8 * (r >> 2) + 4 * hi; const float sbp = sb[g * 128 + p];
                                *(unsigned*)(MIX + (size_t)(n0 + p) * DM + 512 + c0) = pk2(gelu1(bflo(uw_[r8])) * (acc0[r] + sbp), gelu1(bfhi(uw_[r8])) * (acc1[r] + sbp)); }
                        }
                    }
                }
            }
            __syncthreads();
            if (l + 1 < NLAYER && vcu >= 8) {
                LAS float* scr = (LAS float*)(lds + wave * 16384);
                for (int it = (vcu - 8) * 8 + wave; it < IT_LAYER / 2; it += (G - 8) * 8) CONVERT_ITEM(l + 1, it);
            }
            __syncthreads();
        }
        SEAM(pb + 1);
        for (int rep_ = 0; rep_ < REPS(2); ++rep_) if (EN(2) && IN(pb + 2)) { PH_IDS();
            if (tid < 256) {
                for (int E = bx * 256 + tid; E < 65536; E += G * 256) {
                    const int v = E & 63, d = (E >> 6) & 31, h = (E >> 11) & 3, dir = (E >> 13) & 1, b = E >> 14;
                    const float logit = a.in[dir ? I_RDB : I_RDF][l * 4 + h];
                    const float g128 = __builtin_amdgcn_exp2f(128.f * log2f(1.f / (1.f + expf(-logit))));
                    float S = 0.f;
#pragma unroll
                    for (int c = 0; c < 66; ++c) {
                        int T;
                        if (dir == 0) T = (c < 2) ? b * 2 + c : 8 + b * 64 + (c - 2);
                        else T = (c < 2) ? b * 2 + (1 - c) : 8 + b * 64 + (63 - (c - 2));
                        const size_t idx = ((size_t)(T * 2 + dir) * 4 + h) * 2048 + d * 64 + v;
                        const float x = SLOC[idx]; SIN[idx] = S; S = g128 * S + x;
                    }
                }
            }
            {
                pg8::Gemm g{CQN, WUQ + (size_t)l * 768 * 384, 384, 384, nullptr, 0, 0};
                pg8::StaticOrder S; S.init(NTOK / 256, 3, G, bx);
                pg8::EpiBf16 E{QB, 768};
                pg8::gemm_phase<pg8::EpiBf16, pg8::StaticOrder, false>(lds, g, S, E, wave_s);
            }
            {
                pg8::Gemm g{CKVN, WUKV + (size_t)l * 1024 * 256, 256, 256, nullptr, 0, 0};
                const int rot1 = (G * 9 / 16) & ~7;
                pg8::StaticOrder S; S.init(NTOK / 256, 2, G, (bx + G - rot1) % G);
                pg8::EpiK E{KB};
                pg8::gemm_phase<pg8::EpiK, pg8::StaticOrder, false>(lds, g, S, E, wave_s);
            }
            {
                pg8::Gemm g{WUKV + (size_t)l * 1024 * 256 + 512 * 256, CKVN, 256, 256, nullptr, 0, 0};
                const int rot2 = ((G * 9 / 16) & ~7) + 8;
                pg8::StaticOrder S; S.init(2, NTOK / 256, G, (bx + G - rot2) % G);
                pg8::EpiVT E{VT8};
                pg8::gemm_phase<pg8::EpiVT, pg8::StaticOrder, false>(lds, g, S, E, wave_s);
            }
        }
        SEAM(pb + 2);
        for (int rep_ = 0; rep_ < REPS(3); ++rep_) if (EN(3) && IN(pb + 3)) { PH_IDS();
            for (int rnd = 0; rnd < 3; ++rnd) {
                int b, h, qrow0, seq, t0;
                if (rnd < 2) { const int u = rnd * G + vcu; if (u >= 512) continue; const int bh = u >> 5, qb = u & 31; b = bh >> 2; h = bh & 3; qrow0 = NCTX + b * SEQ + qb * 256; seq = KEYS; t0 = qb * 256; }
                else { const int k = vcu - 16; if (k < 0 || k >= 16 || l == NLAYER - 1) continue; b = k >> 2; h = k & 3; qrow0 = b * CTXL; seq = CTXL; t0 = -1; }
                att::attn_unit(QB + ((size_t)qrow0 * 768 + h * 192), KB + h * 192, VT8 + (size_t)((b * 4 + h) * (KEYS / 64)) * VT_TILE, MIX + ((size_t)qrow0 * DM + h * 128), seq, b * CTXL, NCTX + b * SEQ, t0, ATAB, (char*)lds_raw, wave_s);
            }
            {
                LAS float* qs = (LAS float*)lds;
                LAS float* ks = (LAS float*)(lds + 33792);
                LAS bf16_t* vs = (LAS bf16_t*)(lds + 67584);
                const int hl = wave >> 2, dir = (wave >> 1) & 1, half = wave & 1, hi = lane >> 5, il = lane & 31;
                for (int T = vcu; T < NTOK / 128; T += G) {
                    if (l == NLAYER - 1 && T < NCTX / 128) continue;
                    const int n0 = T * 128;
                    for (int pass = 0; pass < 2; ++pass) {
                        const int h = pass * 2 + hl;
                        __syncthreads();
                        {
                            f32x4 qv_[4], kv_[4]; u32x4 vv_[4];
#pragma unroll
                            for (int u_ = 0; u_ < 4; ++u_) { const int i = tid + 512 * u_; const int tok = i >> 4, part = i & 15;
                                qv_[u_] = *(const f32x4*)(RQ + (size_t)(n0 + tok) * 128 + pass * 64 + part * 4); kv_[u_] = *(const f32x4*)(RK + (size_t)(n0 + tok) * 128 + pass * 64 + part * 4);
                                vv_[u_] = *(const u32x4*)(PROJ + (size_t)(n0 + tok) * PROJW + C_RV + pass * 128 + part * 8); }
#pragma unroll
                            for (int u_ = 0; u_ < 4; ++u_) { const int i = tid + 512 * u_; const int tok = i >> 4, part = i & 15, hh = part >> 3, d0 = (part & 7) * 4;
                                const f32x4 qv = qv_[u_], kv = kv_[u_];
                                LAS float* qd = qs + (hh * 128 + tok) * 33 + d0; LAS float* kd = ks + (hh * 128 + tok) * 33 + d0;
                                qd[0] = qv.x; qd[1] = qv.y; qd[2] = qv.z; qd[3] = qv.w; kd[0] = kv.x; kd[1] = kv.y; kd[2] = kv.z; kd[3] = kv.w;
                                *(LAS u32x4*)(vs + tok * 128 + part * 8) = vv_[u_]; }
                        }
                        __syncthreads();
                        const float logit = a.in[dir ? I_RDB : I_RDF][l * 4 + h];
                        const float lg2 = log2f(1.f / (1.f + expf(-logit)));
                        float sinv0[16], sinv1[16];
                        { const float* sp = SIN + ((size_t)(T * 2 + dir) * 4 + h) * 2048 + il;
#pragma unroll
                          for (int s = 0; s < 16; ++s) { sinv0[s] = sp[(2 * s + hi) * 64]; sinv1[s] = sp[(2 * s + hi) * 64 + 32]; } }
                        float* OUT = dir ? OB : OF;
                        for (int ii = 0; ii < 2; ++ii) {
                            const int I = half ? (ii ? 2 : 1) : (ii ? 3 : 0);
                            const int ipos = 32 * I + il, itok = dir ? 127 - ipos : ipos;
                            const LAS float* qrow = qs + (hl * 128 + itok) * 33 + hi;
                            f32x16 acc0 = {}, acc1 = {};
#pragma unroll
                            for (int s = 0; s < 16; ++s) { const float bq = qrow[2 * s];
                                acc0 = __builtin_amdgcn_mfma_f32_32x32x2f32(sinv0[s], bq, acc0, 0, 0, 0);
                                acc1 = __builtin_amdgcn_mfma_f32_32x32x2f32(sinv1[s], bq, acc1, 0, 0, 0); }
                            { const float cf = __builtin_amdgcn_exp2f(lg2 * (float)(ipos + 1));
#pragma unroll
                              for (int r = 0; r < 16; ++r) { acc0[r] *= cf; acc1[r] *= cf; } }
                            for (int J = 0; J <= I; ++J) {
                                const int jposA = 32 * J + il, jtokA = dir ? 127 - jposA : jposA;
                                const LAS float* krow = ks + (hl * 128 + jtokA) * 33 + hi;
                                f32x16 pt = {};
#pragma unroll
                                for (int s = 0; s < 16; ++s) pt = __builtin_amdgcn_mfma_f32_32x32x2f32(krow[2 * s], qrow[2 * s], pt, 0, 0, 0);
#pragma unroll
                                for (int r = 0; r < 16; ++r) { const int jl = (r & 3) + 8 * (r >> 2) + 4 * hi;
                                    const bool keep = (J < I) || (dir ? (il > jl) : (il >= jl));
                                    const float fac = __builtin_amdgcn_exp2f(lg2 * (float)(32 * (I - J) + il - jl));
                                    pt[r] = keep ? pt[r] * fac : 0.f; }
#pragma unroll
                                for (int r = 0; r < 16; ++r) { const int jpos = 32 * J + (r & 3) + 8 * (r >> 2) + 4 * hi, jtok = dir ? 127 - jpos : jpos;
                                    const float a0 = bf2f(vs[jtok * 128 + hl * 64 + il]), a1 = bf2f(vs[jtok * 128 + hl * 64 + 32 + il]);
                                    acc0 = __builtin_amdgcn_mfma_f32_32x32x2f32(a0, pt[r], acc0, 0, 0, 0);
                                    acc1 = __builtin_amdgcn_mfma_f32_32x32x2f32(a1, pt[r], acc1, 0, 0, 0); }
                            }
                            float* op = OUT + (size_t)(n0 + itok) * 256 + h * 64;
#pragma unroll
                            for (int rq = 0; rq < 4; ++rq) {
                                *(f32x4*)(op + 8 * rq + 4 * hi) = (f32x4){acc0[4 * rq], acc0[4 * rq + 1], acc0[4 * rq + 2], acc0[4 * rq + 3]};
                                *(f32x4*)(op + 32 + 8 * rq + 4 * hi) = (f32x4){acc1[4 * rq], acc1[4 * rq + 1], acc1[4 * rq + 2], acc1[4 * rq + 3]}; }
                        }
                    }
                    asm volatile("s_waitcnt vmcnt(0)" ::: "memory");
                    __syncthreads();
                    for (int ib = 0; ib < 2; ++ib) {
                        f32x4 fF[8], fB[8]; u32x2 gW[8];
#pragma unroll
                        for (int it = 0; it < 8; ++it) { const int n = n0 + wave * 16 + ib * 8 + it;
                            fF[it] = *((const f32x4*)(OF + (size_t)n * 256) + lane); fB[it] = *((const f32x4*)(OB + (size_t)n * 256) + lane); gW[it] = *(const u32x2*)(PROJ + (size_t)n * PROJW + C_RG + lane * 4); }
#pragma unroll
                        for (int it = 0; it < 8; ++it) { const int n = n0 + wave * 16 + ib * 8 + it;
                            float v0 = fF[it].x + fB[it].x, v1 = fF[it].y + fB[it].y, v2 = fF[it].z + fB[it].z, v3 = fF[it].w + fB[it].w;
                            float s = v0 + v1 + v2 + v3; s += dpp_f<0xB1>(s); s += dpp_f<0x4E>(s); s += dpp_f<0x141>(s); s += dpp_f<0x140>(s);
                            const float mean = s * (1.f / 64.f); v0 -= mean; v1 -= mean; v2 -= mean; v3 -= mean;
                            float q = v0 * v0 + v1 * v1 + v2 * v2 + v3 * v3; q += dpp_f<0xB1>(q); q += dpp_f<0x4E>(q); q += dpp_f<0x141>(q); q += dpp_f<0x140>(q);
                            const float rs = rsqrtf(q * (1.f / 64.f) + LN_EPS);
                            const float g0 = bflo(gW[it].x), g1 = bfhi(gW[it].x), g2 = bflo(gW[it].y), g3 = bfhi(gW[it].y);
                            u32x2 o; o.x = pk2(v0 * rs * g0 * sigmoidf_(g0), v1 * rs * g1 * sigmoidf_(g1)); o.y = pk2(v2 * rs * g2 * sigmoidf_(g2), v3 * rs * g3 * sigmoidf_(g3));
                            *(u32x2*)(MIX + (size_t)n * DM + 768 + lane * 4) = o; }
                    }
                }
                __syncthreads();
            }
            if (l + 1 < NLAYER && vcu >= 32) {
                LAS float* scr = (LAS float*)(lds + wave * 16384);
                for (int it = IT_LAYER / 2 + (vcu - 32) * 8 + wave; it < IT_LAYER; it += (G - 32) * 8) CONVERT_ITEM(l + 1, it);
                __syncthreads();
            }
        }
        SEAM(pb + 3);
        for (int rep_ = 0; rep_ < REPS(4); ++rep_) if (EN(4) && IN(pb + 4)) { PH_IDS();
            const int skipr = (l == NLAYER - 1) ? NCTX : 0;
            pg8::Gemm g{MIX + (size_t)skipr * DM, WOT + (size_t)l * 1024 * 1024, 1024, 1024, nullptr, 0, 0};
            pg8::StaticOrder S; S.init((NTOK - skipr) / 256, 4, G, bx);
            pg8::EpiBf16 E{YB + (size_t)skipr * DM, DM};
            pg8::gemm_phase<pg8::EpiBf16, pg8::StaticOrder, false>(lds, g, S, E, wave_s);
        }
        SEAM(pb + 4);
        if (EN(5) && IN(pb + 5)) { PH_IDS();
            LAS f32x4* rwl4 = (LAS f32x4*)lds;
            LAS unsigned* cnt = (LAS unsigned*)(lds + RING_BYTES);
            { const f32x4* src = (const f32x4*)(a.in[I_RW] + (size_t)l * 1024 * 32);
              f32x4 wv_[16];
#pragma unroll
              for (int u_ = 0; u_ < 16; ++u_) wv_[u_] = src[tid + 512 * u_];
#pragma unroll
              for (int u_ = 0; u_ < 16; ++u_) { const int i = tid + 512 * u_; const int d = i >> 3, cq = i & 7; const int rho = ((d & 3) * 4 + (d >> 8)) * 64 + ((d >> 2) & 63); rwl4[rho * 8 + (cq ^ (rho & 7))] = wv_[u_]; } }
            if (tid < 32) cnt[tid] = 0u;
            __syncthreads();
            const float* ln1g = a.in[I_LN1G] + l * DM; const float* ln1b = a.in[I_LN1B] + l * DM; const float* rb = a.in[I_RB] + l * 32;
            const int per = ((NTOK + G - 1) / G + 1) & ~1; const int n0 = bx * per, n1 = (n0 + per < NTOK) ? n0 + per : NTOK;
            const int myE = ((lane >> 5) & 1) * 16 + ((lane >> 4) & 1) * 8 + ((lane >> 3) & 1) * 4 + ((lane >> 2) & 1) * 2 + ((lane >> 1) & 1);
            const float myRb = rb[myE];
            f32x4 xB[2][4] = {}; u32x2 yB[2][4] = {};
            const int npair = (n1 - n0) >> 1;
            if (wave < npair) {
#pragma unroll
                for (int t = 0; t < 2; ++t)
#pragma unroll
                    for (int j = 0; j < 4; ++j) { XLOAD(xB[t][j], l, n0 + 2 * wave + t, j); yB[t][j] = *((const u32x2*)(YB + (size_t)(n0 + 2 * wave + t) * DM) + lane + 64 * j); } }
            for (int p = wave; p < npair; p += 8) {
                const int nb = n0 + 2 * p;
                f32x4 v[2][4];
                const float* md = MODL + (size_t)modset(nb) * 6144;
                float sm[2];
                {
                    f32x4 g1v[4];
#pragma unroll
                    for (int j = 0; j < 4; ++j) g1v[j] = *((const f32x4*)(md + 2048) + lane + 64 * j);
#pragma unroll
                    for (int t = 0; t < 2; ++t) { float s = 0.f;
#pragma unroll
                        for (int j = 0; j < 4; ++j) { const f32x4 yv = (f32x4){bflo(yB[t][j].x), bfhi(yB[t][j].x), bflo(yB[t][j].y), bfhi(yB[t][j].y)}; v[t][j] = XVAL(xB[t][j], l) * DN_ALPHA + g1v[j] * yv; s += (v[t][j].x + v[t][j].y) + (v[t][j].z + v[t][j].w); }
                        sm[t] = s; }
                }
                __builtin_amdgcn_sched_barrier(0);
                f32x4 pg[4], pb_[4], psh[4], psc[4];
#pragma unroll
                for (int j = 0; j < 4; ++j) { pg[j] = *((const f32x4*)ln1g + lane + 64 * j); pb_[j] = *((const f32x4*)ln1b + lane + 64 * j); psh[j] = *((const f32x4*)(md + 3072) + lane + 64 * j); psc[j] = *((const f32x4*)(md + 4096) + lane + 64 * j); }
                float rstd[2];
                { const float mean0 = wave_sum(sm[0]) * (1.f / DM), mean1 = wave_sum(sm[1]) * (1.f / DM); float q0 = 0.f, q1 = 0.f;
#pragma unroll
                  for (int j = 0; j < 4; ++j) { v[0][j] = v[0][j] - mean0; q0 += (v[0][j].x * v[0][j].x + v[0][j].y * v[0][j].y) + (v[0][j].z * v[0][j].z + v[0][j].w * v[0][j].w);
                      v[1][j] = v[1][j] - mean1; q1 += (v[1][j].x * v[1][j].x + v[1][j].y * v[1][j].y) + (v[1][j].z * v[1][j].z + v[1][j].w * v[1][j].w); }
                  rstd[0] = rsqrtf(wave_sum(q0) * (1.f / DM) + LN_EPS); rstd[1] = rsqrtf(wave_sum(q1) * (1.f / DM) + LN_EPS); }
                __builtin_amdgcn_sched_barrier(0);
#pragma unroll
                for (int j = 0; j < 4; ++j)
#pragma unroll
                    for (int t = 0; t < 2; ++t) { const int n = nb + t;
                        v[t][j] = v[t][j] * rstd[t] * pg[j] + pb_[j]; { u32x2 xw_; xw_.x = pk2(v[t][j].x, v[t][j].y); xw_.y = pk2(v[t][j].z, v[t][j].w); *((u32x2*)(XRB + (size_t)n * DM) + lane + 64 * j) = xw_; }
                        v[t][j] = v[t][j] * (psc[j] + 1.f) + psh[j];
                        *((unsigned*)(XH8 + (size_t)n * DM) + lane + 64 * j) = pk4_fp8(v[t][j].x * ACT_Q, v[t][j].y * ACT_Q, v[t][j].z * ACT_Q, v[t][j].w * ACT_Q); }
                __builtin_amdgcn_sched_barrier(0);
                if (p + 8 < npair) {
#pragma unroll
                    for (int j = 0; j < 4; ++j) { XLOAD(xB[0][j], l, nb + 16, j); yB[0][j] = *((const u32x2*)(YB + (size_t)(nb + 16) * DM) + lane + 64 * j); } }
                __builtin_amdgcn_sched_barrier(0);
                f32x4 ac[2][8];
#pragma unroll
                for (int t = 0; t < 2; ++t)
#pragma unroll
                    for (int q = 0; q < 8; ++q) ac[t][q] = (f32x4){0.f, 0.f, 0.f, 0.f};
                int lq_ = lane; asm volatile("" : "+v"(lq_));
#pragma unroll
                for (int j = 0; j < 4; ++j)
#pragma unroll
                    for (int i = 0; i < 4; ++i) { __builtin_amdgcn_sched_barrier(0); const float hv0 = v[0][j][i], hv1 = v[1][j][i]; const LAS f32x4* rp = rwl4 + ((i * 4 + j) * 64 + lq_) * 8;
#pragma unroll
                        for (int q = 0; q < 8; ++q) { const f32x4 w = rp[q ^ (lq_ & 7)]; ac[0][q] += w * hv0; ac[1][q] += w * hv1; }
#pragma unroll
                        for (int t = 0; t < 2; ++t)
                            asm volatile("" : "+v"(ac[t][0]), "+v"(ac[t][1]), "+v"(ac[t][2]), "+v"(ac[t][3]), "+v"(ac[t][4]), "+v"(ac[t][5]), "+v"(ac[t][6]), "+v"(ac[t][7])); }
                __builtin_amdgcn_sched_barrier(0);
                if (p + 8 < npair) {
#pragma unroll
                    for (int j = 0; j < 4; ++j) { XLOAD(xB[1][j], l, nb + 17, j); yB[1][j] = *((const u32x2*)(YB + (size_t)(nb + 17) * DM) + lane + 64 * j); } }
                __builtin_amdgcn_sched_barrier(0);
                float tv[2][4]; int ti[2][4];
#pragma unroll
                for (int t = 0; t < 2; ++t) {
                    float r16[16], r8[8], r4[4], r2[2], val;
                    { const bool up = (lane & 32) != 0;
#pragma unroll
                      for (int k = 0; k < 16; ++k) { const float lo_ = ac[t][k >> 2][k & 3], hi_ = ac[t][(k + 16) >> 2][k & 3]; r16[k] = (up ? hi_ : lo_) + __shfl_xor(up ? lo_ : hi_, 32); } }
                    { const bool up = (lane & 16) != 0;
#pragma unroll
                      for (int k = 0; k < 8; ++k) r8[k] = (up ? r16[k + 8] : r16[k]) + __shfl_xor(up ? r16[k] : r16[k + 8], 16); }
                    { const bool up = (lane & 8) != 0;
#pragma unroll
                      for (int k = 0; k < 4; ++k) r4[k] = (up ? r8[k + 4] : r8[k]) + dpp_f<0x128>(up ? r8[k] : r8[k + 4]); }
                    { const bool up = (lane & 4) != 0;
#pragma unroll
                      for (int k = 0; k < 2; ++k) r2[k] = (up ? r4[k + 2] : r4[k]) + dpp_f<0x1B>(dpp_f<0x141>(up ? r4[k] : r4[k + 2])); }
                    { const bool up = (lane & 2) != 0; val = (up ? r2[1] : r2[0]) + dpp_f<0x4E>(up ? r2[0] : r2[1]); }
                    val += dpp_f<0xB1>(val);
                    val += myRb;
#pragma unroll
                    for (int k = 0; k < 4; ++k) {
                        float bv = val; int bi = myE;
#pragma unroll
                        for (int o = 32; o >= 16; o >>= 1) { const float ov = __shfl_xor(bv, o); const int oi = __shfl_xor(bi, o); if (ov > bv || (ov == bv && oi < bi)) { bv = ov; bi = oi; } }
#define AMX_STEP(C_) { const float ov = dpp_f<C_>(bv); const int oi = dpp_i<C_>(bi); if (ov > bv || (ov == bv && oi < bi)) { bv = ov; bi = oi; } }
                        AMX_STEP(0x140) AMX_STEP(0x141) AMX_STEP(0x4E) AMX_STEP(0xB1)
#undef AMX_STEP
                        tv[t][k] = bv; ti[t][k] = bi; if (myE == bi) val = -3.0e38f;
                    }
                }
#pragma unroll
                for (int t = 0; t < 2; ++t) {
                    const int n = nb + t;
                    const bool routed = !(l == NLAYER - 1 && n < NCTX);
                    const float e1 = __expf(tv[t][1] - tv[t][0]), e2 = __expf(tv[t][2] - tv[t][0]), e3 = __expf(tv[t][3] - tv[t][0]);
                    const float inv = 1.f / (1.f + e1 + e2 + e3);
                    if (lane < 4) {
                        const int ee = lane == 0 ? ti[t][0] : lane == 1 ? ti[t][1] : lane == 2 ? ti[t][2] : ti[t][3];
                        const float gg = (lane == 0 ? 1.f : lane == 1 ? e1 : lane == 2 ? e2 : e3) * inv;
                        TOPI[n * 4 + lane] = routed ? ee : -1; GATE[n * 4 + lane] = gg;
                        if (routed) __hip_atomic_fetch_add(&cnt[ee], 1u, __ATOMIC_RELAXED, __HIP_MEMORY_SCOPE_WORKGROUP);
                    }
                }
                __builtin_amdgcn_sched_barrier(0);
            }
            __syncthreads();
            if (tid < 32) __hip_atomic_store(ctl + CW_BLKCNT + bx * 32 + tid, cnt[tid], RLX_AGENT);
            __syncthreads();
        }
        SEAM(pb + 5);
        for (int rep_ = 0; rep_ < REPS(6); ++rep_) if (EN(6) && IN(pb + 6)) { PH_IDS();
            LAS int* bc = (LAS int*)lds;
            LAS int* part = (LAS int*)(lds + 65536);
            LAS int* tot = part + 1024; LAS int* base = tot + 32; LAS int* seg = base + 32; LAS int* tiv = seg + 40;
            { unsigned cv_[16];
#pragma unroll
              for (int u_ = 0; u_ < 16; ++u_) { const int i = tid + 512 * u_; cv_[u_] = (i < G * 32) ? ctl[CW_BLKCNT + i] : 0u; }
#pragma unroll
              for (int u_ = 0; u_ < 16; ++u_) { const int i = tid + 512 * u_; if (i < G * 32) bc[i] = (int)cv_[u_]; }
              for (int i = tid + 8192; i < G * 32; i += 512) bc[i] = (int)ctl[CW_BLKCNT + i]; }
            const int per = ((NTOK + G - 1) / G + 1) & ~1; const int n0 = bx * per, n1 = (n0 + per < NTOK) ? n0 + per : NTOK; const int na = (n1 - n0) * 4;
            { const int i0 = tid, i1 = tid + 512; const int t0_ = (i0 < na) ? TOPI[n0 * 4 + i0] : 0, t1_ = (i1 < na) ? TOPI[n0 * 4 + i1] : 0;
              if (i0 < na) tiv[i0] = t0_; if (i1 < na) tiv[i1] = t1_;
              for (int i = tid + 1024; i < na; i += 512) tiv[i] = TOPI[n0 * 4 + i]; }
            __syncthreads();
            { const int e = tid & 31, pt = tid >> 5; const int bpp = (G + 15) / 16; int t = 0, bs = 0;
              for (int b = pt * bpp; b < (pt + 1) * bpp && b < G; ++b) { const int c = bc[b * 32 + e]; t += c; if (b < bx) bs += c; }
              part[pt * 32 + e] = t; part[512 + pt * 32 + e] = bs; }
            __syncthreads();
            if (tid < 32) { int t = 0, bs = 0;
#pragma unroll
              for (int p = 0; p < 16; ++p) { t += part[p * 32 + tid]; bs += part[512 + p * 32 + tid]; }
              tot[tid] = t; base[tid] = bs; }
            __syncthreads();
            if (tid == 0) { int off = 0; for (int e = 0; e < 32; ++e) { seg[e] = off; off += (tot[e] + 255) & ~255; } seg[32] = off; }
            __syncthreads();
            if (bx == 0) {
                const int ntl = seg[32] >> 8;
                if (tid == 0) __hip_atomic_store(ctl + CW_NT, (unsigned)ntl, RLX_AGENT);
                for (int t = tid; t < ntl; t += 512) { int e = 0; for (int k = 0; k < 32; ++k) if (seg[k] <= t * 256) e = k; __hip_atomic_store(ctl + CW_TILE_E + t, (unsigned)e, RLX_AGENT); }
            }
            for (int e = wave; e < 32; e += 8) {
                if ((e % G) == bx) for (int r = seg[e] + tot[e] + lane; r < seg[e + 1]; r += 64) ROWTOK[r] = 0;
            }
            for (int i = tid; i < na; i += 512) { const int e = tiv[i];
                if (e >= 0) { int rk = 0; for (int j = 0; j < i; ++j) rk += (tiv[j] == e) ? 1 : 0;
                    const int pos = seg[e] + base[e] + rk; DEST[n0 * 4 + i] = pos; ROWTOK[pos] = n0 + (i >> 2); } }
            __syncthreads();
        }
        SEAM(pb + 6);
        for (int rep_ = 0; rep_ < REPS(7); ++rep_) if (EN(7) && IN(pb + 7)) { PH_IDS();
            const int ntl = __builtin_amdgcn_readfirstlane(ld_ctl(ctl + CW_NT));
            LAS unsigned char* te = (LAS unsigned char*)(lds + RING_BYTES);
            LAS unsigned short* rows = (LAS unsigned short*)(lds + RING_BYTES + 1024);
            pg8::MoeOrder S; S.so.init(ntl, 8, G, bx); S.tile_e = te;
            {
                const unsigned e0_ = (tid < ntl) ? ctl[CW_TILE_E + tid] : 0u, e1_ = (tid + 512 < ntl) ? ctl[CW_TILE_E + tid + 512] : 0u;
                int rv_[18];
#pragma unroll
                for (int i = 0; i < 18; ++i) { pg8::Unit u; const bool ok = S.so.next(i, u); rv_[i] = (ok && tid < 256) ? ROWTOK[u.pm * 256 + tid] : 0; }
                if (tid < ntl) te[tid] = (unsigned char)e0_; if (tid + 512 < ntl) te[tid + 512] = (unsigned char)e1_;
                for (int t = tid + 1024; t < ntl; t += 512) te[t] = (unsigned char)ctl[CW_TILE_E + t];
#pragma unroll
                for (int i = 0; i < 18; ++i) if (tid < 256) rows[i * 256 + tid] = (unsigned short)rv_[i];
            }
            __syncthreads();
            pg8::Gemm g{XH8, WGU + (size_t)l * 32 * 2048 * 1024, 1024, 1024, rows, ACT_E, WGU_E};
            pg8::EpiSwiglu E{ACT, a.in[I_BGU] + (size_t)l * 32 * 2048};
            pg8::gemm_phase<pg8::EpiSwiglu, pg8::MoeOrder, true, true>(lds, g, S, E, wave_s);
        }
        SEAM(pb + 7);
        for (int rep_ = 0; rep_ < REPS(8); ++rep_) if (EN(8) && IN(pb + 8)) { PH_IDS();
            const int ntl = __builtin_amdgcn_readfirstlane(ld_ctl(ctl + CW_NT));
            LAS unsigned char* te = (LAS unsigned char*)(lds + RING_BYTES);
            { const unsigned e0_ = (tid < ntl) ? ctl[CW_TILE_E + tid] : 0u, e1_ = (tid + 512 < ntl) ? ctl[CW_TILE_E + tid + 512] : 0u;
              if (tid < ntl) te[tid] = (unsigned char)e0_; if (tid + 512 < ntl) te[tid + 512] = (unsigned char)e1_;
              for (int t = tid + 1024; t < ntl; t += 512) te[t] = (unsigned char)ctl[CW_TILE_E + t]; }
            __syncthreads();
            pg8::Gemm g{ACT, WDN + (size_t)l * 32 * 1024 * 1024, 1024, 1024, nullptr, ACT_E, WDN_E};
            pg8::MoeOrder S; S.so.init(ntl, 4, G, bx); S.tile_e = te;
            pg8::EpiDown E{DOUT, a.in[I_BDN] + (size_t)l * 32 * 1024};
            pg8::gemm_phase<pg8::EpiDown, pg8::MoeOrder, false, true>(lds, g, S, E, wave_s);
        }
        SEAM(pb + 8);
        if (EN(9) && IN(pb + 9)) { PH_IDS();
            const float* ln2g = a.in[I_LN2G] + l * DM; const float* ln2b = a.in[I_LN2B] + l * DM;
            const bool lastl = (l == NLAYER - 1);
            const int nbeg = lastl ? NCTX : 0;
            int dA[2][4] = {}; float gA[2][4] = {};
            unsigned rB[2][4][4] = {}; u32x2 xB[2][4] = {}; float gB[2][4] = {};
            const int PSTEP = 2 * NGW;
            const int nA = nbeg + 2 * gw;
            if (nA < NTOK) {
#pragma unroll
                for (int t = 0; t < 2; ++t)
#pragma unroll
                    for (int k = 0; k < 4; ++k) { dA[t][k] = DEST[(nA + t) * 4 + k]; gA[t][k] = GATE[(nA + t) * 4 + k]; }
#pragma unroll
                for (int t = 0; t < 2; ++t)
#pragma unroll
                    for (int j = 0; j < 4; ++j) {
#pragma unroll
                        for (int k = 0; k < 4; ++k) rB[t][j][k] = *((const unsigned*)(DOUT + (size_t)dA[t][k] * DM) + lane + 64 * j);
                        xB[t][j] = *((const u32x2*)(XRB + (size_t)(nA + t) * DM) + lane + 64 * j); }
#pragma unroll
                for (int t = 0; t < 2; ++t)
#pragma unroll
                    for (int k = 0; k < 4; ++k) gB[t][k] = gA[t][k];
                if (nA + PSTEP < NTOK) {
#pragma unroll
                    for (int t = 0; t < 2; ++t)
#pragma unroll
                        for (int k = 0; k < 4; ++k) { dA[t][k] = DEST[(nA + PSTEP + t) * 4 + k]; gA[t][k] = GATE[(nA + PSTEP + t) * 4 + k]; } }
            }
            for (int n = nbeg + 2 * gw; n < NTOK; n += PSTEP) {
                const float* md = MODL + (size_t)modset(n) * 6144;
                f32x4 v[2][4]; float sm[2];
                {
                    f32x4 g2[4];
#pragma unroll
                    for (int j = 0; j < 4; ++j) g2[j] = *((const f32x4*)(md + 5120) + lane + 64 * j);
#pragma unroll
                    for (int t = 0; t < 2; ++t) { float s = 0.f;
#pragma unroll
                        for (int j = 0; j < 4; ++j) {
                            f32x4 f = (f32x4){0.f, 0.f, 0.f, 0.f};
#pragma unroll
                            for (int k = 0; k < 4; ++k) { const unsigned w = rB[t][j][k]; const f32x2 lo_ = __builtin_amdgcn_cvt_pk_f32_fp8((int)w, false), hi_ = __builtin_amdgcn_cvt_pk_f32_fp8((int)w, true); const float gk = gB[t][k] * (1.f / DO_Q);
                                f.x += gk * lo_.x; f.y += gk * lo_.y; f.z += gk * hi_.x; f.w += gk * hi_.y; }
                            const f32x4 xv = (f32x4){bflo(xB[t][j].x), bfhi(xB[t][j].x), bflo(xB[t][j].y), bfhi(xB[t][j].y)};
                            v[t][j] = xv * DN_ALPHA + g2[j] * f; s += (v[t][j].x + v[t][j].y) + (v[t][j].z + v[t][j].w); }
                        sm[t] = s; }
                }
                __builtin_amdgcn_sched_barrier(0);
                if (n + PSTEP < NTOK) {
#pragma unroll
                    for (int t = 0; t < 2; ++t)
#pragma unroll
                        for (int j = 0; j < 4; ++j) {
#pragma unroll
                            for (int k = 0; k < 4; ++k) rB[t][j][k] = *((const unsigned*)(DOUT + (size_t)dA[t][k] * DM) + lane + 64 * j);
                            xB[t][j] = *((const u32x2*)(XRB + (size_t)(n + PSTEP + t) * DM) + lane + 64 * j); }
#pragma unroll
                    for (int t = 0; t < 2; ++t)
#pragma unroll
                        for (int k = 0; k < 4; ++k) gB[t][k] = gA[t][k];
                    if (n + 2 * PSTEP < NTOK) {
#pragma unroll
                        for (int t = 0; t < 2; ++t)
#pragma unroll
                            for (int k = 0; k < 4; ++k) { dA[t][k] = DEST[(n + 2 * PSTEP + t) * 4 + k]; gA[t][k] = GATE[(n + 2 * PSTEP + t) * 4 + k]; } }
                }
                __builtin_amdgcn_sched_barrier(0);
                const float* mdn = MODL + 5 * 6144 + (size_t)modset(n) * 6144;
                f32x4 pg[4], pb_[4];
#pragma unroll
                for (int j = 0; j < 4; ++j) { pg[j] = *((const f32x4*)ln2g + lane + 64 * j); pb_[j] = *((const f32x4*)ln2b + lane + 64 * j); }
                float rstd[2];
                { const float mean0 = wave_sum(sm[0]) * (1.f / DM), mean1 = wave_sum(sm[1]) * (1.f / DM); float q0 = 0.f, q1 = 0.f;
#pragma unroll
                  for (int j = 0; j < 4; ++j) { v[0][j] = v[0][j] - mean0; q0 += (v[0][j].x * v[0][j].x + v[0][j].y * v[0][j].y) + (v[0][j].z * v[0][j].z + v[0][j].w * v[0][j].w);
                      v[1][j] = v[1][j] - mean1; q1 += (v[1][j].x * v[1][j].x + v[1][j].y * v[1][j].y) + (v[1][j].z * v[1][j].z + v[1][j].w * v[1][j].w); }
                  rstd[0] = rsqrtf(wave_sum(q0) * (1.f / DM) + LN_EPS); rstd[1] = rsqrtf(wave_sum(q1) * (1.f / DM) + LN_EPS); }
                __builtin_amdgcn_sched_barrier(0);
#pragma unroll
                for (int j = 0; j < 4; ++j) { __builtin_amdgcn_sched_barrier(0);
                    f32x4 psh = (f32x4){0.f, 0.f, 0.f, 0.f}, psc = psh;
                    if (!lastl) { psh = *((const f32x4*)(mdn) + lane + 64 * j); psc = *((const f32x4*)(mdn + 1024) + lane + 64 * j); }
#pragma unroll
                    for (int t = 0; t < 2; ++t) { const int nn = n + t;
                        v[t][j] = v[t][j] * rstd[t] * pg[j] + pb_[j];
                        if (lastl) *((f32x4*)(a.out + (size_t)(nn - NCTX) * DM) + lane + 64 * j) = v[t][j];
                        else { u32x2 xw_; xw_.x = pk2(v[t][j].x, v[t][j].y); xw_.y = pk2(v[t][j].z, v[t][j].w); *((u32x2*)(XRB + (size_t)nn * DM) + lane + 64 * j) = xw_;
                            const f32x4 hh = (v[t][j] * (psc + 1.f) + psh) * ACT_Q; *((unsigned*)(XHF + (size_t)nn * DM) + lane + 64 * j) = pk4_fp8(hh.x, hh.y, hh.z, hh.w); } } }
                __builtin_amdgcn_sched_barrier(0);
            }
        }
        SEAM(pb + 9);
    }
#undef IN
#undef SEAM
}

extern "C" void kernel_launch(void* const* d_in, const int* in_sizes, int n_in, void* d_out, int out_size, void* d_ws, size_t ws_size, hipStream_t stream) {
    static int grid = 0;
    if (grid == 0) {
        if (n_in != 28 || ws_size < WS_END) { fprintf(stderr, "kernel_launch: need 28 inputs and %zu bytes of workspace (got %d, %zu)\n", (size_t)WS_END, n_in, ws_size); grid = -1; return; }
        int dev = 0, cus = 0, per_cu = 0;
        if (hipGetDevice(&dev) != hipSuccess || hipDeviceGetAttribute(&cus, hipDeviceAttributeMultiprocessorCount, dev) != hipSuccess) { grid = -1; return; }
        if (hipFuncSetAttribute((const void*)mega, hipFuncAttributeMaxDynamicSharedMemorySize, LDS_BYTES) != hipSuccess) { fprintf(stderr, "kernel_launch: hipFuncSetAttribute failed\n"); grid = -1; return; }
        if (hipOccupancyMaxActiveBlocksPerMultiprocessor(&per_cu, (const void*)mega, 512, LDS_BYTES) != hipSuccess || per_cu < 1) { fprintf(stderr, "kernel_launch: occupancy query says %d\n", per_cu); }
        (void)hipGetLastError();
        grid = cus;
        if (grid > 256) grid = 256;
    }
    if (grid < 0) return;
    (void)hipMemsetAsync((char*)d_ws + WS_CTL, 0, CTL_ZERO_BYTES, stream);
    Args a{};
    for (int i = 0; i < 28; ++i) a.in[i] = (const float*)d_in[i];
    a.out = (float*)d_out; a.ws = (unsigned char*)d_ws;
    constexpr int NPH = 2 + 10 * NLAYER;
#if MK_PER_PHASE
    for (int p = 0; p < NPH; ++p) { a.ph_lo = p; a.ph_hi = p + 1; hipLaunchKernelGGL(mega, dim3(grid), dim3(512), LDS_BYTES, stream, a); }
#else
    a.ph_lo = 0; a.ph_hi = NPH;
    hipLaunchKernelGGL(mega, dim3(grid), dim3(512), LDS_BYTES, stream, a);
#endif
    const hipError_t le = hipPeekAtLastError();
    if (le != hipSuccess) fprintf(stderr, "kernel_launch: launch failed: %s\n", hipGetErrorName(le));
}
```

```cpp
#include <hip/hip_runtime.h>
#include <cstdio>
#include <cstdint>

#ifndef MK_PER_PHASE
#define MK_PER_PHASE 0
#endif

#define GAS __attribute__((address_space(1)))
#define LAS __attribute__((address_space(3)))
typedef unsigned short bf16_t;
typedef short bf16x8 __attribute__((ext_vector_type(8)));
typedef short s16x4 __attribute__((ext_vector_type(4)));
typedef float f32x2 __attribute__((ext_vector_type(2)));
typedef float f32x4 __attribute__((ext_vector_type(4)));
typedef float f32x16 __attribute__((ext_vector_type(16)));
typedef unsigned u32x2 __attribute__((ext_vector_type(2)));
typedef unsigned u32x4 __attribute__((ext_vector_type(4)));
typedef int v8i __attribute__((ext_vector_type(8)));
typedef int v4i __attribute__((ext_vector_type(4)));

constexpr int DM = 1024, NB = 4, SEQ = 8192, NLAYER = 4, CTXL = 256;
constexpr int NCTX = NB * CTXL;
constexpr int NTOK = NCTX + NB * SEQ;
constexpr int KEYS = CTXL + SEQ;
constexpr int PROJW = 2048;
constexpr int NEXP = 32, TOPK = 4;
constexpr int CAP_TILES = 560, CAP_ROWS = CAP_TILES * 256;
constexpr float LN_EPS = 1e-5f, RMS_EPS = 1e-6f;
constexpr float DN_ALPHA = 1.681792830507429f;
constexpr float MLA_SCALE = 0.07216878364870322f;
constexpr float RET_QSCALE = 0.1767766952966369f;
constexpr float ACT_Q = 4.f;      constexpr int ACT_E = 0x7d7d7d7d;
constexpr float WGU_Q = 128.f;    constexpr int WGU_E = 0x78787878;
constexpr float WDN_Q = 256.f;    constexpr int WDN_E = 0x77777777;
constexpr float QK_Q = 8.f;       constexpr int QK_E = 0x7c7c7c7c;
constexpr float QC_Q = 16.f * 0.07216878364870322f * 1.4426950408889634f;   constexpr int QC_E = 0x7b7b7b7b;
constexpr float PV_Q = 8.f;       constexpr int PV_E = 0x7c7c7c7c;
constexpr int VT_ROW = 80, VT_TILE = 128 * VT_ROW;
constexpr float DO_Q = 64.f;
constexpr int C_CQ = 0, C_CKV = 384, C_KR = 640, C_SGU = 704, C_SGV = 960, C_RQ = 1216, C_RK = 1344, C_RV = 1472, C_RG = 1728;

constexpr size_t MiB = 1u << 20;
constexpr size_t WS_CTL = 0, CTL_ZERO_BYTES = 1 * MiB;
constexpr size_t WS_MOD = 1 * MiB;
constexpr size_t WS_ATAB = 2 * MiB;
constexpr size_t WS_RTAB = 2 * MiB + 65536;
constexpr size_t WS_WIN = 4 * MiB;
constexpr size_t WS_WUQ = 20 * MiB;
constexpr size_t WS_WUKV = 23 * MiB;
constexpr size_t WS_WO = 25 * MiB;
constexpr size_t WS_SGWB = 34 * MiB;
constexpr size_t WS_WGU = 64 * MiB;
constexpr size_t WS_WDN = 576 * MiB;
constexpr size_t WS_XRES = 832 * MiB;
constexpr size_t WS_XH = 964 * MiB;
constexpr size_t WS_PROJ = 1030 * MiB;
constexpr size_t WS_CQN = 1162 * MiB;
constexpr size_t WS_CKVN = 1187 * MiB;
constexpr size_t WS_QB = 1204 * MiB;
constexpr size_t WS_KB = 1254 * MiB;
constexpr size_t WS_VB = 1304 * MiB;
constexpr size_t WS_SGU = 1337 * MiB;
constexpr size_t WS_SGV = 1354 * MiB;
constexpr size_t WS_RQ = 1371 * MiB;
constexpr size_t WS_RK = 1388 * MiB;
constexpr size_t WS_OF = 1405 * MiB;
constexpr size_t WS_OB = 1438 * MiB;
constexpr size_t WS_MIX = 1471 * MiB;
constexpr size_t WS_Y = 1537 * MiB;
constexpr size_t WS_TOPI = 1669 * MiB;
constexpr size_t WS_GATE = 1670 * MiB;
constexpr size_t WS_DEST = 1671 * MiB;
constexpr size_t WS_ROWTOK = 1672 * MiB;
constexpr size_t WS_ACT = 1673 * MiB;
constexpr size_t WS_XH8 = 1830 * MiB;
constexpr size_t WS_DOUT = 1953 * MiB;
constexpr size_t WS_END = 2233 * MiB;
constexpr int CW_BAR = 4096;
constexpr int CW_BLKCNT = 16384;
constexpr int CW_NT = 32768;
constexpr int CW_TILE_E = 32832;
constexpr int CW_ECTX = 40960;

constexpr int LDS_BYTES = 147456;
constexpr int RING_BYTES = 131072;
constexpr int MISC_OFF = LDS_BYTES - 256;

#define RLX_AGENT __ATOMIC_RELAXED, __HIP_MEMORY_SCOPE_AGENT
__device__ __forceinline__ unsigned f2bf(float f) { unsigned u = __builtin_bit_cast(unsigned, f); return (u + 0x7fffu + ((u >> 16) & 1u)) >> 16; }
__device__ __forceinline__ unsigned pk2(float lo, float hi) { return f2bf(lo) | (f2bf(hi) << 16); }
__device__ __forceinline__ float bf2f(unsigned short h) { return __builtin_bit_cast(float, (unsigned)h << 16); }
__device__ __forceinline__ float bflo(unsigned w) { return __builtin_bit_cast(float, w << 16); }
__device__ __forceinline__ float bfhi(unsigned w) { return __builtin_bit_cast(float, w & 0xffff0000u); }
__device__ __forceinline__ unsigned cvt_pk_bf16(float lo, float hi) { unsigned r; asm volatile("v_cvt_pk_bf16_f32 %0, %1, %2" : "=v"(r) : "v"(lo), "v"(hi)); return r; }
__device__ __forceinline__ unsigned pk4_fp8(float x0, float x1, float x2, float x3) { int w = 0; w = __builtin_amdgcn_cvt_pk_fp8_f32(x0, x1, w, false); w = __builtin_amdgcn_cvt_pk_fp8_f32(x2, x3, w, true); return (unsigned)w; }
template <int CTRL> __device__ __forceinline__ float dpp_f(float v) { return __builtin_bit_cast(float, __builtin_amdgcn_update_dpp(0, __builtin_bit_cast(int, v), CTRL, 0xf, 0xf, true)); }
template <int CTRL> __device__ __forceinline__ int dpp_i(int v) { return __builtin_amdgcn_update_dpp(0, v, CTRL, 0xf, 0xf, true); }
__device__ __forceinline__ float wave_sum(float v) {
    v += dpp_f<0xB1>(v);
    v += dpp_f<0x4E>(v);
    v += dpp_f<0x141>(v);
    v += dpp_f<0x140>(v);
    { const int b_ = __builtin_bit_cast(int, v);
      const float r0 = __builtin_bit_cast(float, __builtin_amdgcn_readlane(b_, 0)), r1 = __builtin_bit_cast(float, __builtin_amdgcn_readlane(b_, 16)), r2 = __builtin_bit_cast(float, __builtin_amdgcn_readlane(b_, 32)), r3 = __builtin_bit_cast(float, __builtin_amdgcn_readlane(b_, 48));
      v = (r0 + r1) + (r2 + r3); }
    return v;
}
__device__ __forceinline__ int lane_id() { int l; asm volatile("v_mbcnt_lo_u32_b32 %0, -1, 0\n\tv_mbcnt_hi_u32_b32 %0, -1, %0" : "=v"(l)); return l; }
__device__ __forceinline__ int ld_ctl(const unsigned* p) { return (int)__hip_atomic_load(p, RLX_AGENT); }
__device__ __forceinline__ float gelu1(float v) {
    const float av = fabsf(v), d = av * 0.2316418882f + 1.0f, t = __builtin_amdgcn_rcpf(d);
    float q = t * 0.5307027145f + (-0.7265760135f); q = q * t + 0.7107068705f; q = q * t + (-0.142248368f); q = q * t + 0.127414796f; q = q * t;
    const float e = __builtin_amdgcn_exp2f((v * v) * (-0.72134752044f));
    const float m = v * (q * e), r = v - m;
    return v < 0.f ? m : r;
}
__device__ __forceinline__ float sigmoidf_(float x) { return __builtin_amdgcn_rcpf(1.f + __builtin_amdgcn_exp2f(-1.4426950408889634f * x)); }
__device__ __forceinline__ int modset(int n) { return (n < NCTX) ? 4 : ((n - NCTX) >> 13); }

__device__ const double INV_R[16] = {1.0, 0.5411695265464637, 0.2928644564625237, 0.15848931924611134, 0.08576958985908942, 0.046415888336127795, 0.025118864315095794, 0.013593563908785255,
                                     0.007356422544596414, 0.003981071705534973, 0.0021544346900318843, 0.0011659144011798323, 0.000630957344480193, 0.0003414548873833601, 0.00018478497974222906, 0.0001};
__device__ const double INV_A[16] = {1.0, 0.5623413251903491, 0.31622776601683794, 0.1778279410038923, 0.1, 0.05623413251903491, 0.03162277660168379, 0.01778279410038923,
                                     0.01, 0.005623413251903491, 0.0031622776601683794, 0.0017782794100389228, 0.001, 0.0005623413251903491, 0.00031622776601683794, 0.00017782794100389227};
__device__ __forceinline__ void sincos_d(double x, float& s, float& c) {
    const double k = rint(x * 0.15915494309189535);
    double r = fma(-k, 6.283185307179586, x); r = fma(-k, 2.4492935982947064e-16, r);
    const double r2 = r * r;
    double ps = -1.0 / 51090942171709440000.0;
    ps = fma(ps, r2, 1.0 / 121645100408832000.0);
    ps = fma(ps, r2, -1.0 / 355687428096000.0);
    ps = fma(ps, r2, 1.0 / 1307674368000.0);
    ps = fma(ps, r2, -1.0 / 6227020800.0);
    ps = fma(ps, r2, 1.0 / 39916800.0);
    ps = fma(ps, r2, -1.0 / 362880.0);
    ps = fma(ps, r2, 1.0 / 5040.0);
    ps = fma(ps, r2, -1.0 / 120.0);
    ps = fma(ps, r2, 1.0 / 6.0);
    ps = fma(ps, r2, -1.0);
    ps = -ps * r;
    double pc = 1.0 / 2432902008176640000.0;
    pc = fma(pc, r2, -1.0 / 6402373705728000.0);
    pc = fma(pc, r2, 1.0 / 20922789888000.0);
    pc = fma(pc, r2, -1.0 / 87178291200.0);
    pc = fma(pc, r2, 1.0 / 479001600.0);
    pc = fma(pc, r2, -1.0 / 3628800.0);
    pc = fma(pc, r2, 1.0 / 40320.0);
    pc = fma(pc, r2, -1.0 / 720.0);
    pc = fma(pc, r2, 1.0 / 24.0);
    pc = fma(pc, r2, -0.5);
    pc = fma(pc, r2, 1.0);
    s = (float)ps; c = (float)pc;
}

#define XB_TMO      128
#define XB_XCNT(j)  (256  + 64 * (j))
#define XB_XSUB(j)  (1280 + 64 * (j))
#define XB_XGEN(j)  (2304 + 64 * (j))
#define XB_TOP      3328
#define XB_TOPGEN   3392
#define XCD_BAR_WORDS 3456
#define XB_SPIN_CAP (1u << 24)
__device__ __forceinline__ unsigned xb_ld(unsigned* p)              { return __hip_atomic_load(p, __ATOMIC_RELAXED, __HIP_MEMORY_SCOPE_AGENT); }
__device__ __forceinline__ unsigned xb_add(unsigned* p, unsigned v) { return __hip_atomic_fetch_add(p, v, __ATOMIC_RELAXED, __HIP_MEMORY_SCOPE_AGENT); }
__device__ __forceinline__ unsigned xb_xcc_id() { return (unsigned)__builtin_amdgcn_s_getreg((3 << 11) | 20) & 0xFu; }
#define XB_SPIN(cond, bar) do { unsigned _sp = 0; while (cond) { __builtin_amdgcn_s_sleep(1); \
    if ((++_sp & 255u) == 0u) { if (xb_ld(&(bar)[XB_TMO])) break; if (_sp > XB_SPIN_CAP) { atomicAdd(&(bar)[XB_TMO], 1u); break; } } } } while (0)
struct XcdBarrier { unsigned* bar; unsigned x; volatile LAS unsigned* st; int wave; };
__device__ __forceinline__ XcdBarrier xcd_barrier_post(unsigned* bar, volatile LAS unsigned* st) {
    XcdBarrier b; b.bar = bar; b.x = xb_xcc_id(); b.st = st; b.wave = 0;
    if (threadIdx.x == 0) (void)xb_add(&bar[XB_XCNT(b.x)], 1u);
    return b;
}
__device__ __forceinline__ void xcd_barrier_complete(unsigned* bar, unsigned x, unsigned& nloc, unsigned& nx) {
    const unsigned G = gridDim.x * gridDim.y * gridDim.z;
    unsigned sum, cnt, mine, sp = 0u;
    for (;;) {
        sum = 0u; cnt = 0u; mine = 0u;
#pragma unroll
        for (unsigned j = 0; j < 16; ++j) { const unsigned c = xb_ld(&bar[XB_XCNT(j)]); sum += c; cnt += (c > 0u) ? 1u : 0u; mine = (j == x) ? c : mine; }
        if (sum == G) break;
        __builtin_amdgcn_s_sleep(1);
        if ((++sp & 255u) == 0u) { if (xb_ld(&bar[XB_TMO])) break; if (sp > XB_SPIN_CAP) { atomicAdd(&bar[XB_TMO], 1u); break; } }
    }
    nloc = mine > 0u ? mine : 1u; nx = cnt > 0u ? cnt : 1u;
}
__device__ __forceinline__ void xcd_barrier(const XcdBarrier& b) {
    asm volatile("s_waitcnt vmcnt(0)" ::: "memory");
    __syncthreads();
    if (b.wave == 0 && lane_id() == 0) {
        unsigned* bar = b.bar;
        __builtin_amdgcn_s_waitcnt(0);
        unsigned nloc = b.st[0], nx = b.st[1];
        if (nloc == 0u) { xcd_barrier_complete(bar, b.x, nloc, nx); b.st[0] = nloc; b.st[1] = nx; }
        const unsigned old = xb_add(&bar[XB_XSUB(b.x)], 1u);
        const unsigned gen = old / nloc;
        if (old + 1u == (gen + 1u) * nloc) {
            __builtin_amdgcn_fence(__ATOMIC_RELEASE, "agent");
            asm volatile("s_waitcnt vmcnt(0)" ::: "memory");
            const unsigned og = xb_add(&bar[XB_TOP], 1u);
            const unsigned tg = og / nx;
            if (og + 1u == (tg + 1u) * nx) xb_add(&bar[XB_TOPGEN], 1u);
            else XB_SPIN(xb_ld(&bar[XB_TOPGEN]) == tg, bar);
            __builtin_amdgcn_fence(__ATOMIC_ACQUIRE, "agent");
            xb_add(&bar[XB_XGEN(b.x)], 1u);
            asm volatile("s_waitcnt vmcnt(0)" ::: "memory");
        } else {
            XB_SPIN(xb_ld(&bar[XB_XGEN(b.x)]) == gen, bar);
            __builtin_amdgcn_fence(__ATOMIC_ACQUIRE, "agent");
            asm volatile("s_waitcnt vmcnt(0)" ::: "memory");
        }
    }
    __syncthreads();
}

namespace pg8 {
constexpr int BM = 256, BK = 64, HALF = 128, HTB = HALF * BK * 2, NXCD = 8, WGM = 8;
__host__ __device__ __forceinline__ int lds_byte(int r, int c) { const int st = (r >> 4) * 2 + (c >> 5), rr = r & 15, cc = c & 31, ob = rr * 64 + cc * 2; return st * 1024 + (ob ^ (((ob >> 9) & 1) << 5)); }
__host__ __device__ __forceinline__ void stage_rc(int b, int& R, int& C) { const int st = b / 1024, sb = b % 1024, swz = sb ^ (((sb >> 9) & 1) << 5); R = (st >> 1) * 16 + swz / 64; C = (st & 1) * 32 + (swz % 64) / 2; }
__host__ __device__ __forceinline__ int perm32(int rho) { const int n = rho >> 4, i = rho & 15; return 8 * (i >> 2) + 4 * n + (i & 3); }
struct Unit { int pm, pn; };
struct Gemm { const void* A; const void* Bt; int lda, K; const LAS unsigned short* rowlds; int scaleA, scaleB; };

struct StaticOrder {
    int nM, nN, nwg, G, c;
    __device__ __forceinline__ void init(int nM_, int nN_, int G_, int c_) { nM = nM_; nN = nN_; nwg = nM * nN; G = G_; c = c_; }
    __device__ __forceinline__ bool next(int i, Unit& u) const {
        const long L = (long)i * G + c; if (L >= nwg) return false;
        int wgid = (int)L; { const int q = nwg / NXCD, r = nwg % NXCD, xcd = wgid % NXCD, off = wgid / NXCD; wgid = (xcd < r ? xcd * (q + 1) : r * (q + 1) + (xcd - r) * q) + off; }
        const int nig = WGM * nN, gid = wgid / nig, fm = gid * WGM, gsz = (nM - fm) < WGM ? (nM - fm) : WGM;
        u.pm = fm + ((wgid % nig) % gsz); u.pn = (wgid % nig) / gsz; return true;
    }
};
struct OneUnit { int pm, pn; __device__ __forceinline__ bool next(int i, Unit& u) const { if (i != 0) return false; u.pm = pm; u.pn = pn; return true; } };
struct MoeOrder {
    StaticOrder so; const LAS unsigned char* tile_e;
    __device__ __forceinline__ bool next(int i, Unit& u) const {
        if (!so.next(i, u)) return false;
        const int e = __builtin_amdgcn_readfirstlane((int)tile_e[u.pm]);
        u.pn = e * so.nN + u.pn; return true;
    }
};

template <class Epi, class Sched, bool GATHER, bool FP8 = false>
__device__ __forceinline__ void gemm_phase(LAS unsigned char* lds, const Gemm g, const Sched& S, const Epi& E, const int wave_s) {
    int tid_ = wave_s * 64 + lane_id(); asm volatile("" : "+v"(tid_));
    const int tid = tid_, wid = __builtin_amdgcn_readfirstlane(tid >> 6), lane = tid & 63, wr = wid >> 2, wc = wid & 3, fr = lane & 15, fq = lane >> 4;
    constexpr int ESZ = FP8 ? 1 : 2;
    const int K = g.K, nt = K * ESZ / (BK * 2);
    int RA[2]; unsigned CA2[2], voffB[2];
#pragma unroll
    for (int i = 0; i < 2; ++i) { int R, C; stage_rc(tid * 16 + i * 8192, R, C); const int Rb = Epi::PERM ? ((R & ~31) + perm32(R & 31)) : R;
        RA[i] = R; CA2[i] = (unsigned)C * 2u; voffB[i] = (unsigned)(Rb * K * ESZ + C * 2); }
    const unsigned lda2 = (unsigned)g.lda * ESZ;
    const size_t kstep = (size_t)(BK * 2);
    const size_t hstepB = (size_t)HALF * K * ESZ, tstepB = 2 * hstepB;
    const unsigned ldsw = (unsigned)wid * 1024u;
    const int aoff = lds_byte(wr * 64 + fr, fq * 8), boff = lds_byte(wc * 32 + fr, fq * 8);
#define PG8_SA(b, h) (((b) * 2 + (h)) * HTB)
#define PG8_SB(b, h) ((4 + (b) * 2 + (h)) * HTB)
#define PG8_STAGE_B(bufoff, gbase) do { _Pragma("unroll") for (int _i = 0; _i < 2; ++_i) \
        __builtin_amdgcn_global_load_lds((const unsigned*)((const char*)(gbase) + voffB[_i]), (LAS unsigned*)(lds + (bufoff) + ldsw + _i * 8192), 16, 0, 0); } while (0)
#define PG8_STAGE_A(bufoff, gbase, UA) do { _Pragma("unroll") for (int _i = 0; _i < 2; ++_i) \
        __builtin_amdgcn_global_load_lds((const unsigned*)((const char*)(gbase) + (UA)[_i]), (LAS unsigned*)(lds + (bufoff) + ldsw + _i * 8192), 16, 0, 0); } while (0)
#define PG8_LD8(base) __builtin_shufflevector(*(const LAS v4i*)(base), *(const LAS v4i*)((base) + 1024), 0, 1, 2, 3, 4, 5, 6, 7)
#define PG8_LDA(dst, b, h) do { _Pragma("unroll") for (int m = 0; m < 4; ++m) dst[m] = PG8_LD8(lds + PG8_SA(b, h) + aoff + m * 2048); } while (0)
#define PG8_LDB(dst, b, h) do { _Pragma("unroll") for (int n = 0; n < 2; ++n) dst[n] = PG8_LD8(lds + PG8_SB(b, h) + boff + n * 2048); } while (0)
#define PG8_HALF(F, k) __builtin_bit_cast(bf16x8, (k) ? __builtin_shufflevector(F, F, 4, 5, 6, 7) : __builtin_shufflevector(F, F, 0, 1, 2, 3))
#define PG8_MMA(ai, bj, At, Bt) do { __builtin_amdgcn_s_setprio(1); \
        if constexpr (FP8) { _Pragma("unroll") for (int m = 0; m < 4; ++m) _Pragma("unroll") for (int n = 0; n < 2; ++n) \
            asm volatile("v_mfma_scale_f32_16x16x128_f8f6f4 %0, %1, %2, %0, %3, %4 op_sel_hi:[0,0,0]" : "+v"(acc[ai][bj][m][n]) : "v"(Bt[n]), "v"(At[m]), "v"(scB), "v"(scA)); } \
        else { _Pragma("unroll") for (int m = 0; m < 4; ++m) _Pragma("unroll") for (int n = 0; n < 2; ++n) _Pragma("unroll") for (int k = 0; k < 2; ++k) \
            acc[ai][bj][m][n] = __builtin_amdgcn_mfma_f32_16x16x32_bf16(PG8_HALF(Bt[n], k), PG8_HALF(At[m], k), acc[ai][bj][m][n], 0, 0, 0); } \
        __builtin_amdgcn_s_setprio(0); } while (0)
#define PG8_WAIT_V(n) asm volatile("s_waitcnt vmcnt(" #n ")" ::: "memory")
#define PG8_WAIT_L(n) asm volatile("s_waitcnt lgkmcnt(" #n ")" ::: "memory")
#define PG8_BAR __builtin_amdgcn_s_barrier()
#define PG8_SCHED __builtin_amdgcn_sched_barrier(0)
#define PG8_CALC_UA(dst, un, uord) do { _Pragma("unroll") for (int _h = 0; _h < 2; ++_h) _Pragma("unroll") for (int _i = 0; _i < 2; ++_i) { \
        int _rr = (un).pm * BM + _h * HALF + RA[_i]; if (GATHER) _rr = (int)g.rowlds[(uord) * 256 + _h * HALF + RA[_i]]; dst[_h][_i] = (unsigned)_rr * lda2 + CA2[_i]; } } while (0)
    Unit cur, nxt; int ui = 0;
    if (!S.next(0, cur)) return;
    const int scA = g.scaleA, scB = g.scaleB; (void)scA; (void)scB;
    if constexpr (Epi::BIAS_LDS) { if (wid == 0) __builtin_amdgcn_global_load_lds((const unsigned*)(E.bias_src(cur) + lane_id() * 4), (LAS unsigned*)(lds + Epi::BIAS_OFF), 16, 0, 0); }
    unsigned uAc[2][2], uAn[2][2];
    const size_t tstepA = (size_t)BM * lda2;
    if constexpr (GATHER) { PG8_CALC_UA(uAc, cur, 0); }
    else {
#pragma unroll
        for (int h = 0; h < 2; ++h)
#pragma unroll
            for (int i = 0; i < 2; ++i) { uAc[h][i] = (unsigned)(h * HALF + RA[i]) * lda2 + CA2[i]; uAn[h][i] = uAc[h][i]; } }
    f32x4 acc[2][2][4][2];
#pragma unroll
    for (int a = 0; a < 2; ++a)
#pragma unroll
        for (int b = 0; b < 2; ++b)
#pragma unroll
            for (int m = 0; m < 4; ++m)
#pragma unroll
                for (int n = 0; n < 2; ++n) acc[a][b][m][n] = (f32x4){0.f, 0.f, 0.f, 0.f};
    v8i At[4], B0[2], B1[2];
    const char* cA = GATHER ? (const char*)g.A : (const char*)g.A + (size_t)cur.pm * tstepA;
    const char* cB = (const char*)g.Bt + (size_t)cur.pn * tstepB;
    PG8_STAGE_B(PG8_SB(0, 0), cB); PG8_STAGE_B(PG8_SB(0, 1), cB + hstepB); PG8_STAGE_A(PG8_SA(0, 0), cA, uAc[0]); PG8_STAGE_A(PG8_SA(0, 1), cA, uAc[1]);
    if (wr == 1) PG8_BAR;
    PG8_WAIT_V(2); PG8_BAR;
    PG8_STAGE_B(PG8_SB(1, 0), cB + kstep); PG8_STAGE_A(PG8_SA(1, 0), cA + kstep, uAc[0]); PG8_STAGE_B(PG8_SB(1, 1), cB + hstepB + kstep);
    PG8_WAIT_V(6); PG8_BAR;
    for (;;) {
        const bool has_next = S.next(ui + 1, nxt);
        const char* nB = has_next ? (const char*)g.Bt + (size_t)nxt.pn * tstepB : cB;
        const char* nA = (GATHER || !has_next) ? cA : (const char*)g.A + (size_t)nxt.pm * tstepA;
        if constexpr (GATHER) {
            if (has_next) { PG8_CALC_UA(uAn, nxt, ui + 1); }
            else {
#pragma unroll
                for (int h = 0; h < 2; ++h)
#pragma unroll
                    for (int i = 0; i < 2; ++i) uAn[h][i] = uAc[h][i]; } }
#pragma unroll 1
        for (int t = 0; t < nt; t += 2) {
            const bool last = (t == nt - 2);
            const char* a1 = cA + (size_t)(t + 1) * kstep;
            const char* a2 = last ? nA : cA + (size_t)(t + 2) * kstep; const char* b2 = last ? nB : cB + (size_t)(t + 2) * kstep;
            const char* a3 = a2 + kstep; const char* b3 = b2 + kstep;
            unsigned u2[2][2];
#pragma unroll
            for (int h = 0; h < 2; ++h)
#pragma unroll
                for (int i = 0; i < 2; ++i) u2[h][i] = (GATHER && last) ? uAn[h][i] : uAc[h][i];
            PG8_LDB(B0, 0, 0); PG8_LDB(B1, 0, 1); PG8_SCHED; PG8_LDA(At, 0, 0); PG8_STAGE_A(PG8_SA(1, 1), a1, uAc[1]);
            PG8_WAIT_V(8); PG8_WAIT_L(0); PG8_BAR; PG8_MMA(0, 0, At, B0); PG8_MMA(0, 1, At, B1); PG8_BAR; PG8_SCHED;
            PG8_LDA(At, 0, 1); PG8_STAGE_B(PG8_SB(0, 0), b2); PG8_STAGE_B(PG8_SB(0, 1), b2 + hstepB); PG8_STAGE_A(PG8_SA(0, 0), a2, u2[0]);
            PG8_WAIT_V(8); PG8_WAIT_L(0); PG8_BAR; PG8_MMA(1, 0, At, B0); PG8_MMA(1, 1, At, B1); PG8_BAR; PG8_SCHED;
            PG8_LDB(B0, 1, 0); PG8_LDB(B1, 1, 1); PG8_SCHED; PG8_LDA(At, 1, 0); PG8_STAGE_A(PG8_SA(0, 1), a2, u2[1]);
            PG8_WAIT_V(8); PG8_WAIT_L(0); PG8_BAR; PG8_MMA(0, 0, At, B0); PG8_MMA(0, 1, At, B1); PG8_BAR; PG8_SCHED;
            PG8_LDA(At, 1, 1); PG8_STAGE_B(PG8_SB(1, 0), b3); PG8_STAGE_B(PG8_SB(1, 1), b3 + hstepB); PG8_STAGE_A(PG8_SA(1, 0), a3, u2[0]);
            PG8_WAIT_V(8); PG8_WAIT_L(0); PG8_BAR; PG8_MMA(1, 0, At, B0); PG8_MMA(1, 1, At, B1); PG8_BAR; PG8_SCHED;
        }
        if (wr == 0) PG8_BAR;
        if constexpr (FP8) { asm volatile("s_nop 15\n\ts_nop 15" ::: "memory"); PG8_SCHED; }
        if constexpr (Epi::BIAS_LDS) E(acc, cur, wr, wc, fr, fq, (const LAS float*)(lds + Epi::BIAS_OFF + (ui & 1) * 1024)); else E(acc, cur, wr, wc, fr, fq);
        if (!has_next) break;
#pragma unroll
        for (int a = 0; a < 2; ++a)
#pragma unroll
            for (int b = 0; b < 2; ++b)
#pragma unroll
                for (int m = 0; m < 4; ++m)
#pragma unroll
                    for (int n = 0; n < 2; ++n) acc[a][b][m][n] = (f32x4){0.f, 0.f, 0.f, 0.f};
        cur = nxt; cB = nB; cA = nA; ++ui;
        if constexpr (Epi::BIAS_LDS) { if (wid == 0) __builtin_amdgcn_global_load_lds((const unsigned*)(E.bias_src(cur) + lane_id() * 4), (LAS unsigned*)(lds + Epi::BIAS_OFF + (ui & 1) * 1024), 16, 0, 0); }
        if constexpr (GATHER) {
#pragma unroll
            for (int h = 0; h < 2; ++h)
#pragma unroll
                for (int i = 0; i < 2; ++i) uAc[h][i] = uAn[h][i]; }
        if (wr == 1) PG8_BAR;
    }
    PG8_WAIT_V(0);
    PG8_BAR;
#undef PG8_SA
#undef PG8_SB
#undef PG8_STAGE_A
#undef PG8_STAGE_B
#undef PG8_LDA
#undef PG8_LDB
#undef PG8_MMA
#undef PG8_LD8
#undef PG8_HALF
#undef PG8_WAIT_V
#undef PG8_WAIT_L
#undef PG8_BAR
#undef PG8_SCHED
#undef PG8_CALC_UA
}

struct EpiF32 { static constexpr bool BIAS_LDS = false; static constexpr int BIAS_OFF = 0;
    static constexpr bool PERM = false;
    float* C; int ldc;
    __device__ __forceinline__ void operator()(const f32x4 (&acc)[2][2][4][2], const Unit& u, int wr, int wc, int fr, int fq) const {
        const int row0 = u.pm * BM + wr * 64 + fr, col0 = u.pn * BM + wc * 32 + 4 * fq;
#pragma unroll
        for (int ai = 0; ai < 2; ++ai)
#pragma unroll
            for (int m = 0; m < 4; ++m) { float* rowp = C + (size_t)(row0 + ai * HALF + m * 16) * ldc + col0;
#pragma unroll
                for (int bj = 0; bj < 2; ++bj)
#pragma unroll
                    for (int n = 0; n < 2; ++n) *(f32x4*)(rowp + bj * HALF + n * 16) = acc[ai][bj][m][n]; }
    }
};
struct EpiBf16 {
    static constexpr bool PERM = true, BIAS_LDS = false; static constexpr int BIAS_OFF = 0;
    bf16_t* O; int ldc;
    __device__ __forceinline__ void operator()(const f32x4 (&acc)[2][2][4][2], const Unit& u, int wr, int wc, int fr, int fq) const {
        const int row0 = u.pm * BM + wr * 64 + fr, col0 = u.pn * BM + wc * 32 + 8 * fq;
#pragma unroll
        for (int ai = 0; ai < 2; ++ai)
#pragma unroll
            for (int m = 0; m < 4; ++m) { bf16_t* rowp = O + (size_t)(row0 + ai * HALF + m * 16) * ldc + col0;
#pragma unroll
                for (int bj = 0; bj < 2; ++bj) { const f32x4 v0 = acc[ai][bj][m][0], v1 = acc[ai][bj][m][1];
                    u32x4 w; w.x = cvt_pk_bf16(v0[0], v0[1]); w.y = cvt_pk_bf16(v0[2], v0[3]); w.z = cvt_pk_bf16(v1[0], v1[1]); w.w = cvt_pk_bf16(v1[2], v1[3]);
                    *(u32x4*)(rowp + bj * HALF) = w; } }
    }
};
struct EpiK {
    static constexpr bool PERM = true, BIAS_LDS = false; static constexpr int BIAS_OFF = 0;
    unsigned char* KB;
    __device__ __forceinline__ void operator()(const f32x4 (&acc)[2][2][4][2], const Unit& u, int wr, int wc, int fr, int fq) const {
        const int row0 = u.pm * BM + wr * 64 + fr, cw = wc * 32 + 8 * fq;
        unsigned char* base = KB + (u.pn * 2) * 192 + cw;
#pragma unroll
        for (int ai = 0; ai < 2; ++ai)
#pragma unroll
            for (int m = 0; m < 4; ++m) { unsigned char* rowp = base + (size_t)(row0 + ai * HALF + m * 16) * 768;
#pragma unroll
                for (int bj = 0; bj < 2; ++bj) { const f32x4 v0 = acc[ai][bj][m][0] * QK_Q, v1 = acc[ai][bj][m][1] * QK_Q;
                    u32x2 w; w.x = pk4_fp8(v0[0], v0[1], v0[2], v0[3]); w.y = pk4_fp8(v1[0], v1[1], v1[2], v1[3]);
                    *(u32x2*)(rowp + bj * 192) = w; } }
    }
};
struct EpiVT {
    static constexpr bool PERM = true, BIAS_LDS = false; static constexpr int BIAS_OFF = 0;
    unsigned char* VT;
    __device__ __forceinline__ void operator()(const f32x4 (&acc)[2][2][4][2], const Unit& u, int wr, int wc, int fr, int fq) const {
        const int row0 = u.pm * BM + wr * 64 + fr, col0 = u.pn * BM + wc * 32 + 8 * fq;
#pragma unroll
        for (int bj = 0; bj < 2; ++bj) {
            const int n = col0 + bj * HALF;
            const int b = (n < NCTX) ? (n >> 8) : ((n - NCTX) >> 13); const int key = (n < NCTX) ? (n & 255) : CTXL + ((n - NCTX) & 8191);
            const int tile = key >> 6, kk0 = key & 63; const int boff = (kk0 >> 5) * 16 + 4 * ((kk0 & 31) >> 3);
#pragma unroll
            for (int ai = 0; ai < 2; ++ai)
#pragma unroll
                for (int m = 0; m < 4; ++m) { const int vc = row0 + ai * HALF + m * 16; const int hh = vc >> 7, v = vc & 127;
                    unsigned char* p = VT + ((size_t)((b * 4 + hh) * (KEYS / 64) + tile)) * VT_TILE + v * VT_ROW + boff;
                    const f32x4 v0 = acc[ai][bj][m][0] * PV_Q, v1 = acc[ai][bj][m][1] * PV_Q;
                    *(unsigned*)p = pk4_fp8(v0[0], v0[1], v0[2], v0[3]); *(unsigned*)(p + 32) = pk4_fp8(v1[0], v1[1], v1[2], v1[3]); } }
    }
};
struct EpiSwiglu {
    static constexpr bool PERM = true, BIAS_LDS = true; static constexpr int BIAS_OFF = RING_BYTES + 12288;
    unsigned char* ACT; const float* bias;
    __device__ __forceinline__ const float* bias_src(const Unit& u) const { return bias + (u.pn >> 3) * 2048 + (u.pn & 7) * BM; }
    __device__ __forceinline__ void operator()(const f32x4 (&acc)[2][2][4][2], const Unit& u, int wr, int wc, int fr, int fq, const LAS float* bl) const {
        const int pnl = u.pn & 7;
        const int row0 = u.pm * BM + wr * 64 + fr, cl = wc * 32 + 8 * fq, col0 = pnl * BM + cl;
#pragma unroll
        for (int ai = 0; ai < 2; ++ai)
#pragma unroll
            for (int m = 0; m < 4; ++m) { unsigned char* rowp = ACT + (size_t)(row0 + ai * HALF + m * 16) * 1024 + (col0 >> 1);
#pragma unroll
                for (int bj = 0; bj < 2; ++bj) { const f32x4 v0 = acc[ai][bj][m][0] + *(const LAS f32x4*)(bl + cl + bj * HALF), v1 = acc[ai][bj][m][1] + *(const LAS f32x4*)(bl + cl + bj * HALF + 4);
                    float o[4];
#pragma unroll
                    for (int i = 0; i < 4; ++i) { const float hg = (i < 2) ? v0[2 * i] : v1[2 * i - 4], hl = (i < 2) ? v0[2 * i + 1] : v1[2 * i - 3];
                        const float glu = fminf(hg, 7.f), lin = fminf(fmaxf(hl, -7.f), 7.f);
                        o[i] = glu * sigmoidf_(1.702f * glu) * (lin + 1.f); }
                    *(unsigned*)(rowp + bj * (HALF / 2)) = pk4_fp8(o[0] * ACT_Q, o[1] * ACT_Q, o[2] * ACT_Q, o[3] * ACT_Q); } }
    }
};
struct EpiDown {
    static constexpr bool PERM = true, BIAS_LDS = true; static constexpr int BIAS_OFF = RING_BYTES + 12288;
    unsigned char* O; const float* bias;
    __device__ __forceinline__ const float* bias_src(const Unit& u) const { return bias + (u.pn >> 2) * 1024 + (u.pn & 3) * BM; }
    __device__ __forceinline__ void operator()(const f32x4 (&acc)[2][2][4][2], const Unit& u, int wr, int wc, int fr, int fq, const LAS float* bl) const {
        const int pnl = u.pn & 3;
        const int row0 = u.pm * BM + wr * 64 + fr, cl = wc * 32 + 8 * fq, col0 = pnl * BM + cl;
#pragma unroll
        for (int ai = 0; ai < 2; ++ai)
#pragma unroll
            for (int m = 0; m < 4; ++m) { unsigned char* rowp = O + (size_t)(row0 + ai * HALF + m * 16) * 1024 + col0;
#pragma unroll
                for (int bj = 0; bj < 2; ++bj) { const f32x4 v0 = (acc[ai][bj][m][0] + *(const LAS f32x4*)(bl + cl + bj * HALF)) * DO_Q, v1 = (acc[ai][bj][m][1] + *(const LAS f32x4*)(bl + cl + bj * HALF + 4)) * DO_Q;
                    u32x2 w; w.x = pk4_fp8(v0[0], v0[1], v0[2], v0[3]); w.y = pk4_fp8(v1[0], v1[1], v1[2], v1[3]);
                    *(u32x2*)(rowp + bj * HALF) = w; } }
    }
};
}

namespace att {
constexpr int DQK = 192, DV = 128, NW = 8, QBLK = 32, KVBLK = 64;
constexpr int LDQ = 768, LDK = 768, LDV = 512, LDO = 1024;
constexpr float THR = 4.f;
constexpr int KROWB = 208;
constexpr int SHM_V = VT_TILE, SHM_K = KVBLK * KROWB;
constexpr int SHM_QR = 2 * SHM_V + 2 * SHM_K + NW * 64 * 4;
constexpr int SHM_ATTN = SHM_QR + NW * 4096;
#define KSWZ192(row, colB) ((row) * KROWB + (colB))
#define SBAR() __builtin_amdgcn_sched_barrier(0)
__device__ __forceinline__ int crow(int r, int hi) { return (r & 3) + 8 * (r >> 2) + 4 * hi; }
__device__ __forceinline__ float max3f(float a, float b, float c) { return fmaxf(fmaxf(a, b), c); }
__device__ __forceinline__ unsigned cvtpk(float lo, float hi) { unsigned r; asm volatile("v_cvt_pk_bf16_f32 %0, %1, %2" : "=v"(r) : "v"(lo), "v"(hi)); return r; }
constexpr float PSH = 3.f, THR2 = THR * 1.4426950408889634f;
__device__ __forceinline__ void partialSM(f32x16& p0, f32x16& p1, float& m_reg, float& alpha, const bool first) {
    float ma = max3f(p0[0], p0[1], p0[2]), mb = max3f(p0[3], p0[4], p0[5]), mc = max3f(p0[6], p0[7], p0[8]), md = max3f(p0[9], p0[10], p0[11]);
    ma = max3f(ma, p0[12], p0[13]); mb = max3f(mb, p0[14], p0[15]); mc = max3f(mc, p1[0], p1[1]); md = max3f(md, p1[2], p1[3]);
    ma = max3f(ma, p1[4], p1[5]); mb = max3f(mb, p1[6], p1[7]); mc = max3f(mc, p1[8], p1[9]); md = max3f(md, p1[10], p1[11]);
    ma = max3f(ma, p1[12], p1[13]); mb = max3f(mb, p1[14], p1[15]);
    float pmax = fmaxf(max3f(ma, mb, mc), md);
    { auto rr = __builtin_amdgcn_permlane32_swap(__float_as_uint(pmax), __float_as_uint(pmax), false, false);
      pmax = fmaxf(__uint_as_float(rr[0]), __uint_as_float(rr[1])); }
    const float u = pmax - PSH;
    if (__builtin_expect(!first && __all(u <= THR2), 1)) { alpha = 1.f; }
    else { const float dl = first ? u : fmaxf(u, 0.f); alpha = __builtin_amdgcn_exp2f(-dl); m_reg += dl;
#pragma unroll
        for (int r = 0; r < 16; ++r) { p0[r] -= dl; p1[r] -= dl; } }
#pragma unroll
    for (int r = 0; r < 16; ++r) p0[r] = __builtin_amdgcn_exp2f(p0[r]);
}
__device__ __forceinline__ void finishSM(f32x16& p0, f32x16& p1, float alpha, float& l_reg, v8i& pa) {
#pragma unroll
    for (int r = 0; r < 16; ++r) p1[r] = __builtin_amdgcn_exp2f(p1[r]);
    float sa = p0[0] + p0[1], sb = p0[2] + p0[3], sc = p0[4] + p0[5], sd = p0[6] + p0[7];
    sa += p0[8]; sb += p0[9]; sc += p0[10]; sd += p0[11]; sa += p0[12]; sb += p0[13]; sc += p0[14]; sd += p0[15];
#pragma unroll
    for (int r = 0; r < 16; r += 4) { sa += p1[r]; sb += p1[r + 1]; sc += p1[r + 2]; sd += p1[r + 3]; }
    float ps = (sa + sb) + (sc + sd);
    { auto rr = __builtin_amdgcn_permlane32_swap(__float_as_uint(ps), __float_as_uint(ps), false, false);
      ps = __uint_as_float(rr[0]) + __uint_as_float(rr[1]); }
    l_reg = l_reg * alpha + ps;
#pragma unroll
    for (int c = 0; c < 4; ++c) { pa[c] = (int)pk4_fp8(p0[4 * c], p0[4 * c + 1], p0[4 * c + 2], p0[4 * c + 3]);
        pa[4 + c] = (int)pk4_fp8(p1[4 * c], p1[4 * c + 1], p1[4 * c + 2], p1[4 * c + 3]); }
}
__device__ __forceinline__ void qkt(f32x16& p0, f32x16& p1, const float m_reg, const char* Ks, const v8i* q8, int r32, int hi) {
    { const float ini = PSH - m_reg;
#pragma unroll
      for (int r = 0; r < 16; ++r) { p0[r] = ini; p1[r] = ini; } }
#pragma unroll
    for (int ks = 0; ks < 3; ++ks) { const char* kp = Ks + r32 * KROWB + ks * 64 + hi * 32;
        const v8i a0 = __builtin_shufflevector(*reinterpret_cast<const v4i*>(kp), *reinterpret_cast<const v4i*>(kp + 16), 0, 1, 2, 3, 4, 5, 6, 7);
        const v8i a1 = __builtin_shufflevector(*reinterpret_cast<const v4i*>(kp + 32 * KROWB), *reinterpret_cast<const v4i*>(kp + 32 * KROWB + 16), 0, 1, 2, 3, 4, 5, 6, 7);
        p0 = __builtin_amdgcn_mfma_scale_f32_32x32x64_f8f6f4(a0, q8[ks], p0, 0, 0, 0, QK_E, 0, QC_E);
        p1 = __builtin_amdgcn_mfma_scale_f32_32x32x64_f8f6f4(a1, q8[ks], p1, 0, 0, 0, QK_E, 0, QC_E); }
}
__device__ __forceinline__ void pv_d0(f32x16* o, const char* Vs, const v8i pa, int r32, int hi) {
#pragma unroll
    for (int d0 = 0; d0 < 4; ++d0) { const char* vp = Vs + (d0 * 32 + r32) * VT_ROW + hi * 32;
        const v8i bv = __builtin_shufflevector(*reinterpret_cast<const v4i*>(vp), *reinterpret_cast<const v4i*>(vp + 16), 0, 1, 2, 3, 4, 5, 6, 7);
        o[d0] = __builtin_amdgcn_mfma_scale_f32_32x32x64_f8f6f4(pa, bv, o[d0], 0, 0, 0, PV_E, 0, PV_E); }
}
constexpr int ABUF = SHM_K + SHM_V;
constexpr int SHM_ATTN3 = 3 * ABUF + NW * 64 * 4;
__device__ __forceinline__ void attn_unit(const bf16_t* Qb, const unsigned char* Kh, const unsigned char* Vh, bf16_t* Ob, int seq, int cbase, int lbase, int t0, const f32x2* atab, char* lds, const int wave_s) {
    int tid_ = wave_s * 64 + lane_id(); asm volatile("" : "+v"(tid_));
    const int tid = tid_, wid = wave_s, lane = tid & 63, r32 = lane & 31, hi = lane >> 5;
    float* ws = (float*)(lds + 3 * ABUF) + wid * 64; float* li_l = ws; float* al_l = ws + 32;
    float m_reg = 0.f, l_reg = 0; f32x16 o[4] = {}; v8i qr[3];
    const bf16_t* Qw = Qb + (long)(wid * QBLK + r32) * LDQ + hi * 32;
#pragma unroll
    for (int ks = 0; ks < 3; ++ks) {
        float x[32];
#pragma unroll
        for (int c4 = 0; c4 < 4; ++c4) { const u32x4 w = *reinterpret_cast<const u32x4*>(Qw + ks * 64 + c4 * 8);
            x[8 * c4 + 0] = bflo(w.x); x[8 * c4 + 1] = bfhi(w.x); x[8 * c4 + 2] = bflo(w.y); x[8 * c4 + 3] = bfhi(w.y); x[8 * c4 + 4] = bflo(w.z); x[8 * c4 + 5] = bfhi(w.z); x[8 * c4 + 6] = bflo(w.w); x[8 * c4 + 7] = bfhi(w.w); }
        if (ks == 2 && t0 >= 0) { const int t = t0 + wid * QBLK + r32; const int pos = hi ? (t & 63) : (t >> 6); const f32x2* tb = atab + pos * 16;
#pragma unroll
            for (int f = 0; f < 16; ++f) { const f32x2 cs = tb[f]; const float a = x[2 * f], b = x[2 * f + 1]; x[2 * f] = a * cs.x - b * cs.y; x[2 * f + 1] = b * cs.x + a * cs.y; } }
        v8i q;
#pragma unroll
        for (int c = 0; c < 8; ++c) q[c] = (int)pk4_fp8(x[4 * c] * QC_Q, x[4 * c + 1] * QC_Q, x[4 * c + 2] * QC_Q, x[4 * c + 3] * QC_Q);
        qr[ks] = q; }
    unsigned kq[2];
#pragma unroll
    for (int i = 0; i < 2; ++i) { const int c = (i * 8 + wid) * 64 + lane; const int r = c / 13, cc = c % 13; kq[i] = (unsigned)((r < 64 ? r : 63) * LDK + (cc < 12 ? cc : 11) * 16); }
    const unsigned vq0 = (unsigned)(wid * 1024 + lane * 16);
    LAS unsigned char* ldsl = (LAS unsigned char*)(uintptr_t)(unsigned)(uintptr_t)lds;
#define DMA_TILE(jt, buf) do { const int kr_ = ((jt) < 4) ? cbase + 64 * (jt) : lbase + 64 * ((jt) - 4); const char* kp_ = (const char*)Kh + (size_t)kr_ * LDK; const char* vp_ = (const char*)Vh + (size_t)(jt) * VT_TILE + vq0; \
    LAS unsigned char* kb_ = ldsl + (buf) * ABUF + wid * 1024; LAS unsigned char* vb_ = kb_ + SHM_K; \
    __builtin_amdgcn_global_load_lds((const unsigned*)(kp_ + kq[0]), (LAS unsigned*)(kb_), 16, 0, 0); \
    if (wid < 5) __builtin_amdgcn_global_load_lds((const unsigned*)(kp_ + kq[1]), (LAS unsigned*)(kb_ + 8192), 16, 0, 0); \
    __builtin_amdgcn_global_load_lds((const unsigned*)(vp_), (LAS unsigned*)(vb_), 16, 0, 0); \
    if (wid < 2) __builtin_amdgcn_global_load_lds((const unsigned*)(vp_ + 8192), (LAS unsigned*)(vb_ + 8192), 16, 0, 0); } while (0)
#define WAITBAR() do { asm volatile("s_waitcnt vmcnt(0)" ::: "memory"); __syncthreads(); } while (0)
#define RESC(a) do { if (__any((a) < 1.f)) { if (hi == 0) al_l[r32] = (a); asm volatile("s_waitcnt lgkmcnt(0)" ::: "memory"); \
    _Pragma("unroll") for (int d = 0; d < 4; ++d) _Pragma("unroll") for (int r = 0; r < 16; ++r) o[d][r] *= al_l[crow(r, hi)]; } } while (0)
#define KBUF(b) (lds + (b) * ABUF)
#define VBASE(b) (lds + (b) * ABUF + SHM_K)
    f32x16 pA0, pA1, pB0, pB1; float alA, alB; v8i pa; const int NT = seq / KVBLK;
    DMA_TILE(0, 0); DMA_TILE(1, 1); WAITBAR();
    qkt(pA0, pA1, m_reg, KBUF(0), qr, r32, hi); partialSM(pA0, pA1, m_reg, alA, true);
    int bprev = 0, bj = 1;
    for (int j = 1; j + 1 < NT; j += 2) {
        { const int bn = 3 - bprev - bj; DMA_TILE(j + 1, bn);
          SBAR(); qkt(pB0, pB1, m_reg, KBUF(bj), qr, r32, hi);
          finishSM(pA0, pA1, alA, l_reg, pa); SBAR();
          pv_d0(o, VBASE(bprev), pa, r32, hi); partialSM(pB0, pB1, m_reg, alB, false);
          RESC(alB); WAITBAR(); bprev = bj; bj = bn; }
        { const int bn = 3 - bprev - bj; if (j + 2 < NT) DMA_TILE(j + 2, bn);
          SBAR(); qkt(pA0, pA1, m_reg, KBUF(bj), qr, r32, hi);
          finishSM(pB0, pB1, alB, l_reg, pa); SBAR();
          pv_d0(o, VBASE(bprev), pa, r32, hi); partialSM(pA0, pA1, m_reg, alA, false);
          RESC(alA); WAITBAR(); bprev = bj; bj = bn; }
    }
    SBAR(); qkt(pB0, pB1, m_reg, KBUF(bj), qr, r32, hi);
    finishSM(pA0, pA1, alA, l_reg, pa); SBAR();
    pv_d0(o, VBASE(bprev), pa, r32, hi); partialSM(pB0, pB1, m_reg, alB, false);
    RESC(alB);
    finishSM(pB0, pB1, alB, l_reg, pa); SBAR();
    pv_d0(o, VBASE(bj), pa, r32, hi);
    if (hi == 0) li_l[r32] = l_reg; asm volatile("s_waitcnt lgkmcnt(0)" ::: "memory");
    float rli[16];
#pragma unroll
    for (int r = 0; r < 16; ++r) rli[r] = 8.f * __builtin_amdgcn_rcpf(li_l[crow(r, hi)]);
    bf16_t* Ow = Ob + (long)(wid * QBLK) * LDO;
#pragma unroll
    for (int r = 0; r < 16; ++r) { const int orow = crow(r, hi);
#pragma unroll
        for (int d0 = 0; d0 < 4; ++d0) Ow[(long)orow * LDO + d0 * 32 + r32] = (bf16_t)f2bf(o[d0][r] * rli[r]); }
    __syncthreads();
#undef DMA_TILE
#undef WAITBAR
#undef RESC
#undef KBUF
#undef VBASE
}
}

struct Args { const float* in[28]; float* out; unsigned char* ws; int ph_lo, ph_hi; };
enum { I_X = 0, I_C, I_CTX, I_CCTX, I_ADAW, I_ADAB, I_WIN, I_QNG, I_KVNG, I_WUQ, I_WUKV, I_SGNG, I_SGNB, I_SGW, I_SGB, I_RDF, I_RDB, I_WO, I_LN1G, I_LN1B, I_RW, I_RB, I_WGU, I_BGU, I_WDN, I_BDN, I_LN2G, I_LN2B };

template <int QPERM>
__device__ __forceinline__ void transpose_item(const float* W, int K, int N, bf16_t* WT, LAS float* scr, int item, int lane) {
    const int nblk = N / 32, kb = item / nblk, nb = item % nblk, k0 = 64 * kb, n0 = 32 * nb;
#pragma unroll 8
    for (int i = 0; i < 32; ++i) { const int kk = 2 * i + (lane >> 5); scr[kk * 33 + (lane & 31)] = W[(size_t)(k0 + kk) * N + n0 + (lane & 31)]; }
    asm volatile("s_waitcnt lgkmcnt(0)" ::: "memory");
    const int c = lane & 7;
#pragma unroll
    for (int j = 0; j < 4; ++j) { const int n = (lane >> 3) + 8 * j; const LAS float* s = scr + (8 * c) * 33 + n;
        u32x4 o; o.x = pk2(s[0 * 33], s[1 * 33]); o.y = pk2(s[2 * 33], s[3 * 33]); o.z = pk2(s[4 * 33], s[5 * 33]); o.w = pk2(s[6 * 33], s[7 * 33]);
        int dn = n0 + n;
        if (QPERM == 1) { const int h = dn / 192, d = dn % 192; if (d >= 128) { const int jj = d - 128, a = jj >> 5, p = (jj >> 4) & 1, f = jj & 15; dn = h * 192 + 128 + 2 * (a * 16 + f) + p; } }
        if (QPERM == 2) { const int h = dn >> 8, j = dn & 255; dn = (j < 128) ? h * 128 + j : 512 + h * 128 + (j - 128); }
        *(u32x4*)(WT + (size_t)dn * K + k0 + 8 * c) = o; }
    asm volatile("s_waitcnt lgkmcnt(0)" ::: "memory");
}

__device__ __forceinline__ void transpose_item_fp8(const float* W, int K, int N, unsigned char* WT, float q, LAS float* scr, int item, int lane) {
    const int nblk = N / 32, kb = item / nblk, nb = item % nblk, k0 = 64 * kb, n0 = 32 * nb;
#pragma unroll 8
    for (int i = 0; i < 32; ++i) { const int kk = 2 * i + (lane >> 5); scr[kk * 33 + (lane & 31)] = W[(size_t)(k0 + kk) * N + n0 + (lane & 31)]; }
    asm volatile("s_waitcnt lgkmcnt(0)" ::: "memory");
    const int c = lane & 7;
#pragma unroll
    for (int j = 0; j < 4; ++j) { const int n = (lane >> 3) + 8 * j; const LAS float* s = scr + (8 * c) * 33 + n;
        u32x2 o; o.x = pk4_fp8(s[0 * 33] * q, s[1 * 33] * q, s[2 * 33] * q, s[3 * 33] * q); o.y = pk4_fp8(s[4 * 33] * q, s[5 * 33] * q, s[6 * 33] * q, s[7 * 33] * q);
        *(u32x2*)(WT + (size_t)(n0 + n) * K + k0 + 8 * c) = o; }
    asm volatile("s_waitcnt lgkmcnt(0)" ::: "memory");
}

__device__ __forceinline__ void transpose_item_fp8w(const float* W, int K, int N, unsigned char* WT, float q, LAS unsigned char* scr, int item, int lane) {
    const int nblk = N / 128, kb = item / nblk, nb = item % nblk, k0 = 64 * kb, n0 = 128 * nb;
    const int l5 = lane & 31, h = lane >> 5;
    const float* src = W + (size_t)(k0 + 16 * h) * N + n0 + 4 * l5;
#pragma unroll
    for (int b = 0; b < 2; ++b) {
        f32x4 x[16];
#pragma unroll
        for (int s_ = 0; s_ < 16; ++s_) x[s_] = *(const f32x4*)(src + (size_t)(32 * b + s_) * N);
#pragma unroll
        for (int i = 0; i < 4; ++i) {
            u32x4 o;
            o.x = pk4_fp8(x[0][i] * q, x[1][i] * q, x[2][i] * q, x[3][i] * q); o.y = pk4_fp8(x[4][i] * q, x[5][i] * q, x[6][i] * q, x[7][i] * q);
            o.z = pk4_fp8(x[8][i] * q, x[9][i] * q, x[10][i] * q, x[11][i] * q); o.w = pk4_fp8(x[12][i] * q, x[13][i] * q, x[14][i] * q, x[15][i] * q);
            *(LAS u32x4*)(scr + (l5 + 32 * i) * 80 + (2 * b + h) * 16) = o; }
    }
    asm volatile("s_waitcnt lgkmcnt(0)" ::: "memory");
#pragma unroll
    for (int qd = 0; qd < 8; ++qd) {
        const int rho = 16 * qd + (lane >> 2), piece = lane & 3;
        const u32x4 o = *(const LAS u32x4*)(scr + rho * 80 + piece * 16);
        const int nl = 4 * (rho & 31) + (rho >> 5);
        *(u32x4*)(WT + (size_t)(n0 + nl) * K + k0 + piece * 16) = o; }
    asm volatile("s_waitcnt lgkmcnt(0)" ::: "memory");
}

__global__ void __launch_bounds__(512, 2) mega(Args a) {
    extern __shared__ __attribute__((aligned(16))) unsigned char lds_raw[];
    LAS unsigned char* lds = (LAS unsigned char*)lds_raw;
    const int G = gridDim.x, bx = blockIdx.x;
    const int wave_s = __builtin_amdgcn_readfirstlane(threadIdx.x >> 6);
    const int vcu = (G % 8 == 0) ? (bx % 8) * (G / 8) + bx / 8 : bx;
    const int NGW = G * 8;
#define PH_IDS() int lane_ = lane_id(); asm volatile("" : "+v"(lane_)); const int lane = lane_; const int wave = wave_s; const int tid = wave * 64 + lane; const int gw = vcu * 8 + wave; (void)lane; (void)gw; (void)tid
    unsigned char* ws = a.ws;
    unsigned* ctl = (unsigned*)(ws + WS_CTL);
    volatile LAS unsigned* MISC = (volatile LAS unsigned*)(lds + MISC_OFF);
    for (int u = threadIdx.x; u < (LDS_BYTES - RING_BYTES) / 4; u += 512) ((LAS unsigned*)(lds + RING_BYTES))[u] = 0u;
    __syncthreads();
    const int lo = a.ph_lo, hi = a.ph_hi;
    XcdBarrier bar; bar.bar = ctl + CW_BAR; bar.x = 0; bar.st = MISC + 8;
    if (hi - lo > 1) bar = xcd_barrier_post(ctl + CW_BAR, MISC + 8);
    bar.wave = wave_s;
#ifndef MK_ONLY
#define MK_ONLY -1
#endif
#ifndef MK_MASK
#define MK_MASK 0xFFF
#endif
#define EN(q) ((MK_ONLY < 0 || MK_ONLY == (q)) && ((MK_MASK >> (q)) & 1))
#ifndef MK_REP_PHASE
#define MK_REP_PHASE -1
#endif
#ifndef MK_REP_N
#define MK_REP_N 1
#endif
#define REPS(q) ((MK_REP_PHASE == (q)) ? MK_REP_N : 1)
#ifndef MK_SUB
#define MK_SUB 15
#endif
#define SUB(m) ((MK_SUB & (m)) != 0)
#define XROW0(n_) (((n_) < NCTX) ? a.in[I_CTX] + (size_t)(n_) * DM : a.in[I_X] + (size_t)((n_) - NCTX) * DM)
#define XLOAD(dst_, l_, n_, j_) do { if ((l_) == 0) dst_ = *((const f32x4*)XROW0(n_) + lane + 64 * (j_)); else { const u32x2 w_ = *((const u32x2*)(XRB + (size_t)(n_) * DM) + lane + 64 * (j_)); dst_ = (f32x4){__uint_as_float(w_.x), __uint_as_float(w_.y), 0.f, 0.f}; } } while (0)
#define XVAL(src_, l_) (((l_) == 0) ? (src_) : (f32x4){bflo(__float_as_uint((src_).x)), bfhi(__float_as_uint((src_).x)), bflo(__float_as_uint((src_).y)), bfhi(__float_as_uint((src_).y))})
#define IN(k) (lo <= (k) && (k) < hi)
#define SEAM(k) do { if (IN(k) && IN((k) + 1)) xcd_barrier(bar); } while (0)

    float* MOD = (float*)(ws + WS_MOD);
    f32x2* ATAB = (f32x2*)(ws + WS_ATAB);
    f32x2* RTAB = (f32x2*)(ws + WS_RTAB);
    unsigned char* WIN8 = ws + WS_WIN; bf16_t* WUQ = (bf16_t*)(ws + WS_WUQ); bf16_t* WUKV = (bf16_t*)(ws + WS_WUKV); bf16_t* WOT = (bf16_t*)(ws + WS_WO);
    unsigned char* WGU = ws + WS_WGU; unsigned char* WDN = ws + WS_WDN; unsigned char* XH8 = ws + WS_XH8; bf16_t* SGWB = (bf16_t*)(ws + WS_SGWB);
    bf16_t* XRB = (bf16_t*)(ws + WS_XRES); unsigned char* XHF = ws + WS_XH; bf16_t* PROJ = (bf16_t*)(ws + WS_PROJ);
    bf16_t* CQN = (bf16_t*)(ws + WS_CQN); bf16_t* CKVN = (bf16_t*)(ws + WS_CKVN);
    bf16_t* QB = (bf16_t*)(ws + WS_QB); unsigned char* KB = ws + WS_KB; unsigned char* VT8 = ws + WS_VB;
    float* SLOC = (float*)(ws + WS_SGU); float* SIN = (float*)(ws + WS_SGV);
    float* RQ = (float*)(ws + WS_RQ); float* RK = (float*)(ws + WS_RK); float* OF = (float*)(ws + WS_OF); float* OB = (float*)(ws + WS_OB);
    bf16_t* MIX = (bf16_t*)(ws + WS_MIX); bf16_t* YB = (bf16_t*)(ws + WS_Y);
    int* TOPI = (int*)(ws + WS_TOPI); float* GATE = (float*)(ws + WS_GATE); int* DEST = (int*)(ws + WS_DEST); int* ROWTOK = (int*)(ws + WS_ROWTOK);
    unsigned char* ACT = ws + WS_ACT; unsigned char* DOUT = ws + WS_DOUT;

    constexpr int IT_IN = 16 * 62, IT_UQ = 6 * 24, IT_UKV = 4 * 32, IT_O = 16 * 32, IT_SMALL = IT_IN + IT_UQ + IT_UKV + IT_O, IT_GU = 16 * 16, IT_DN = 16 * 8;
    constexpr int IT_LAYER = IT_SMALL + 32 * IT_GU + 32 * IT_DN;
#define CONVERT_ITEM(L_, it_) do { int r_ = (it_); const int cl_ = (L_); \
        if (r_ < IT_IN) { transpose_item_fp8(a.in[I_WIN] + (size_t)cl_ * 1024 * 1984, 1024, 1984, WIN8 + (size_t)cl_ * 2048 * 1024, WGU_Q, scr, r_, lane); break; } r_ -= IT_IN; \
        if (r_ < IT_UQ) { transpose_item<1>(a.in[I_WUQ] + (size_t)cl_ * 384 * 768, 384, 768, WUQ + (size_t)cl_ * 768 * 384, scr, r_, lane); break; } r_ -= IT_UQ; \
        if (r_ < IT_UKV) { transpose_item<2>(a.in[I_WUKV] + (size_t)cl_ * 256 * 1024, 256, 1024, WUKV + (size_t)cl_ * 1024 * 256, scr, r_, lane); break; } r_ -= IT_UKV; \
        if (r_ < IT_O) { transpose_item<0>(a.in[I_WO] + (size_t)cl_ * 1024 * 1024, 1024, 1024, WOT + (size_t)cl_ * 1024 * 1024, scr, r_, lane); break; } r_ -= IT_O; \
        if (r_ < 32 * IT_GU) { const int mtx_ = cl_ * 32 + r_ / IT_GU; r_ %= IT_GU; transpose_item_fp8w(a.in[I_WGU] + (size_t)mtx_ * 1024 * 2048, 1024, 2048, WGU + (size_t)mtx_ * 2048 * 1024, WGU_Q, (LAS unsigned char*)scr, r_, lane); break; } r_ -= 32 * IT_GU; \
        { const int mtx_ = cl_ * 32 + r_ / IT_DN; r_ %= IT_DN; transpose_item_fp8w(a.in[I_WDN] + (size_t)mtx_ * 1024 * 1024, 1024, 1024, WDN + (size_t)mtx_ * 1024 * 1024, WDN_Q, (LAS unsigned char*)scr, r_, lane); } } while (0)

    for (int rep_ = 0; rep_ < REPS(10); ++rep_) if (EN(10) && IN(0)) { PH_IDS();
        {
            LAS float* sc = (LAS float*)lds;
            LAS float* red = (LAS float*)(lds + 20480);
            { float cv_[10];
#pragma unroll
              for (int u_ = 0; u_ < 10; ++u_) { const int i = tid + 512 * u_; const int s = i >> 10, k = i & 1023; cv_[u_] = (s < 4) ? a.in[I_C][s * 1024 + k] : a.in[I_CCTX][k]; }
#pragma unroll
              for (int u_ = 0; u_ < 10; ++u_) sc[tid + 512 * u_] = cv_[u_] * sigmoidf_(cv_[u_]); }
            __syncthreads();
            for (int it = bx; it < 4 * 96; it += G) {
                const int l = it / 96, j0 = (it % 96) * 64;
                const float* wp = a.in[I_ADAW] + (size_t)l * 1024 * 6144 + j0 + lane;
                float s0 = 0, s1 = 0, s2 = 0, s3 = 0, s4 = 0;
#pragma unroll 8
                for (int kk = 0; kk < 128; ++kk) { const int k = wave * 128 + kk; const float w = wp[(size_t)k * 6144];
                    s0 += sc[k] * w; s1 += sc[1024 + k] * w; s2 += sc[2048 + k] * w; s3 += sc[3072 + k] * w; s4 += sc[4096 + k] * w; }
                red[(wave * 5 + 0) * 64 + lane] = s0; red[(wave * 5 + 1) * 64 + lane] = s1; red[(wave * 5 + 2) * 64 + lane] = s2; red[(wave * 5 + 3) * 64 + lane] = s3; red[(wave * 5 + 4) * 64 + lane] = s4;
                __syncthreads();
                if (tid < 320) { const int s = tid >> 6, jl = tid & 63; float v = 0;
#pragma unroll
                    for (int w = 0; w < 8; ++w) v += red[(w * 5 + s) * 64 + jl];
                    MOD[((size_t)l * 5 + s) * 6144 + j0 + jl] = v + a.in[I_ADAB][l * 6144 + j0 + jl]; }
                __syncthreads();
            }
        }
        for (int i = bx * 512 + tid; i < 128 * 16; i += G * 512) { float s, c; sincos_d((double)(i >> 4) * INV_A[i & 15], s, c); ATAB[i] = (f32x2){c, s}; }
        for (int i = bx * 512 + tid; i < KEYS * 16; i += G * 512) { float s, c; sincos_d((double)(i >> 4) * INV_R[i & 15], s, c); RTAB[i] = (f32x2){c, s}; }
        for (int i = bx * 512 + tid; i < 4 * 4 * 128 * 128 / 4; i += G * 512) { const f32x4 w = *((const f32x4*)a.in[I_SGW] + i); u32x2 o; o.x = pk2(w.x, w.y); o.y = pk2(w.z, w.w); *((u32x2*)SGWB + i) = o; }
        for (int i = bx * 512 + tid; i < 4 * 64 * 1024 / 16; i += G * 512) { const int l = i / (64 * 1024 / 16), r = i % (64 * 1024 / 16);
            *(u32x4*)(WIN8 + ((size_t)l * 2048 + 1984) * 1024 + (size_t)r * 16) = (u32x4){0u, 0u, 0u, 0u}; }
        {
            __syncthreads();
            LAS float* scr = (LAS float*)(lds + wave * 16384);
            for (int it = gw; it < IT_LAYER; it += NGW) CONVERT_ITEM(0, it);
            __syncthreads();
        }
    }
    SEAM(0);
    if (EN(11) && IN(1)) { PH_IDS();
        for (int n = gw; n < NTOK; n += 2 * NGW) {
            const int nn[2] = {n, (n + NGW < NTOK) ? n + NGW : n};
            f32x4 xv_[2][4], sh_[2][4], sc_[2][4];
#pragma unroll
            for (int t = 0; t < 2; ++t) { const float* md = MOD + (size_t)modset(nn[t]) * 6144; const f32x4* xr = (const f32x4*)XROW0(nn[t]) + lane;
#pragma unroll
                for (int j = 0; j < 4; ++j) { xv_[t][j] = xr[64 * j]; sh_[t][j] = *((const f32x4*)(md) + lane + 64 * j); sc_[t][j] = *((const f32x4*)(md + 1024) + lane + 64 * j); } }
#pragma unroll
            for (int t = 0; t < 2; ++t) { unsigned* o8 = (unsigned*)(XHF + (size_t)nn[t] * DM) + lane;
#pragma unroll
                for (int j = 0; j < 4; ++j) { const f32x4 v = xv_[t][j], sh = sh_[t][j], scl = sc_[t][j];
                    o8[64 * j] = pk4_fp8((v.x * (1.f + scl.x) + sh.x) * ACT_Q, (v.y * (1.f + scl.y) + sh.y) * ACT_Q, (v.z * (1.f + scl.z) + sh.z) * ACT_Q, (v.w * (1.f + scl.w) + sh.w) * ACT_Q); } }
        }
    }
    SEAM(1);

#pragma unroll 1
    for (int l = 0; l < NLAYER; ++l) {
        const int pb = 2 + 10 * l;
        const float* MODL = MOD + (size_t)l * 5 * 6144;
        for (int rep_ = 0; rep_ < REPS(0); ++rep_) if (EN(0) && IN(pb + 0)) { PH_IDS();
            pg8::Gemm g{XHF, WIN8 + (size_t)l * 2048 * 1024, 1024, 1024, nullptr, ACT_E, WGU_E};
            pg8::StaticOrder S; S.init(NTOK / 256, PROJW / 256, G, bx);
            pg8::EpiBf16 E{PROJ, PROJW};
            pg8::gemm_phase<pg8::EpiBf16, pg8::StaticOrder, false, true>(lds, g, S, E, wave_s);
        }
        SEAM(pb + 0);
        for (int rep_ = 0; rep_ < REPS(1); ++rep_) if (EN(1) && IN(pb + 1)) { PH_IDS();
            const float* qg = a.in[I_QNG] + l * 384; const float* kvg = a.in[I_KVNG] + l * 256;
            const float* sgg = a.in[I_SGNG] + l * 256; const float* sgb = a.in[I_SGNB] + l * 256;
            const float* sb = a.in[I_SGB] + l * 4 * 128;
            LAS float* ksr = (LAS float*)lds;
            LAS bf16_t* vsT = (LAS bf16_t*)(lds + 65536);
            constexpr int VST = 136;
            for (int T = vcu; T < NTOK / 128; T += G) {
                const int n0 = T * 128;
                float qgv[6];
#pragma unroll
                for (int j = 0; j < 3; ++j) { qgv[2 * j] = qg[lane * 2 + 128 * j]; qgv[2 * j + 1] = qg[lane * 2 + 128 * j + 1]; }
                const f32x4 kvgv = *(const f32x4*)(kvg + lane * 4), sggv = *(const f32x4*)(sgg + lane * 4), sgbv = *(const f32x4*)(sgb + lane * 4);
                const bool kvonly = (l == NLAYER - 1) && (n0 < NCTX);
                __syncthreads();
                for (int hb = 0; hb < 2; ++hb) {
                    unsigned cqw[8][3]; u32x2 ckw[8], sgw[8]; unsigned short krw[8], q1w[8], q2w[8], k1w[8], k2w[8]; f32x2 rcs[8], acs[8];
#pragma unroll
                    for (int k = 0; k < 8; ++k) {
                        const int n = n0 + wave * 16 + hb * 8 + k;
                        const bf16_t* pr = PROJ + (size_t)n * PROJW;
                        const bool lat = n >= NCTX; const int t = (n - NCTX) & 8191; const int upos = lat ? CTXL + t : (n & 255);
#pragma unroll
                        for (int j = 0; j < 3; ++j) cqw[k][j] = *(const unsigned*)(pr + C_CQ + lane * 2 + 128 * j);
                        ckw[k] = *(const u32x2*)(pr + C_CKV + lane * 4); sgw[k] = *(const u32x2*)(pr + C_SGV + lane * 4);
                        krw[k] = pr[C_KR + lane];
                        { const int h = lane >> 4, i = lane & 15; q1w[k] = pr[C_RQ + h * 32 + i]; q2w[k] = pr[C_RQ + h * 32 + 16 + i]; k1w[k] = pr[C_RK + h * 32 + i]; k2w[k] = pr[C_RK + h * 32 + 16 + i]; rcs[k] = RTAB[upos * 16 + i]; }
                        { const int aa = lane >> 5, f = lane & 15; const int pos = lat ? (aa ? (t & 63) : (t >> 6)) : 0; acs[k] = ATAB[pos * 16 + f]; }
                    }
                    __builtin_amdgcn_sched_barrier(0);
#pragma unroll
                    for (int k = 0; k < 8; ++k) {
                        __builtin_amdgcn_sched_barrier(0);
                        const int tl = wave * 16 + hb * 8 + k, n = n0 + tl;
                        if (!kvonly) {
                            float v[6]; float ss = 0;
#pragma unroll
                            for (int j = 0; j < 3; ++j) { const unsigned w = cqw[k][j]; v[2 * j] = bflo(w); v[2 * j + 1] = bfhi(w); ss += v[2 * j] * v[2 * j] + v[2 * j + 1] * v[2 * j + 1]; }
                            const float rs = rsqrtf(wave_sum(ss) * (1.f / 384.f) + RMS_EPS);
#pragma unroll
                            for (int j = 0; j < 3; ++j) { const int c = lane * 2 + 128 * j; *(unsigned*)(CQN + (size_t)n * 384 + c) = pk2(v[2 * j] * rs * qgv[2 * j], v[2 * j + 1] * rs * qgv[2 * j + 1]); }
                        }
                        {
                            const u32x2 w = ckw[k];
                            const float v0 = bflo(w.x), v1 = bfhi(w.x), v2 = bflo(w.y), v3 = bfhi(w.y);
                            const float rs = rsqrtf(wave_sum(v0 * v0 + v1 * v1 + v2 * v2 + v3 * v3) * (1.f / 256.f) + RMS_EPS);
                            const f32x4 gg = kvgv;
                            u32x2 o; o.x = pk2(v0 * rs * gg.x, v1 * rs * gg.y); o.y = pk2(v2 * rs * gg.z, v3 * rs * gg.w);
                            *(u32x2*)(CKVN + (size_t)n * 256 + lane * 4) = o;
                        }
                        {
                            const float x = bf2f(krw[k]); const float xp = __shfl_xor(x, 16);
                            const int aa = lane >> 5, p = (lane >> 4) & 1, f = lane & 15; const f32x2 cs = acs[k];
                            const float o = p ? (x * cs.x + xp * cs.y) : (x * cs.x - xp * cs.y);
                            const int dd = 128 + 2 * (aa * 16 + f) + p; const unsigned char ob = (unsigned char)(pk4_fp8(o * QK_Q, 0.f, 0.f, 0.f) & 0xffu);
                            unsigned char* kd = KB + (size_t)n * 768 + dd;
                            kd[0] = ob; kd[192] = ob; kd[384] = ob; kd[576] = ob;
                        }
                        if (!kvonly) {
                            const u32x2 w = sgw[k];
                            float v0 = gelu1(bflo(w.x)), v1 = gelu1(bfhi(w.x)), v2 = gelu1(bflo(w.y)), v3 = gelu1(bfhi(w.y));
                            const float mean = wave_sum(v0 + v1 + v2 + v3) * (1.f / 256.f);
                            v0 -= mean; v1 -= mean; v2 -= mean; v3 -= mean;
                            const float rs = rsqrtf(wave_sum(v0 * v0 + v1 * v1 + v2 * v2 + v3 * v3) * (1.f / 256.f) + LN_EPS);
                            const f32x4 gg = sggv, bb = sgbv;
                            LAS bf16_t* vd = vsT + (lane * 4) * VST + tl;
                            vd[0] = (bf16_t)f2bf(v0 * rs * gg.x + bb.x); vd[VST] = (bf16_t)f2bf(v1 * rs * gg.y + bb.y); vd[2 * VST] = (bf16_t)f2bf(v2 * rs * gg.z + bb.z); vd[3 * VST] = (bf16_t)f2bf(v3 * rs * gg.w + bb.w);
                        }
                        {
                            const int h = lane >> 4, i = lane & 15; const f32x2 cs = rcs[k];
                            if (!kvonly) { const float q1 = bf2f(q1w[k]), q2 = bf2f(q2w[k]);
                                RQ[(size_t)n * 128 + h * 32 + i] = (q1 * cs.x - q2 * cs.y) * RET_QSCALE; RQ[(size_t)n * 128 + h * 32 + 16 + i] = (q2 * cs.x + q1 * cs.y) * RET_QSCALE; }
                            const float k1 = bf2f(k1w[k]), k2 = bf2f(k2w[k]);
                            const float ka = k1 * cs.x - k2 * cs.y, kb = k2 * cs.x + k1 * cs.y;
                            RK[(size_t)n * 128 + h * 32 + i] = ka; RK[(size_t)n * 128 + h * 32 + 16 + i] = kb;
                            ksr[tl * 128 + h * 32 + i] = ka; ksr[tl * 128 + h * 32 + 16 + i] = kb;
                        }
                    }
                }
                __syncthreads();
                {
                    const int h = wave >> 1, dir = wave & 1, hi = lane >> 5, il = lane & 31;
                    const float logit = a.in[dir ? I_RDB : I_RDF][l * 4 + h];
                    const float lg2 = log2f(1.f / (1.f + expf(-logit)));
                    f32x16 acc0 = {}, acc1 = {};
                    const bf16_t* vp = PROJ + (size_t)n0 * PROJW + C_RV + h * 64 + 2 * il;
                    for (int sb = 0; sb < 4; ++sb) {
                        unsigned bw[16];
#pragma unroll
                        for (int s = 0; s < 16; ++s) { const int tok = 2 * (sb * 16 + s) + hi; bw[s] = *(const unsigned*)(vp + (size_t)tok * PROJW); }
#pragma unroll
                        for (int s = 0; s < 16; ++s) { const int tok = 2 * (sb * 16 + s) + hi;
                            const float fac = __builtin_amdgcn_exp2f(lg2 * (float)(dir ? tok : 127 - tok));
                            const float av = ksr[tok * 128 + h * 32 + il] * fac;
                            acc0 = __builtin_amdgcn_mfma_f32_32x32x2f32(av, bflo(bw[s]), acc0, 0, 0, 0);
                            acc1 = __builtin_amdgcn_mfma_f32_32x32x2f32(av, bfhi(bw[s]), acc1, 0, 0, 0); }
                    }
                    float* so = SLOC + ((size_t)(T * 2 + dir) * 4 + h) * 2048 + 2 * il;
#pragma unroll
                    for (int r = 0; r < 16; ++r) { const int d = (r & 3) + 8 * (r >> 2) + 4 * hi; *(f32x2*)(so + d * 64) = (f32x2){acc0[r], acc1[r]}; }
                }
                if (!kvonly) {
                    const int g = wave >> 1, mh = wave & 1, hi = lane >> 5, il = lane & 31, c0 = g * 64 + 2 * il;
                    bf16x8 bfr[2][8];
#pragma unroll
                    for (int e = 0; e < 2; ++e)
#pragma unroll
                        for (int kk = 0; kk < 8; ++kk) bfr[e][kk] = *(const LAS bf16x8*)(vsT + (c0 + e) * VST + kk * 16 + hi * 8);
                    const bf16_t* wg = SGWB + ((size_t)(l * 4 + g) * 128) * 128;
                    for (int mt = 2 * mh; mt < 2 * mh + 2; ++mt) {
                        f32x16 acc0 = {}, acc1 = {};
                        const bf16_t* wr = wg + (size_t)(mt * 32 + il) * 128 + hi * 8;
#pragma unroll
                        for (int kk = 0; kk < 8; ++kk) { const bf16x8 af = *(const bf16x8*)(wr + kk * 16); acc0 = __builtin_amdgcn_mfma_f32_32x32x16_bf16(af, bfr[0][kk], acc0, 0, 0, 0); acc1 = __builtin_amdgcn_mfma_f32_32x32x16_bf16(af, bfr[1][kk], acc1, 0, 0, 0); }
#pragma unroll
                        for (int rb = 0; rb < 16; rb += 8) {
                            unsigned uw_[8];
#pragma unroll
                            for (int r8 = 0; r8 < 8; ++r8) { const int r = rb + r8; const int p = mt * 32 + (r & 3) + 8 * (r >> 2) + 4 * hi; uw_[r8] = *(const unsigned*)(PROJ + (size_t)(n0 + p) * PROJW + C_SGU + c0); }
#pragma unroll
                            for (int r8 = 0; r8 < 8; ++r8) { const int r = rb + r8; const int p = mt * 32 + (r & 3) + 8 * (r >> 2) + 4 * hi; const float sbp = sb[g * 128 + p];
                                *(unsigned*)(MIX + (size_t)(n0 + p) * DM + 512 + c0) = pk2(gelu1(bflo(uw_[r8])) * (acc0[r] + sbp), gelu1(bfhi(uw_[r8])) * (acc1[r] + sbp)); }
                        }
                    }
                }
            }
            __syncthreads();
            if (l + 1 < NLAYER && vcu >= 8) {
                LAS float* scr = (LAS float*)(lds + wave * 16384);
                for (int it = (vcu - 8) * 8 + wave; it < IT_LAYER / 2; it += (G - 8) * 8) CONVERT_ITEM(l + 1, it);
            }
            __syncthreads();
        }
        SEAM(pb + 1);
        for (int rep_ = 0; rep_ < REPS(2); ++rep_) if (EN(2) && IN(pb + 2)) { PH_IDS();
            if (tid < 256) {
                for (int E = bx * 256 + tid; E < 65536; E += G * 256) {
                    const int v = E & 63, d = (E >> 6) & 31, h = (E >> 11) & 3, dir = (E >> 13) & 1, b = E >> 14;
                    const float logit = a.in[dir ? I_RDB : I_RDF][l * 4 + h];
                    const float g128 = __builtin_amdgcn_exp2f(128.f * log2f(1.f / (1.f + expf(-logit))));
                    float S = 0.f;
#pragma unroll
                    for (int c = 0; c < 66; ++c) {
                        int T;
                        if (dir == 0) T = (c < 2) ? b * 2 + c : 8 + b * 64 + (c - 2);
                        else T = (c < 2) ? b * 2 + (1 - c) : 8 + b * 64 + (63 - (c - 2));
                        const size_t idx = ((size_t)(T * 2 + dir) * 4 + h) * 2048 + d * 64 + v;
                        const float x = SLOC[idx]; SIN[idx] = S; S = g128 * S + x;
                    }
                }
            }
            {
                pg8::Gemm g{CQN, WUQ + (size_t)l * 768 * 384, 384, 384, nullptr, 0, 0};
                pg8::StaticOrder S; S.init(NTOK / 256, 3, G, bx);
                pg8::EpiBf16 E{QB, 768};
                pg8::gemm_phase<pg8::EpiBf16, pg8::StaticOrder, false>(lds, g, S, E, wave_s);
            }
            {
                pg8::Gemm g{CKVN, WUKV + (size_t)l * 1024 * 256, 256, 256, nullptr, 0, 0};
                const int rot1 = (G * 9 / 16) & ~7;
                pg8::StaticOrder S; S.init(NTOK / 256, 2, G, (bx + G - rot1) % G);
                pg8::EpiK E{KB};
                pg8::gemm_phase<pg8::EpiK, pg8::StaticOrder, false>(lds, g, S, E, wave_s);
            }
            {
                pg8::Gemm g{WUKV + (size_t)l * 1024 * 256 + 512 * 256, CKVN, 256, 256, nullptr, 0, 0};
                const int rot2 = ((G * 9 / 16) & ~7) + 8;
                pg8::StaticOrder S; S.init(2, NTOK / 256, G, (bx + G - rot2) % G);
                pg8::EpiVT E{VT8};
                pg8::gemm_phase<pg8::EpiVT, pg8::StaticOrder, false>(lds, g, S, E, wave_s);
            }
        }
        SEAM(pb + 2);
#define ECTX_PUBLISH(rt_) do { asm volatile("s_waitcnt vmcnt(0)" ::: "memory"); __syncthreads(); \
        if (tid == 0) { __builtin_amdgcn_fence(__ATOMIC_RELEASE, "agent"); asm volatile("s_waitcnt vmcnt(0)" ::: "memory"); __hip_atomic_fetch_add(ctl + CW_ECTX + (l * 4 + (rt_)) * 64, 1u, RLX_AGENT); } } while (0)
        for (int rep_ = 0; rep_ < REPS(3); ++rep_) if (EN(3) && IN(pb + 3)) { PH_IDS();
            for (int rnd = 0; rnd < 3; ++rnd) {
                int b, h, qrow0, seq, t0;
                if (rnd < 2) { const int u = rnd * G + vcu; if (u >= 512) continue; const int bh = u >> 5, qb = u & 31; b = bh >> 2; h = bh & 3; qrow0 = NCTX + b * SEQ + qb * 256; seq = KEYS; t0 = qb * 256; }
                else { const int k = vcu - 16; if (k < 0 || k >= 16 || l == NLAYER - 1) continue; b = k >> 2; h = k & 3; qrow0 = b * CTXL; seq = CTXL; t0 = -1; }
                att::attn_unit(QB + ((size_t)qrow0 * 768 + h * 192), KB + h * 192, VT8 + (size_t)((b * 4 + h) * (KEYS / 64)) * VT_TILE, MIX + ((size_t)qrow0 * DM + h * 128), seq, b * CTXL, NCTX + b * SEQ, t0, ATAB, (char*)lds_raw, wave_s);
                if (rnd == 2) ECTX_PUBLISH(b);
            }
            {
                LAS float* qs = (LAS float*)lds;
                LAS float* ks = (LAS float*)(lds + 33792);
                LAS bf16_t* vs = (LAS bf16_t*)(lds + 67584);
                const int hl = wave >> 2, dir = (wave >> 1) & 1, half = wave & 1, hi = lane >> 5, il = lane & 31;
                for (int T = vcu; T < NTOK / 128; T += G) {
                    if (l == NLAYER - 1 && T < NCTX / 128) continue;
                    const int n0 = T * 128;
                    for (int pass = 0; pass < 2; ++pass) {
                        const int h = pass * 2 + hl;
                        __syncthreads();
                        {
                            f32x4 qv_[4], kv_[4]; u32x4 vv_[4];
#pragma unroll
                            for (int u_ = 0; u_ < 4; ++u_) { const int i = tid + 512 * u_; const int tok = i >> 4, part = i & 15;
                                qv_[u_] = *(const f32x4*)(RQ + (size_t)(n0 + tok) * 128 + pass * 64 + part * 4); kv_[u_] = *(const f32x4*)(RK + (size_t)(n0 + tok) * 128 + pass * 64 + part * 4);
                                vv_[u_] = *(const u32x4*)(PROJ + (size_t)(n0 + tok) * PROJW + C_RV + pass * 128 + part * 8); }
#pragma unroll
                            for (int u_ = 0; u_ < 4; ++u_) { const int i = tid + 512 * u_; const int tok = i >> 4, part = i & 15, hh = part >> 3, d0 = (part & 7) * 4;
                                const f32x4 qv = qv_[u_], kv = kv_[u_];
                                LAS float* qd = qs + (hh * 128 + tok) * 33 + d0; LAS float* kd = ks + (hh * 128 + tok) * 33 + d0;
                                qd[0] = qv.x; qd[1] = qv.y; qd[2] = qv.z; qd[3] = qv.w; kd[0] = kv.x; kd[1] = kv.y; kd[2] = kv.z; kd[3] = kv.w;
                                *(LAS u32x4*)(vs + tok * 128 + part * 8) = vv_[u_]; }
                        }
                        __syncthreads();
                        const float logit = a.in[dir ? I_RDB : I_RDF][l * 4 + h];
                        const float lg2 = log2f(1.f / (1.f + expf(-logit)));
                        float sinv0[16], sinv1[16];
                        { const float* sp = SIN + ((size_t)(T * 2 + dir) * 4 + h) * 2048 + il;
#pragma unroll
                          for (int s = 0; s < 16; ++s) { sinv0[s] = sp[(2 * s + hi) * 64]; sinv1[s] = sp[(2 * s + hi) * 64 + 32]; } }
                        float* OUT = dir ? OB : OF;
                        for (int ii = 0; ii < 2; ++ii) {
                            const int I = half ? (ii ? 2 : 1) : (ii ? 3 : 0);
                            const int ipos = 32 * I + il, itok = dir ? 127 - ipos : ipos;
                            const LAS float* qrow = qs + (hl * 128 + itok) * 33 + hi;
                            f32x16 acc0 = {}, acc1 = {};
#pragma unroll
                            for (int s = 0; s < 16; ++s) { const float bq = qrow[2 * s];
                                acc0 = __builtin_amdgcn_mfma_f32_32x32x2f32(sinv0[s], bq, acc0, 0, 0, 0);
                                acc1 = __builtin_amdgcn_mfma_f32_32x32x2f32(sinv1[s], bq, acc1, 0, 0, 0); }
                            { const float cf = __builtin_amdgcn_exp2f(lg2 * (float)(ipos + 1));
#pragma unroll
                              for (int r = 0; r < 16; ++r) { acc0[r] *= cf; acc1[r] *= cf; } }
                            for (int J = 0; J <= I; ++J) {
                                const int jposA = 32 * J + il, jtokA = dir ? 127 - jposA : jposA;
                                const LAS float* krow = ks + (hl * 128 + jtokA) * 33 + hi;
                                f32x16 pt = {};
#pragma unroll
                                for (int s = 0; s < 16; ++s) pt = __builtin_amdgcn_mfma_f32_32x32x2f32(krow[2 * s], qrow[2 * s], pt, 0, 0, 0);
#pragma unroll
                                for (int r = 0; r < 16; ++r) { const int jl = (r & 3) + 8 * (r >> 2) + 4 * hi;
                                    const bool keep = (J < I) || (dir ? (il > jl) : (il >= jl));
                                    const float fac = __builtin_amdgcn_exp2f(lg2 * (float)(32 * (I - J) + il - jl));
                                    pt[r] = keep ? pt[r] * fac : 0.f; }
#pragma unroll
                                for (int r = 0; r < 16; ++r) { const int jpos = 32 * J + (r & 3) + 8 * (r >> 2) + 4 * hi, jtok = dir ? 127 - jpos : jpos;
                                    const float a0 = bf2f(vs[jtok * 128 + hl * 64 + il]), a1 = bf2f(vs[jtok * 128 + hl * 64 + 32 + il]);
                                    acc0 = __builtin_amdgcn_mfma_f32_32x32x2f32(a0, pt[r], acc0, 0, 0, 0);
                                    acc1 = __builtin_amdgcn_mfma_f32_32x32x2f32(a1, pt[r], acc1, 0, 0, 0); }
                            }
                            float* op = OUT + (size_t)(n0 + itok) * 256 + h * 64;
#pragma unroll
                            for (int rq = 0; rq < 4; ++rq) {
                                *(f32x4*)(op + 8 * rq + 4 * hi) = (f32x4){acc0[4 * rq], acc0[4 * rq + 1], acc0[4 * rq + 2], acc0[4 * rq + 3]};
                                *(f32x4*)(op + 32 + 8 * rq + 4 * hi) = (f32x4){acc1[4 * rq], acc1[4 * rq + 1], acc1[4 * rq + 2], acc1[4 * rq + 3]}; }
                        }
                    }
                    asm volatile("s_waitcnt vmcnt(0)" ::: "memory");
                    __syncthreads();
                    for (int ib = 0; ib < 2; ++ib) {
                        f32x4 fF[8], fB[8]; u32x2 gW[8];
#pragma unroll
                        for (int it = 0; it < 8; ++it) { const int n = n0 + wave * 16 + ib * 8 + it;
                            fF[it] = *((const f32x4*)(OF + (size_t)n * 256) + lane); fB[it] = *((const f32x4*)(OB + (size_t)n * 256) + lane); gW[it] = *(const u32x2*)(PROJ + (size_t)n * PROJW + C_RG + lane * 4); }
#pragma unroll
                        for (int it = 0; it < 8; ++it) { const int n = n0 + wave * 16 + ib * 8 + it;
                            float v0 = fF[it].x + fB[it].x, v1 = fF[it].y + fB[it].y, v2 = fF[it].z + fB[it].z, v3 = fF[it].w + fB[it].w;
                            float s = v0 + v1 + v2 + v3; s += dpp_f<0xB1>(s); s += dpp_f<0x4E>(s); s += dpp_f<0x141>(s); s += dpp_f<0x140>(s);
                            const float mean = s * (1.f / 64.f); v0 -= mean; v1 -= mean; v2 -= mean; v3 -= mean;
                            float q = v0 * v0 + v1 * v1 + v2 * v2 + v3 * v3; q += dpp_f<0xB1>(q); q += dpp_f<0x4E>(q); q += dpp_f<0x141>(q); q += dpp_f<0x140>(q);
                            const float rs = rsqrtf(q * (1.f / 64.f) + LN_EPS);
                            const float g0 = bflo(gW[it].x), g1 = bfhi(gW[it].x), g2 = bflo(gW[it].y), g3 = bfhi(gW[it].y);
                            u32x2 o; o.x = pk2(v0 * rs * g0 * sigmoidf_(g0), v1 * rs * g1 * sigmoidf_(g1)); o.y = pk2(v2 * rs * g2 * sigmoidf_(g2), v3 * rs * g3 * sigmoidf_(g3));
                            *(u32x2*)(MIX + (size_t)n * DM + 768 + lane * 4) = o; }
                    }
                    if (T < NCTX / 128 && l + 1 < NLAYER) ECTX_PUBLISH(T >> 1);
                }
                __syncthreads();
            }
            if (l + 1 < NLAYER && vcu >= 16 && vcu < 32) {
                const int rt = (vcu - 16) >> 2, ct = (vcu - 16) & 3;
                if (tid == 0) { unsigned spins = 0; while (__hip_atomic_load(ctl + CW_ECTX + (l * 4 + rt) * 64, RLX_AGENT) < 6u && ++spins < (1u << 22)) __builtin_amdgcn_s_sleep(2);
                    __builtin_amdgcn_fence(__ATOMIC_ACQUIRE, "agent"); }
                asm volatile("s_waitcnt vmcnt(0)" ::: "memory"); __syncthreads();
                pg8::Gemm g{MIX, WOT + (size_t)l * 1024 * 1024, 1024, 1024, nullptr, 0, 0};
                pg8::OneUnit S1{rt, ct};
                pg8::EpiBf16 E1{YB, DM};
                pg8::gemm_phase<pg8::EpiBf16, pg8::OneUnit, false>(lds, g, S1, E1, wave_s);
            }
            if (l + 1 < NLAYER && vcu >= 32) {
                LAS float* scr = (LAS float*)(lds + wave * 16384);
                for (int it = IT_LAYER / 2 + (vcu - 32) * 8 + wave; it < IT_LAYER; it += (G - 32) * 8) CONVERT_ITEM(l + 1, it);
                __syncthreads();
            }
        }
        SEAM(pb + 3);
        for (int rep_ = 0; rep_ < REPS(4); ++rep_) if (EN(4) && IN(pb + 4)) { PH_IDS();
            const int skipr = NCTX;
            pg8::Gemm g{MIX + (size_t)skipr * DM, WOT + (size_t)l * 1024 * 1024, 1024, 1024, nullptr, 0, 0};
            pg8::StaticOrder S; S.init((NTOK - skipr) / 256, 4, G, bx);
            pg8::EpiBf16 E{YB + (size_t)skipr * DM, DM};
            pg8::gemm_phase<pg8::EpiBf16, pg8::StaticOrder, false>(lds, g, S, E, wave_s);
        }
        SEAM(pb + 4);
        if (EN(5) && IN(pb + 5)) { PH_IDS();
            LAS f32x4* rwl4 = (LAS f32x4*)lds;
            LAS unsigned* cnt = (LAS unsigned*)(lds + RING_BYTES);
            { const f32x4* src = (const f32x4*)(a.in[I_RW] + (size_t)l * 1024 * 32);
              f32x4 wv_[16];
#pragma unroll
              for (int u_ = 0; u_ < 16; ++u_) wv_[u_] = src[tid + 512 * u_];
#pragma unroll
              for (int u_ = 0; u_ < 16; ++u_) { const int i = tid + 512 * u_; const int d = i >> 3, cq = i & 7; const int rho = ((d & 3) * 4 + (d >> 8)) * 64 + ((d >> 2) & 63); rwl4[rho * 8 + (cq ^ (rho & 7))] = wv_[u_]; } }
            if (tid < 32) cnt[tid] = 0u;
            __syncthreads();
            const float* ln1g = a.in[I_LN1G] + l * DM; const float* ln1b = a.in[I_LN1B] + l * DM; const float* rb = a.in[I_RB] + l * 32;
            const int per = ((NTOK + G - 1) / G + 1) & ~1; const int n0 = bx * per, n1 = (n0 + per < NTOK) ? n0 + per : NTOK;
            const int myE = ((lane >> 5) & 1) * 16 + ((lane >> 4) & 1) * 8 + ((lane >> 3) & 1) * 4 + ((lane >> 2) & 1) * 2 + ((lane >> 1) & 1);
            const float myRb = rb[myE];
            f32x4 xB[2][4] = {}; u32x2 yB[2][4] = {};
            const int npair = (n1 - n0) >> 1;
            if (wave < npair) {
#pragma unroll
                for (int t = 0; t < 2; ++t)
#pragma unroll
                    for (int j = 0; j < 4; ++j) { XLOAD(xB[t][j], l, n0 + 2 * wave + t, j); yB[t][j] = *((const u32x2*)(YB + (size_t)(n0 + 2 * wave + t) * DM) + lane + 64 * j); } }
            for (int p = wave; p < npair; p += 8) {
                const int nb = n0 + 2 * p;
                f32x4 v[2][4];
                const float* md = MODL + (size_t)modset(nb) * 6144;
                float sm[2];
                {
                    f32x4 g1v[4];
#pragma unroll
                    for (int j = 0; j < 4; ++j) g1v[j] = *((const f32x4*)(md + 2048) + lane + 64 * j);
#pragma unroll
                    for (int t = 0; t < 2; ++t) { float s = 0.f;
#pragma unroll
                        for (int j = 0; j < 4; ++j) { const f32x4 yv = (f32x4){bflo(yB[t][j].x), bfhi(yB[t][j].x), bflo(yB[t][j].y), bfhi(yB[t][j].y)}; v[t][j] = XVAL(xB[t][j], l) * DN_ALPHA + g1v[j] * yv; s += (v[t][j].x + v[t][j].y) + (v[t][j].z + v[t][j].w); }
                        sm[t] = s; }
                }
                __builtin_amdgcn_sched_barrier(0);
                f32x4 pg[4], pb_[4], psh[4], psc[4];
#pragma unroll
                for (int j = 0; j < 4; ++j) { pg[j] = *((const f32x4*)ln1g + lane + 64 * j); pb_[j] = *((const f32x4*)ln1b + lane + 64 * j); psh[j] = *((const f32x4*)(md + 3072) + lane + 64 * j); psc[j] = *((const f32x4*)(md + 4096) + lane + 64 * j); }
                float rstd[2];
                { const float mean0 = wave_sum(sm[0]) * (1.f / DM), mean1 = wave_sum(sm[1]) * (1.f / DM); float q0 = 0.f, q1 = 0.f;
#pragma unroll
                  for (int j = 0; j < 4; ++j) { v[0][j] = v[0][j] - mean0; q0 += (v[0][j].x * v[0][j].x + v[0][j].y * v[0][j].y) + (v[0][j].z * v[0][j].z + v[0][j].w * v[0][j].w);
                      v[1][j] = v[1][j] - mean1; q1 += (v[1][j].x * v[1][j].x + v[1][j].y * v[1][j].y) + (v[1][j].z * v[1][j].z + v[1][j].w * v[1][j].w); }
                  rstd[0] = rsqrtf(wave_sum(q0) * (1.f / DM) + LN_EPS); rstd[1] = rsqrtf(wave_sum(q1) * (1.f / DM) + LN_EPS); }
                __builtin_amdgcn_sched_barrier(0);
#pragma unroll
                for (int j = 0; j < 4; ++j)
#pragma unroll
                    for (int t = 0; t < 2; ++t) { const int n = nb + t;
                        v[t][j] = v[t][j] * rstd[t] * pg[j] + pb_[j]; { u32x2 xw_; xw_.x = pk2(v[t][j].x, v[t][j].y); xw_.y = pk2(v[t][j].z, v[t][j].w); *((u32x2*)(XRB + (size_t)n * DM) + lane + 64 * j) = xw_; }
                        v[t][j] = v[t][j] * (psc[j] + 1.f) + psh[j];
                        *((unsigned*)(XH8 + (size_t)n * DM) + lane + 64 * j) = pk4_fp8(v[t][j].x * ACT_Q, v[t][j].y * ACT_Q, v[t][j].z * ACT_Q, v[t][j].w * ACT_Q); }
                __builtin_amdgcn_sched_barrier(0);
                if (p + 8 < npair) {
#pragma unroll
                    for (int j = 0; j < 4; ++j) { XLOAD(xB[0][j], l, nb + 16, j); yB[0][j] = *((const u32x2*)(YB + (size_t)(nb + 16) * DM) + lane + 64 * j); } }
                __builtin_amdgcn_sched_barrier(0);
                f32x4 ac[2][8];
#pragma unroll
                for (int t = 0; t < 2; ++t)
#pragma unroll
                    for (int q = 0; q < 8; ++q) ac[t][q] = (f32x4){0.f, 0.f, 0.f, 0.f};
                int lq_ = lane; asm volatile("" : "+v"(lq_));
#pragma unroll
                for (int j = 0; j < 4; ++j)
#pragma unroll
                    for (int i = 0; i < 4; ++i) { __builtin_amdgcn_sched_barrier(0); const float hv0 = v[0][j][i], hv1 = v[1][j][i]; const LAS f32x4* rp = rwl4 + ((i * 4 + j) * 64 + lq_) * 8;
#pragma unroll
                        for (int q = 0; q < 8; ++q) { const f32x4 w = rp[q ^ (lq_ & 7)]; ac[0][q] += w * hv0; ac[1][q] += w * hv1; }
#pragma unroll
                        for (int t = 0; t < 2; ++t)
                            asm volatile("" : "+v"(ac[t][0]), "+v"(ac[t][1]), "+v"(ac[t][2]), "+v"(ac[t][3]), "+v"(ac[t][4]), "+v"(ac[t][5]), "+v"(ac[t][6]), "+v"(ac[t][7])); }
                __builtin_amdgcn_sched_barrier(0);
                if (p + 8 < npair) {
#pragma unroll
                    for (int j = 0; j < 4; ++j) { XLOAD(xB[1][j], l, nb + 17, j); yB[1][j] = *((const u32x2*)(YB + (size_t)(nb + 17) * DM) + lane + 64 * j); } }
                __builtin_amdgcn_sched_barrier(0);
                float tv[2][4]; int ti[2][4];
#pragma unroll
                for (int t = 0; t < 2; ++t) {
                    float r16[16], r8[8], r4[4], r2[2], val;
                    { const bool up = (lane & 32) != 0;
#pragma unroll
                      for (int k = 0; k < 16; ++k) { const float lo_ = ac[t][k >> 2][k & 3], hi_ = ac[t][(k + 16) >> 2][k & 3]; r16[k] = (up ? hi_ : lo_) + __shfl_xor(up ? lo_ : hi_, 32); } }
                    { const bool up = (lane & 16) != 0;
#pragma unroll
                      for (int k = 0; k < 8; ++k) r8[k] = (up ? r16[k + 8] : r16[k]) + __shfl_xor(up ? r16[k] : r16[k + 8], 16); }
                    { const bool up = (lane & 8) != 0;
#pragma unroll
                      for (int k = 0; k < 4; ++k) r4[k] = (up ? r8[k + 4] : r8[k]) + dpp_f<0x128>(up ? r8[k] : r8[k + 4]); }
                    { const bool up = (lane & 4) != 0;
#pragma unroll
                      for (int k = 0; k < 2; ++k) r2[k] = (up ? r4[k + 2] : r4[k]) + dpp_f<0x1B>(dpp_f<0x141>(up ? r4[k] : r4[k + 2])); }
                    { const bool up = (lane & 2) != 0; val = (up ? r2[1] : r2[0]) + dpp_f<0x4E>(up ? r2[0] : r2[1]); }
                    val += dpp_f<0xB1>(val);
                    val += myRb;
#pragma unroll
                    for (int k = 0; k < 4; ++k) {
                        float bv = val; int bi = myE;
#pragma unroll
                        for (int o = 32; o >= 16; o >>= 1) { const float ov = __shfl_xor(bv, o); const int oi = __shfl_xor(bi, o); if (ov > bv || (ov == bv && oi < bi)) { bv = ov; bi = oi; } }
#define AMX_STEP(C_) { const float ov = dpp_f<C_>(bv); const int oi = dpp_i<C_>(bi); if (ov > bv || (ov == bv && oi < bi)) { bv = ov; bi = oi; } }
                        AMX_STEP(0x140) AMX_STEP(0x141) AMX_STEP(0x4E) AMX_STEP(0xB1)
#undef AMX_STEP
                        tv[t][k] = bv; ti[t][k] = bi; if (myE == bi) val = -3.0e38f;
                    }
                }
#pragma unroll
                for (int t = 0; t < 2; ++t) {
                    const int n = nb + t;
                    const bool routed = !(l == NLAYER - 1 && n < NCTX);
                    const float e1 = __expf(tv[t][1] - tv[t][0]), e2 = __expf(tv[t][2] - tv[t][0]), e3 = __expf(tv[t][3] - tv[t][0]);
                    const float inv = 1.f / (1.f + e1 + e2 + e3);
                    if (lane < 4) {
                        const int ee = lane == 0 ? ti[t][0] : lane == 1 ? ti[t][1] : lane == 2 ? ti[t][2] : ti[t][3];
                        const float gg = (lane == 0 ? 1.f : lane == 1 ? e1 : lane == 2 ? e2 : e3) * inv;
                        TOPI[n * 4 + lane] = routed ? ee : -1; GATE[n * 4 + lane] = gg;
                        if (routed) __hip_atomic_fetch_add(&cnt[ee], 1u, __ATOMIC_RELAXED, __HIP_MEMORY_SCOPE_WORKGROUP);
                    }
                }
                __builtin_amdgcn_sched_barrier(0);
            }
            __syncthreads();
            if (tid < 32) __hip_atomic_store(ctl + CW_BLKCNT + bx * 32 + tid, cnt[tid], RLX_AGENT);
            __syncthreads();
        }
        SEAM(pb + 5);
        for (int rep_ = 0; rep_ < REPS(6); ++rep_) if (EN(6) && IN(pb + 6)) { PH_IDS();
            LAS int* bc = (LAS int*)lds;
            LAS int* part = (LAS int*)(lds + 65536);
            LAS int* tot = part + 1024; LAS int* base = tot + 32; LAS int* seg = base + 32; LAS int* tiv = seg + 40;
            { unsigned cv_[16];
#pragma unroll
              for (int u_ = 0; u_ < 16; ++u_) { const int i = tid + 512 * u_; cv_[u_] = (i < G * 32) ? ctl[CW_BLKCNT + i] : 0u; }
#pragma unroll
              for (int u_ = 0; u_ < 16; ++u_) { const int i = tid + 512 * u_; if (i < G * 32) bc[i] = (int)cv_[u_]; }
              for (int i = tid + 8192; i < G * 32; i += 512) bc[i] = (int)ctl[CW_BLKCNT + i]; }
            const int per = ((NTOK + G - 1) / G + 1) & ~1; const int n0 = bx * per, n1 = (n0 + per < NTOK) ? n0 + per : NTOK; const int na = (n1 - n0) * 4;
            { const int i0 = tid, i1 = tid + 512; const int t0_ = (i0 < na) ? TOPI[n0 * 4 + i0] : 0, t1_ = (i1 < na) ? TOPI[n0 * 4 + i1] : 0;
              if (i0 < na) tiv[i0] = t0_; if (i1 < na) tiv[i1] = t1_;
              for (int i = tid + 1024; i < na; i += 512) tiv[i] = TOPI[n0 * 4 + i]; }
            __syncthreads();
            { const int e = tid & 31, pt = tid >> 5; const int bpp = (G + 15) / 16; int t = 0, bs = 0;
              for (int b = pt * bpp; b < (pt + 1) * bpp && b < G; ++b) { const int c = bc[b * 32 + e]; t += c; if (b < bx) bs += c; }
              part[pt * 32 + e] = t; part[512 + pt * 32 + e] = bs; }
            __syncthreads();
            if (tid < 32) { int t = 0, bs = 0;
#pragma unroll
              for (int p = 0; p < 16; ++p) { t += part[p * 32 + tid]; bs += part[512 + p * 32 + tid]; }
              tot[tid] = t; base[tid] = bs; }
            __syncthreads();
            if (tid == 0) { int off = 0; for (int e = 0; e < 32; ++e) { seg[e] = off; off += (tot[e] + 255) & ~255; } seg[32] = off; }
            __syncthreads();
            if (bx == 0) {
                const int ntl = seg[32] >> 8;
                if (tid == 0) __hip_atomic_store(ctl + CW_NT, (unsigned)ntl, RLX_AGENT);
                for (int t = tid; t < ntl; t += 512) { int e = 0; for (int k = 0; k < 32; ++k) if (seg[k] <= t * 256) e = k; __hip_atomic_store(ctl + CW_TILE_E + t, (unsigned)e, RLX_AGENT); }
            }
            for (int e = wave; e < 32; e += 8) {
                if ((e % G) == bx) for (int r = seg[e] + tot[e] + lane; r < seg[e + 1]; r += 64) ROWTOK[r] = 0;
            }
            for (int i = tid; i < na; i += 512) { const int e = tiv[i];
                if (e >= 0) { int rk = 0; for (int j = 0; j < i; ++j) rk += (tiv[j] == e) ? 1 : 0;
                    const int pos = seg[e] + base[e] + rk; DEST[n0 * 4 + i] = pos; ROWTOK[pos] = n0 + (i >> 2); } }
            __syncthreads();
        }
        SEAM(pb + 6);
        for (int rep_ = 0; rep_ < REPS(7); ++rep_) if (EN(7) && IN(pb + 7)) { PH_IDS();
            const int ntl = __builtin_amdgcn_readfirstlane(ld_ctl(ctl + CW_NT));
            LAS unsigned char* te = (LAS unsigned char*)(lds + RING_BYTES);
            LAS unsigned short* rows = (LAS unsigned short*)(lds + RING_BYTES + 1024);
            pg8::MoeOrder S; S.so.init(ntl, 8, G, bx); S.tile_e = te;
            {
                const unsigned e0_ = (tid < ntl) ? ctl[CW_TILE_E + tid] : 0u, e1_ = (tid + 512 < ntl) ? ctl[CW_TILE_E + tid + 512] : 0u;
                int rv_[18];
#pragma unroll
                for (int i = 0; i < 18; ++i) { pg8::Unit u; const bool ok = S.so.next(i, u); rv_[i] = (ok && tid < 256) ? ROWTOK[u.pm * 256 + tid] : 0; }
                if (tid < ntl) te[tid] = (unsigned char)e0_; if (tid + 512 < ntl) te[tid + 512] = (unsigned char)e1_;
                for (int t = tid + 1024; t < ntl; t += 512) te[t] = (unsigned char)ctl[CW_TILE_E + t];
#pragma unroll
                for (int i = 0; i < 18; ++i) if (tid < 256) rows[i * 256 + tid] = (unsigned short)rv_[i];
            }
            __syncthreads();
            pg8::Gemm g{XH8, WGU + (size_t)l * 32 * 2048 * 1024, 1024, 1024, rows, ACT_E, WGU_E};
            pg8::EpiSwiglu E{ACT, a.in[I_BGU] + (size_t)l * 32 * 2048};
            pg8::gemm_phase<pg8::EpiSwiglu, pg8::MoeOrder, true, true>(lds, g, S, E, wave_s);
        }
        SEAM(pb + 7);
        for (int rep_ = 0; rep_ < REPS(8); ++rep_) if (EN(8) && IN(pb + 8)) { PH_IDS();
            const int ntl = __builtin_amdgcn_readfirstlane(ld_ctl(ctl + CW_NT));
            LAS unsigned char* te = (LAS unsigned char*)(lds + RING_BYTES);
            { const unsigned e0_ = (tid < ntl) ? ctl[CW_TILE_E + tid] : 0u, e1_ = (tid + 512 < ntl) ? ctl[CW_TILE_E + tid + 512] : 0u;
              if (tid < ntl) te[tid] = (unsigned char)e0_; if (tid + 512 < ntl) te[tid + 512] = (unsigned char)e1_;
              for (int t = tid + 1024; t < ntl; t += 512) te[t] = (unsigned char)ctl[CW_TILE_E + t]; }
            __syncthreads();
            pg8::Gemm g{ACT, WDN + (size_t)l * 32 * 1024 * 1024, 1024, 1024, nullptr, ACT_E, WDN_E};
            pg8::MoeOrder S; S.so.init(ntl, 4, G, bx); S.tile_e = te;
            pg8::EpiDown E{DOUT, a.in[I_BDN] + (size_t)l * 32 * 1024};
            pg8::gemm_phase<pg8::EpiDown, pg8::MoeOrder, false, true>(lds, g, S, E, wave_s);
        }
        SEAM(pb + 8);
        if (EN(9) && IN(pb + 9)) { PH_IDS();
            const float* ln2g = a.in[I_LN2G] + l * DM; const float* ln2b = a.in[I_LN2B] + l * DM;
            const bool lastl = (l == NLAYER - 1);
            const int nbeg = lastl ? NCTX : 0;
            int dA[2][4] = {}; float gA[2][4] = {};
            unsigned rB[2][4][4] = {}; u32x2 xB[2][4] = {}; float gB[2][4] = {};
            const int PSTEP = 2 * NGW;
            const int nA = nbeg + 2 * gw;
            if (nA < NTOK) {
#pragma unroll
                for (int t = 0; t < 2; ++t)
#pragma unroll
                    for (int k = 0; k < 4; ++k) { dA[t][k] = DEST[(nA + t) * 4 + k]; gA[t][k] = GATE[(nA + t) * 4 + k]; }
#pragma unroll
                for (int t = 0; t < 2; ++t)
#pragma unroll
                    for (int j = 0; j < 4; ++j) {
#pragma unroll
                        for (int k = 0; k < 4; ++k) rB[t][j][k] = *((const unsigned*)(DOUT + (size_t)dA[t][k] * DM) + lane + 64 * j);
                        xB[t][j] = *((const u32x2*)(XRB + (size_t)(nA + t) * DM) + lane + 64 * j); }
#pragma unroll
                for (int t = 0; t < 2; ++t)
#pragma unroll
                    for (int k = 0; k < 4; ++k) gB[t][k] = gA[t][k];
                if (nA + PSTEP < NTOK) {
#pragma unroll
                    for (int t = 0; t < 2; ++t)
#pragma unroll
                        for (int k = 0; k < 4; ++k) { dA[t][k] = DEST[(nA + PSTEP + t) * 4 + k]; gA[t][k] = GATE[(nA + PSTEP + t) * 4 + k]; } }
            }
            for (int n = nbeg + 2 * gw; n < NTOK; n += PSTEP) {
                const float* md = MODL + (size_t)modset(n) * 6144;
                f32x4 v[2][4]; float sm[2];
                {
                    f32x4 g2[4];
#pragma unroll
                    for (int j = 0; j < 4; ++j) g2[j] = *((const f32x4*)(md + 5120) + lane + 64 * j);
#pragma unroll
                    for (int t = 0; t < 2; ++t) { float s = 0.f;
#pragma unroll
                        for (int j = 0; j < 4; ++j) {
                            f32x4 f = (f32x4){0.f, 0.f, 0.f, 0.f};
#pragma unroll
                            for (int k = 0; k < 4; ++k) { const unsigned w = rB[t][j][k]; const f32x2 lo_ = __builtin_amdgcn_cvt_pk_f32_fp8((int)w, false), hi_ = __builtin_amdgcn_cvt_pk_f32_fp8((int)w, true); const float gk = gB[t][k] * (1.f / DO_Q);
                                f.x += gk * lo_.x; f.y += gk * lo_.y; f.z += gk * hi_.x; f.w += gk * hi_.y; }
                            const f32x4 xv = (f32x4){bflo(xB[t][j].x), bfhi(xB[t][j].x), bflo(xB[t][j].y), bfhi(xB[t][j].y)};
                            v[t][j] = xv * DN_ALPHA + g2[j] * f; s += (v[t][j].x + v[t][j].y) + (v[t][j].z + v[t][j].w); }
                        sm[t] = s; }
                }
                __builtin_amdgcn_sched_barrier(0);
                if (n + PSTEP < NTOK) {
#pragma unroll
                    for (int t = 0; t < 2; ++t)
#pragma unroll
                        for (int j = 0; j < 4; ++j) {
#pragma unroll
                            for (int k = 0; k < 4; ++k) rB[t][j][k] = *((const unsigned*)(DOUT + (size_t)dA[t][k] * DM) + lane + 64 * j);
                            xB[t][j] = *((const u32x2*)(XRB + (size_t)(n + PSTEP + t) * DM) + lane + 64 * j); }
#pragma unroll
                    for (int t = 0; t < 2; ++t)
#pragma unroll
                        for (int k = 0; k < 4; ++k) gB[t][k] = gA[t][k];
                    if (n + 2 * PSTEP < NTOK) {
#pragma unroll
                        for (int t = 0; t < 2; ++t)
#pragma unroll
                            for (int k = 0; k < 4; ++k) { dA[t][k] = DEST[(n + 2 * PSTEP + t) * 4 + k]; gA[t][k] = GATE[(n + 2 * PSTEP + t) * 4 + k]; } }
                }
                __builtin_amdgcn_sched_barrier(0);
                const float* mdn = MODL + 5 * 6144 + (size_t)modset(n) * 6144;
                f32x4 pg[4], pb_[4];
#pragma unroll
                for (int j = 0; j < 4; ++j) { pg[j] = *((const f32x4*)ln2g + lane + 64 * j); pb_[j] = *((const f32x4*)ln2b + lane + 64 * j); }
                float rstd[2];
                { const float mean0 = wave_sum(sm[0]) * (1.f / DM), mean1 = wave_sum(sm[1]) * (1.f / DM); float q0 = 0.f, q1 = 0.f;
#pragma unroll
                  for (int j = 0; j < 4; ++j) { v[0][j] = v[0][j] - mean0; q0 += (v[0][j].x * v[0][j].x + v[0][j].y * v[0][j].y) + (v[0][j].z * v[0][j].z + v[0][j].w * v[0][j].w);
                      v[1][j] = v[1][j] - mean1; q1 += (v[1][j].x * v[1][j].x + v[1][j].y * v[1][j].y) + (v[1][j].z * v[1][j].z + v[1][j].w * v[1][j].w); }
                  rstd[0] = rsqrtf(wave_sum(q0) * (1.f / DM) + LN_EPS); rstd[1] = rsqrtf(wave_sum(q1) * (1.f / DM) + LN_EPS); }
                __builtin_amdgcn_sched_barrier(0);
#pragma unroll
                for (int j = 0; j < 4; ++j) { __builtin_amdgcn_sched_barrier(0);
                    f32x4 psh = (f32x4){0.f, 0.f, 0.f, 0.f}, psc = psh;
                    if (!lastl) { psh = *((const f32x4*)(mdn) + lane + 64 * j); psc = *((const f32x4*)(mdn + 1024) + lane + 64 * j); }
#pragma unroll
                    for (int t = 0; t < 2; ++t) { const int nn = n + t;
                        v[t][j] = v[t][j] * rstd[t] * pg[j] + pb_[j];
                        if (lastl) *((f32x4*)(a.out + (size_t)(nn - NCTX) * DM) + lane + 64 * j) = v[t][j];
                        else { u32x2 xw_; xw_.x = pk2(v[t][j].x, v[t][j].y); xw_.y = pk2(v[t][j].z, v[t][j].w); *((u32x2*)(XRB + (size_t)nn * DM) + lane + 64 * j) = xw_;
                            const f32x4 hh = (v[t][j] * (psc + 1.f) + psh) * ACT_Q; *((unsigned*)(XHF + (size_t)nn * DM) + lane + 64 * j) = pk4_fp8(hh.x, hh.y, hh.z, hh.w); } } }
                __builtin_amdgcn_sched_barrier(0);
            }
        }
        SEAM(pb + 9);
    }
#undef IN
#undef SEAM
}

extern "C" void kernel_launch(void* const* d_in, const int* in_sizes, int n_in, void* d_out, int out_size, void* d_ws, size_t ws_size, hipStream_t stream) {
    static int grid = 0;
    if (grid == 0) {
        if (n_in != 28 || ws_size < WS_END) { fprintf(stderr, "kernel_launch: need 28 inputs and %zu bytes of workspace (got %d, %zu)\n", (size_t)WS_END, n_in, ws_size); grid = -1; return; }
        int dev = 0, cus = 0, per_cu = 0;
        if (hipGetDevice(&dev) != hipSuccess || hipDeviceGetAttribute(&cus, hipDeviceAttributeMultiprocessorCount, dev) != hipSuccess) { grid = -1; return; }
        if (hipFuncSetAttribute((const void*)mega, hipFuncAttributeMaxDynamicSharedMemorySize, LDS_BYTES) != hipSuccess) { fprintf(stderr, "kernel_launch: hipFuncSetAttribute failed\n"); grid = -1; return; }
        if (hipOccupancyMaxActiveBlocksPerMultiprocessor(&per_cu, (const void*)mega, 512, LDS_BYTES) != hipSuccess || per_cu < 1) { fprintf(stderr, "kernel_launch: occupancy query says %d\n", per_cu); }
        (void)hipGetLastError();
        grid = cus;
        if (grid > 256) grid = 256;
    }
    if (grid < 0) return;
    (void)hipMemsetAsync((char*)d_ws + WS_CTL, 0, CTL_ZERO_BYTES, stream);
    Args a{};
    for (int i = 0; i < 28; ++i) a.in[i] = (const float*)d_in[i];
    a.out = (float*)d_out; a.ws = (unsigned char*)d_ws;
    constexpr int NPH = 2 + 10 * NLAYER;
#if MK_PER_PHASE
    for (int p = 0; p < NPH; ++p) { a.ph_lo = p; a.ph_hi = p + 1; hipLaunchKernelGGL(mega, dim3(grid), dim3(512), LDS_BYTES, stream, a); }
#else
    a.ph_lo = 0; a.ph_hi = NPH;
    hipLaunchKernelGGL(mega, dim3(grid), dim3(512), LDS_BYTES, stream, a);
#endif
    const hipError_t le = hipPeekAtLastError();
    if (le != hipSuccess) fprintf(stderr, "kernel_launch: launch failed: %s\n", hipGetErrorName(le));
}
```

```cpp
#include <hip/hip_runtime.h>
#include <cstdio>
#include <cstdint>

#ifndef MK_PER_PHASE
#define MK_PER_PHASE 0
#endif

#define GAS __attribute__((address_space(1)))
#define LAS __attribute__((address_space(3)))
typedef unsigned short bf16_t;
typedef short bf16x8 __attribute__((ext_vector_type(8)));
typedef short s16x4 __attribute__((ext_vector_type(4)));
typedef float f32x2 __attribute__((ext_vector_type(2)));
typedef float f32x4 __attribute__((ext_vector_type(4)));
typedef float f32x16 __attribute__((ext_vector_type(16)));
typedef unsigned u32x2 __attribute__((ext_vector_type(2)));
typedef unsigned u32x4 __attribute__((ext_vector_type(4)));
typedef int v8i __attribute__((ext_vector_type(8)));
typedef int v4i __attribute__((ext_vector_type(4)));

constexpr int DM = 1024, NB = 4, SEQ = 8192, NLAYER = 4, CTXL = 256;
constexpr int NCTX = NB * CTXL;
constexpr int NTOK = NCTX + NB * SEQ;
constexpr int KEYS = CTXL + SEQ;
constexpr int PROJW = 2048;
constexpr int NEXP = 32, TOPK = 4;
constexpr int CAP_TILES = 560, CAP_ROWS = CAP_TILES * 256;
constexpr float LN_EPS = 1e-5f, RMS_EPS = 1e-6f;
constexpr float DN_ALPHA = 1.681792830507429f;
constexpr float MLA_SCALE = 0.07216878364870322f;
constexpr float RET_QSCALE = 0.1767766952966369f;
constexpr float ACT_Q = 4.f;      constexpr int ACT_E = 0x7d7d7d7d;
constexpr float WGU_Q = 128.f;    constexpr int WGU_E = 0x78787878;
constexpr float WDN_Q = 256.f;    constexpr int WDN_E = 0x77777777;
constexpr float QK_Q = 8.f;       constexpr int QK_E = 0x7c7c7c7c;
constexpr float QC_Q = 16.f * 0.07216878364870322f * 1.4426950408889634f;   constexpr int QC_E = 0x7b7b7b7b;
constexpr float PV_Q = 8.f;       constexpr int PV_E = 0x7c7c7c7c;
constexpr int VT_ROW = 80, VT_TILE = 128 * VT_ROW;
constexpr float DO_Q = 64.f;
constexpr int C_CQ = 0, C_CKV = 384, C_KR = 640, C_SGU = 704, C_SGV = 960, C_RQ = 1216, C_RK = 1344, C_RV = 1472, C_RG = 1728;

constexpr size_t MiB = 1u << 20;
constexpr size_t WS_CTL = 0, CTL_ZERO_BYTES = 1 * MiB;
constexpr size_t WS_MOD = 1 * MiB;
constexpr size_t WS_ATAB = 2 * MiB;
constexpr size_t WS_RTAB = 2 * MiB + 65536;
constexpr size_t WS_WIN = 4 * MiB;
constexpr size_t WS_WUQ = 20 * MiB;
constexpr size_t WS_WUKV = 23 * MiB;
constexpr size_t WS_WO = 25 * MiB;
constexpr size_t WS_SGWB = 34 * MiB;
constexpr size_t WS_WGU = 64 * MiB;
constexpr size_t WS_WDN = 576 * MiB;
constexpr size_t WS_XRES = 832 * MiB;
constexpr size_t WS_XH = 964 * MiB;
constexpr size_t WS_PROJ = 1030 * MiB;
constexpr size_t WS_CQN = 1162 * MiB;
constexpr size_t WS_CKVN = 1187 * MiB;
constexpr size_t WS_QB = 1204 * MiB;
constexpr size_t WS_KB = 1254 * MiB;
constexpr size_t WS_VB = 1304 * MiB;
constexpr size_t WS_SGU = 1337 * MiB;
constexpr size_t WS_SGV = 1354 * MiB;
constexpr size_t WS_RQ = 1371 * MiB;
constexpr size_t WS_RK = 1388 * MiB;
constexpr size_t WS_OF = 1405 * MiB;
constexpr size_t WS_OB = 1438 * MiB;
constexpr size_t WS_MIX = 1471 * MiB;
constexpr size_t WS_Y = 1537 * MiB;
constexpr size_t WS_TOPI = 1669 * MiB;
constexpr size_t WS_GATE = 1670 * MiB;
constexpr size_t WS_DEST = 1671 * MiB;
constexpr size_t WS_ROWTOK = 1672 * MiB;
constexpr size_t WS_ACT = 1673 * MiB;
constexpr size_t WS_XH8 = 1830 * MiB;
constexpr size_t WS_DOUT = 1953 * MiB;
constexpr size_t WS_END = 2233 * MiB;
constexpr int CW_BAR = 4096;
constexpr int CW_BLKCNT = 16384;
constexpr int CW_NT = 32768;
constexpr int CW_TILE_E = 32832;
constexpr int CW_ECTX = 40960;

constexpr int LDS_BYTES = 147456;
constexpr int RING_BYTES = 131072;
constexpr int MISC_OFF = LDS_BYTES - 256;

#define RLX_AGENT __ATOMIC_RELAXED, __HIP_MEMORY_SCOPE_AGENT
__device__ __forceinline__ unsigned f2bf(float f) { unsigned u = __builtin_bit_cast(unsigned, f); return (u + 0x7fffu + ((u >> 16) & 1u)) >> 16; }
__device__ __forceinline__ unsigned pk2(float lo, float hi) { return f2bf(lo) | (f2bf(hi) << 16); }
__device__ __forceinline__ float bf2f(unsigned short h) { return __builtin_bit_cast(float, (unsigned)h << 16); }
__device__ __forceinline__ float bflo(unsigned w) { return __builtin_bit_cast(float, w << 16); }
__device__ __forceinline__ float bfhi(unsigned w) { return __builtin_bit_cast(float, w & 0xffff0000u); }
__device__ __forceinline__ unsigned cvt_pk_bf16(float lo, float hi) { unsigned r; asm volatile("v_cvt_pk_bf16_f32 %0, %1, %2" : "=v"(r) : "v"(lo), "v"(hi)); return r; }
__device__ __forceinline__ unsigned pk4_fp8(float x0, float x1, float x2, float x3) { int w = 0; w = __builtin_amdgcn_cvt_pk_fp8_f32(x0, x1, w, false); w = __builtin_amdgcn_cvt_pk_fp8_f32(x2, x3, w, true); return (unsigned)w; }
template <int CTRL> __device__ __forceinline__ float dpp_f(float v) { return __builtin_bit_cast(float, __builtin_amdgcn_update_dpp(0, __builtin_bit_cast(int, v), CTRL, 0xf, 0xf, true)); }
template <int CTRL> __device__ __forceinline__ int dpp_i(int v) { return __builtin_amdgcn_update_dpp(0, v, CTRL, 0xf, 0xf, true); }
__device__ __forceinline__ float wave_sum(float v) {
    v += dpp_f<0xB1>(v);
    v += dpp_f<0x4E>(v);
    v += dpp_f<0x141>(v);
    v += dpp_f<0x140>(v);
    { const int b_ = __builtin_bit_cast(int, v);
      const float r0 = __builtin_bit_cast(float, __builtin_amdgcn_readlane(b_, 0)), r1 = __builtin_bit_cast(float, __builtin_amdgcn_readlane(b_, 16)), r2 = __builtin_bit_cast(float, __builtin_amdgcn_readlane(b_, 32)), r3 = __builtin_bit_cast(float, __builtin_amdgcn_readlane(b_, 48));
      v = (r0 + r1) + (r2 + r3); }
    return v;
}
__device__ __forceinline__ int lane_id() { int l; asm volatile("v_mbcnt_lo_u32_b32 %0, -1, 0\n\tv_mbcnt_hi_u32_b32 %0, -1, %0" : "=v"(l)); return l; }
__device__ __forceinline__ int ld_ctl(const unsigned* p) { return (int)__hip_atomic_load(p, RLX_AGENT); }
__device__ __forceinline__ float gelu1(float v) {
    const float av = fabsf(v), d = av * 0.2316418882f + 1.0f, t = __builtin_amdgcn_rcpf(d);
    float q = t * 0.5307027145f + (-0.7265760135f); q = q * t + 0.7107068705f; q = q * t + (-0.142248368f); q = q * t + 0.127414796f; q = q * t;
    const float e = __builtin_amdgcn_exp2f((v * v) * (-0.72134752044f));
    const float m = v * (q * e), r = v - m;
    return v < 0.f ? m : r;
}
__device__ __forceinline__ float sigmoidf_(float x) { return __builtin_amdgcn_rcpf(1.f + __builtin_amdgcn_exp2f(-1.4426950408889634f * x)); }
__device__ __forceinline__ int modset(int n) { return (n < NCTX) ? 4 : ((n - NCTX) >> 13); }

__device__ const double INV_R[16] = {1.0, 0.5411695265464637, 0.2928644564625237, 0.15848931924611134, 0.08576958985908942, 0.046415888336127795, 0.025118864315095794, 0.013593563908785255,
                                     0.007356422544596414, 0.003981071705534973, 0.0021544346900318843, 0.0011659144011798323, 0.000630957344480193, 0.0003414548873833601, 0.00018478497974222906, 0.0001};
__device__ const double INV_A[16] = {1.0, 0.5623413251903491, 0.31622776601683794, 0.1778279410038923, 0.1, 0.05623413251903491, 0.03162277660168379, 0.01778279410038923,
                                     0.01, 0.005623413251903491, 0.0031622776601683794, 0.0017782794100389228, 0.001, 0.0005623413251903491, 0.00031622776601683794, 0.00017782794100389227};
__device__ __forceinline__ void sincos_d(double x, float& s, float& c) {
    const double k = rint(x * 0.15915494309189535);
    double r = fma(-k, 6.283185307179586, x); r = fma(-k, 2.4492935982947064e-16, r);
    const double r2 = r * r;
    double ps = -1.0 / 51090942171709440000.0;
    ps = fma(ps, r2, 1.0 / 121645100408832000.0);
    ps = fma(ps, r2, -1.0 / 355687428096000.0);
    ps = fma(ps, r2, 1.0 / 1307674368000.0);
    ps = fma(ps, r2, -1.0 / 6227020800.0);
    ps = fma(ps, r2, 1.0 / 39916800.0);
    ps = fma(ps, r2, -1.0 / 362880.0);
    ps = fma(ps, r2, 1.0 / 5040.0);
    ps = fma(ps, r2, -1.0 / 120.0);
    ps = fma(ps, r2, 1.0 / 6.0);
    ps = fma(ps, r2, -1.0);
    ps = -ps * r;
    double pc = 1.0 / 2432902008176640000.0;
    pc = fma(pc, r2, -1.0 / 6402373705728000.0);
    pc = fma(pc, r2, 1.0 / 20922789888000.0);
    pc = fma(pc, r2, -1.0 / 87178291200.0);
    pc = fma(pc, r2, 1.0 / 479001600.0);
    pc = fma(pc, r2, -1.0 / 3628800.0);
    pc = fma(pc, r2, 1.0 / 40320.0);
    pc = fma(pc, r2, -1.0 / 720.0);
    pc = fma(pc, r2, 1.0 / 24.0);
    pc = fma(pc, r2, -0.5);
    pc = fma(pc, r2, 1.0);
    s = (float)ps; c = (float)pc;
}

#define XB_TMO      128
#define XB_XCNT(j)  (256  + 64 * (j))
#define XB_XSUB(j)  (1280 + 64 * (j))
#define XB_XGEN(j)  (2304 + 64 * (j))
#define XB_TOP      3328
#define XB_TOPGEN   3392
#define XCD_BAR_WORDS 3456
#define XB_SPIN_CAP (1u << 24)
__device__ __forceinline__ unsigned xb_ld(unsigned* p)              { return __hip_atomic_load(p, __ATOMIC_RELAXED, __HIP_MEMORY_SCOPE_AGENT); }
__device__ __forceinline__ unsigned xb_add(unsigned* p, unsigned v) { return __hip_atomic_fetch_add(p, v, __ATOMIC_RELAXED, __HIP_MEMORY_SCOPE_AGENT); }
__device__ __forceinline__ unsigned xb_xcc_id() { return (unsigned)__builtin_amdgcn_s_getreg((3 << 11) | 20) & 0xFu; }
#define XB_SPIN(cond, bar) do { unsigned _sp = 0; while (cond) { __builtin_amdgcn_s_sleep(1); \
    if ((++_sp & 255u) == 0u) { if (xb_ld(&(bar)[XB_TMO])) break; if (_sp > XB_SPIN_CAP) { atomicAdd(&(bar)[XB_TMO], 1u); break; } } } } while (0)
struct XcdBarrier { unsigned* bar; unsigned x; volatile LAS unsigned* st; int wave; };
__device__ __forceinline__ XcdBarrier xcd_barrier_post(unsigned* bar, volatile LAS unsigned* st) {
    XcdBarrier b; b.bar = bar; b.x = xb_xcc_id(); b.st = st; b.wave = 0;
    if (threadIdx.x == 0) (void)xb_add(&bar[XB_XCNT(b.x)], 1u);
    return b;
}
__device__ __forceinline__ void xcd_barrier_complete(unsigned* bar, unsigned x, unsigned& nloc, unsigned& nx) {
    const unsigned G = gridDim.x * gridDim.y * gridDim.z;
    unsigned sum, cnt, mine, sp = 0u;
    for (;;) {
        sum = 0u; cnt = 0u; mine = 0u;
#pragma unroll
        for (unsigned j = 0; j < 16; ++j) { const unsigned c = xb_ld(&bar[XB_XCNT(j)]); sum += c; cnt += (c > 0u) ? 1u : 0u; mine = (j == x) ? c : mine; }
        if (sum == G) break;
        __builtin_amdgcn_s_sleep(1);
        if ((++sp & 255u) == 0u) { if (xb_ld(&bar[XB_TMO])) break; if (sp > XB_SPIN_CAP) { atomicAdd(&bar[XB_TMO], 1u); break; } }
    }
    nloc = mine > 0u ? mine : 1u; nx = cnt > 0u ? cnt : 1u;
}
__device__ __forceinline__ void xcd_barrier(const XcdBarrier& b) {
    asm volatile("s_waitcnt vmcnt(0)" ::: "memory");
    __syncthreads();
    if (b.wave == 0 && lane_id() == 0) {
        unsigned* bar = b.bar;
        __builtin_amdgcn_s_waitcnt(0);
        unsigned nloc = b.st[0], nx = b.st[1];
        if (nloc == 0u) { xcd_barrier_complete(bar, b.x, nloc, nx); b.st[0] = nloc; b.st[1] = nx; }
        const unsigned old = xb_add(&bar[XB_XSUB(b.x)], 1u);
        const unsigned gen = old / nloc;
        if (old + 1u == (gen + 1u) * nloc) {
            __builtin_amdgcn_fence(__ATOMIC_RELEASE, "agent");
            asm volatile("s_waitcnt vmcnt(0)" ::: "memory");
            const unsigned og = xb_add(&bar[XB_TOP], 1u);
            const unsigned tg = og / nx;
            if (og + 1u == (tg + 1u) * nx) xb_add(&bar[XB_TOPGEN], 1u);
            else XB_SPIN(xb_ld(&bar[XB_TOPGEN]) == tg, bar);
            __builtin_amdgcn_fence(__ATOMIC_ACQUIRE, "agent");
            xb_add(&bar[XB_XGEN(b.x)], 1u);
            asm volatile("s_waitcnt vmcnt(0)" ::: "memory");
        } else {
            XB_SPIN(xb_ld(&bar[XB_XGEN(b.x)]) == gen, bar);
            __builtin_amdgcn_fence(__ATOMIC_ACQUIRE, "agent");
            asm volatile("s_waitcnt vmcnt(0)" ::: "memory");
        }
    }
    __syncthreads();
}

namespace pg8 {
constexpr int BM = 256, BK = 64, HALF = 128, HTB = HALF * BK * 2, NXCD = 8, WGM = 8;
__host__ __device__ __forceinline__ int lds_byte(int r, int c) { const int st = (r >> 4) * 2 + (c >> 5), rr = r & 15, cc = c & 31, ob = rr * 64 + cc * 2; return st * 1024 + (ob ^ (((ob >> 9) & 1) << 5)); }
__host__ __device__ __forceinline__ void stage_rc(int b, int& R, int& C) { const int st = b / 1024, sb = b % 1024, swz = sb ^ (((sb >> 9) & 1) << 5); R = (st >> 1) * 16 + swz / 64; C = (st & 1) * 32 + (swz % 64) / 2; }
__host__ __device__ __forceinline__ int perm32(int rho) { const int n = rho >> 4, i = rho & 15; return 8 * (i >> 2) + 4 * n + (i & 3); }
struct Unit { int pm, pn; };
struct Gemm { const void* A; const void* Bt; int lda, K; const LAS unsigned short* rowlds; int scaleA, scaleB; };

struct StaticOrder {
    int nM, nN, nwg, G, c;
    __device__ __forceinline__ void init(int nM_, int nN_, int G_, int c_) { nM = nM_; nN = nN_; nwg = nM * nN; G = G_; c = c_; }
    __device__ __forceinline__ bool next(int i, Unit& u) const {
        const long L = (long)i * G + c; if (L >= nwg) return false;
        int wgid = (int)L; { const int q = nwg / NXCD, r = nwg % NXCD, xcd = wgid % NXCD, off = wgid / NXCD; wgid = (xcd < r ? xcd * (q + 1) : r * (q + 1) + (xcd - r) * q) + off; }
        const int nig = WGM * nN, gid = wgid / nig, fm = gid * WGM, gsz = (nM - fm) < WGM ? (nM - fm) : WGM;
        u.pm = fm + ((wgid % nig) % gsz); u.pn = (wgid % nig) / gsz; return true;
    }
};
struct OneUnit { int pm, pn; __device__ __forceinline__ bool next(int i, Unit& u) const { if (i != 0) return false; u.pm = pm; u.pn = pn; return true; } };
struct MoeOrder {
    StaticOrder so; const LAS unsigned char* tile_e;
    __device__ __forceinline__ bool next(int i, Unit& u) const {
        if (!so.next(i, u)) return false;
        const int e = __builtin_amdgcn_readfirstlane((int)tile_e[u.pm]);
        u.pn = e * so.nN + u.pn; return true;
    }
};

template <class Epi, class Sched, bool GATHER, bool FP8 = false>
__device__ __forceinline__ void gemm_phase(LAS unsigned char* lds, const Gemm g, const Sched& S, const Epi& E, const int wave_s) {
    int tid_ = wave_s * 64 + lane_id(); asm volatile("" : "+v"(tid_));
    const int tid = tid_, wid = __builtin_amdgcn_readfirstlane(tid >> 6), lane = tid & 63, wr = wid >> 2, wc = wid & 3, fr = lane & 15, fq = lane >> 4;
    constexpr int ESZ = FP8 ? 1 : 2;
    const int K = g.K, nt = K * ESZ / (BK * 2);
    int RA[2]; unsigned CA2[2], voffB[2];
#pragma unroll
    for (int i = 0; i < 2; ++i) { int R, C; stage_rc(tid * 16 + i * 8192, R, C); const int Rb = Epi::PERM ? ((R & ~31) + perm32(R & 31)) : R;
        RA[i] = R; CA2[i] = (unsigned)C * 2u; voffB[i] = (unsigned)(Rb * K * ESZ + C * 2); }
    const unsigned lda2 = (unsigned)g.lda * ESZ;
    const size_t kstep = (size_t)(BK * 2);
    const size_t hstepB = (size_t)HALF * K * ESZ, tstepB = 2 * hstepB;
    const unsigned ldsw = (unsigned)wid * 1024u;
    const int aoff = lds_byte(wr * 64 + fr, fq * 8), boff = lds_byte(wc * 32 + fr, fq * 8);
#define PG8_SA(b, h) (((b) * 2 + (h)) * HTB)
#define PG8_SB(b, h) ((4 + (b) * 2 + (h)) * HTB)
#define PG8_STAGE_B(bufoff, gbase) do { _Pragma("unroll") for (int _i = 0; _i < 2; ++_i) \
        __builtin_amdgcn_global_load_lds((const unsigned*)((const char*)(gbase) + voffB[_i]), (LAS unsigned*)(lds + (bufoff) + ldsw + _i * 8192), 16, 0, 0); } while (0)
#define PG8_STAGE_A(bufoff, gbase, UA) do { _Pragma("unroll") for (int _i = 0; _i < 2; ++_i) \
        __builtin_amdgcn_global_load_lds((const unsigned*)((const char*)(gbase) + (UA)[_i]), (LAS unsigned*)(lds + (bufoff) + ldsw + _i * 8192), 16, 0, 0); } while (0)
#define PG8_LD8(base) __builtin_shufflevector(*(const LAS v4i*)(base), *(const LAS v4i*)((base) + 1024), 0, 1, 2, 3, 4, 5, 6, 7)
#define PG8_LDA(dst, b, h) do { _Pragma("unroll") for (int m = 0; m < 4; ++m) dst[m] = PG8_LD8(lds + PG8_SA(b, h) + aoff + m * 2048); } while (0)
#define PG8_LDB(dst, b, h) do { _Pragma("unroll") for (int n = 0; n < 2; ++n) dst[n] = PG8_LD8(lds + PG8_SB(b, h) + boff + n * 2048); } while (0)
#define PG8_HALF(F, k) __builtin_bit_cast(bf16x8, (k) ? __builtin_shufflevector(F, F, 4, 5, 6, 7) : __builtin_shufflevector(F, F, 0, 1, 2, 3))
#define PG8_MMA(ai, bj, At, Bt) do { __builtin_amdgcn_s_setprio(1); \
        if constexpr (FP8) { _Pragma("unroll") for (int m = 0; m < 4; ++m) _Pragma("unroll") for (int n = 0; n < 2; ++n) \
            asm volatile("v_mfma_scale_f32_16x16x128_f8f6f4 %0, %1, %2, %0, %3, %4 op_sel_hi:[0,0,0]" : "+v"(acc[ai][bj][m][n]) : "v"(Bt[n]), "v"(At[m]), "v"(scB), "v"(scA)); } \
        else { _Pragma("unroll") for (int m = 0; m < 4; ++m) _Pragma("unroll") for (int n = 0; n < 2; ++n) _Pragma("unroll") for (int k = 0; k < 2; ++k) \
            acc[ai][bj][m][n] = __builtin_amdgcn_mfma_f32_16x16x32_bf16(PG8_HALF(Bt[n], k), PG8_HALF(At[m], k), acc[ai][bj][m][n], 0, 0, 0); } \
        __builtin_amdgcn_s_setprio(0); } while (0)
#define PG8_WAIT_V(n) asm volatile("s_waitcnt vmcnt(" #n ")" ::: "memory")
#define PG8_WAIT_L(n) asm volatile("s_waitcnt lgkmcnt(" #n ")" ::: "memory")
#define PG8_BAR __builtin_amdgcn_s_barrier()
#define PG8_SCHED __builtin_amdgcn_sched_barrier(0)
#define PG8_CALC_UA(dst, un, uord) do { _Pragma("unroll") for (int _h = 0; _h < 2; ++_h) _Pragma("unroll") for (int _i = 0; _i < 2; ++_i) { \
        int _rr = (un).pm * BM + _h * HALF + RA[_i]; if (GATHER) _rr = (int)g.rowlds[(uord) * 256 + _h * HALF + RA[_i]]; dst[_h][_i] = (unsigned)_rr * lda2 + CA2[_i]; } } while (0)
    Unit cur, nxt; int ui = 0;
    if (!S.next(0, cur)) return;
    const int scA = g.scaleA, scB = g.scaleB; (void)scA; (void)scB;
    if constexpr (Epi::BIAS_LDS) { if (wid == 0) __builtin_amdgcn_global_load_lds((const unsigned*)(E.bias_src(cur) + lane_id() * 4), (LAS unsigned*)(lds + Epi::BIAS_OFF), 16, 0, 0); }
    unsigned uAc[2][2], uAn[2][2];
    const size_t tstepA = (size_t)BM * lda2;
    if constexpr (GATHER) { PG8_CALC_UA(uAc, cur, 0); }
    else {
#pragma unroll
        for (int h = 0; h < 2; ++h)
#pragma unroll
            for (int i = 0; i < 2; ++i) { uAc[h][i] = (unsigned)(h * HALF + RA[i]) * lda2 + CA2[i]; uAn[h][i] = uAc[h][i]; } }
    f32x4 acc[2][2][4][2];
#pragma unroll
    for (int a = 0; a < 2; ++a)
#pragma unroll
        for (int b = 0; b < 2; ++b)
#pragma unroll
            for (int m = 0; m < 4; ++m)
#pragma unroll
                for (int n = 0; n < 2; ++n) acc[a][b][m][n] = (f32x4){0.f, 0.f, 0.f, 0.f};
    v8i At[4], B0[2], B1[2];
    const char* cA = GATHER ? (const char*)g.A : (const char*)g.A + (size_t)cur.pm * tstepA;
    const char* cB = (const char*)g.Bt + (size_t)cur.pn * tstepB;
    PG8_STAGE_B(PG8_SB(0, 0), cB); PG8_STAGE_B(PG8_SB(0, 1), cB + hstepB); PG8_STAGE_A(PG8_SA(0, 0), cA, uAc[0]); PG8_STAGE_A(PG8_SA(0, 1), cA, uAc[1]);
    if (wr == 1) PG8_BAR;
    PG8_WAIT_V(2); PG8_BAR;
    PG8_STAGE_B(PG8_SB(1, 0), cB + kstep); PG8_STAGE_A(PG8_SA(1, 0), cA + kstep, uAc[0]); PG8_STAGE_B(PG8_SB(1, 1), cB + hstepB + kstep);
    PG8_WAIT_V(6); PG8_BAR;
    for (;;) {
        const bool has_next = S.next(ui + 1, nxt);
        const char* nB = has_next ? (const char*)g.Bt + (size_t)nxt.pn * tstepB : cB;
        const char* nA = (GATHER || !has_next) ? cA : (const char*)g.A + (size_t)nxt.pm * tstepA;
        if constexpr (GATHER) {
            if (has_next) { PG8_CALC_UA(uAn, nxt, ui + 1); }
            else {
#pragma unroll
                for (int h = 0; h < 2; ++h)
#pragma unroll
                    for (int i = 0; i < 2; ++i) uAn[h][i] = uAc[h][i]; } }
#pragma unroll 1
        for (int t = 0; t < nt; t += 2) {
            const bool last = (t == nt - 2);
            const char* a1 = cA + (size_t)(t + 1) * kstep;
            const char* a2 = last ? nA : cA + (size_t)(t + 2) * kstep; const char* b2 = last ? nB : cB + (size_t)(t + 2) * kstep;
            const char* a3 = a2 + kstep; const char* b3 = b2 + kstep;
            unsigned u2[2][2];
#pragma unroll
            for (int h = 0; h < 2; ++h)
#pragma unroll
                for (int i = 0; i < 2; ++i) u2[h][i] = (GATHER && last) ? uAn[h][i] : uAc[h][i];
            PG8_LDB(B0, 0, 0); PG8_LDB(B1, 0, 1); PG8_SCHED; PG8_LDA(At, 0, 0); PG8_STAGE_A(PG8_SA(1, 1), a1, uAc[1]);
            PG8_WAIT_V(8); PG8_WAIT_L(0); PG8_BAR; PG8_MMA(0, 0, At, B0); PG8_MMA(0, 1, At, B1); PG8_BAR; PG8_SCHED;
            PG8_LDA(At, 0, 1); PG8_STAGE_B(PG8_SB(0, 0), b2); PG8_STAGE_B(PG8_SB(0, 1), b2 + hstepB); PG8_STAGE_A(PG8_SA(0, 0), a2, u2[0]);
            PG8_WAIT_V(8); PG8_WAIT_L(0); PG8_BAR; PG8_MMA(1, 0, At, B0); PG8_MMA(1, 1, At, B1); PG8_BAR; PG8_SCHED;
            PG8_LDB(B0, 1, 0); PG8_LDB(B1, 1, 1); PG8_SCHED; PG8_LDA(At, 1, 0); PG8_STAGE_A(PG8_SA(0, 1), a2, u2[1]);
            PG8_WAIT_V(8); PG8_WAIT_L(0); PG8_BAR; PG8_MMA(0, 0, At, B0); PG8_MMA(0, 1, At, B1); PG8_BAR; PG8_SCHED;
            PG8_LDA(At, 1, 1); PG8_STAGE_B(PG8_SB(1, 0), b3); PG8_STAGE_B(PG8_SB(1, 1), b3 + hstepB); PG8_STAGE_A(PG8_SA(1, 0), a3, u2[0]);
            PG8_WAIT_V(8); PG8_WAIT_L(0); PG8_BAR; PG8_MMA(1, 0, At, B0); PG8_MMA(1, 1, At, B1); PG8_BAR; PG8_SCHED;
        }
        if (wr == 0) PG8_BAR;
        if constexpr (FP8) { asm volatile("s_nop 15\n\ts_nop 15" ::: "memory"); PG8_SCHED; }
        if constexpr (Epi::BIAS_LDS) E(acc, cur, wr, wc, fr, fq, (const LAS float*)(lds + Epi::BIAS_OFF + (ui & 1) * 1024)); else E(acc, cur, wr, wc, fr, fq);
        if (!has_next) break;
#pragma unroll
        for (int a = 0; a < 2; ++a)
#pragma unroll
            for (int b = 0; b < 2; ++b)
#pragma unroll
                for (int m = 0; m < 4; ++m)
#pragma unroll
                    for (int n = 0; n < 2; ++n) acc[a][b][m][n] = (f32x4){0.f, 0.f, 0.f, 0.f};
        cur = nxt; cB = nB; cA = nA; ++ui;
        if constexpr (Epi::BIAS_LDS) { if (wid == 0) __builtin_amdgcn_global_load_lds((const unsigned*)(E.bias_src(cur) + lane_id() * 4), (LAS unsigned*)(lds + Epi::BIAS_OFF + (ui & 1) * 1024), 16, 0, 0); }
        if constexpr (GATHER) {
#pragma unroll
            for (int h = 0; h < 2; ++h)
#pragma unroll
                for (int i = 0; i < 2; ++i) uAc[h][i] = uAn[h][i]; }
        if (wr == 1) PG8_BAR;
    }
    PG8_WAIT_V(0);
    PG8_BAR;
#undef PG8_SA
#undef PG8_SB
#undef PG8_STAGE_A
#undef PG8_STAGE_B
#undef PG8_LDA
#undef PG8_LDB
#undef PG8_MMA
#undef PG8_LD8
#undef PG8_HALF
#undef PG8_WAIT_V
#undef PG8_WAIT_L
#undef PG8_BAR
#undef PG8_SCHED
#undef PG8_CALC_UA
}

struct EpiF32 { static constexpr bool BIAS_LDS = false; static constexpr int BIAS_OFF = 0;
    static constexpr bool PERM = false;
    float* C; int ldc;
    __device__ __forceinline__ void operator()(const f32x4 (&acc)[2][2][4][2], const Unit& u, int wr, int wc, int fr, int fq) const {
        const int row0 = u.pm * BM + wr * 64 + fr, col0 = u.pn * BM + wc * 32 + 4 * fq;
#pragma unroll
        for (int ai = 0; ai < 2; ++ai)
#pragma unroll
            for (int m = 0; m < 4; ++m) { float* rowp = C + (size_t)(row0 + ai * HALF + m * 16) * ldc + col0;
#pragma unroll
                for (int bj = 0; bj < 2; ++bj)
#pragma unroll
                    for (int n = 0; n < 2; ++n) *(f32x4*)(rowp + bj * HALF + n * 16) = acc[ai][bj][m][n]; }
    }
};
struct EpiBf16 {
    static constexpr bool PERM = true, BIAS_LDS = false; static constexpr int BIAS_OFF = 0;
    bf16_t* O; int ldc;
    __device__ __forceinline__ void operator()(const f32x4 (&acc)[2][2][4][2], const Unit& u, int wr, int wc, int fr, int fq) const {
        const int row0 = u.pm * BM + wr * 64 + fr, col0 = u.pn * BM + wc * 32 + 8 * fq;
#pragma unroll
        for (int ai = 0; ai < 2; ++ai)
#pragma unroll
            for (int m = 0; m < 4; ++m) { bf16_t* rowp = O + (size_t)(row0 + ai * HALF + m * 16) * ldc + col0;
#pragma unroll
                for (int bj = 0; bj < 2; ++bj) { const f32x4 v0 = acc[ai][bj][m][0], v1 = acc[ai][bj][m][1];
                    u32x4 w; w.x = cvt_pk_bf16(v0[0], v0[1]); w.y = cvt_pk_bf16(v0[2], v0[3]); w.z = cvt_pk_bf16(v1[0], v1[1]); w.w = cvt_pk_bf16(v1[2], v1[3]);
                    *(u32x4*)(rowp + bj * HALF) = w; } }
    }
};
struct EpiK {
    static constexpr bool PERM = true, BIAS_LDS = false; static constexpr int BIAS_OFF = 0;
    unsigned char* KB;
    __device__ __forceinline__ void operator()(const f32x4 (&acc)[2][2][4][2], const Unit& u, int wr, int wc, int fr, int fq) const {
        const int row0 = u.pm * BM + wr * 64 + fr, cw = wc * 32 + 8 * fq;
        unsigned char* base = KB + (u.pn * 2) * 192 + cw;
#pragma unroll
        for (int ai = 0; ai < 2; ++ai)
#pragma unroll
            for (int m = 0; m < 4; ++m) { unsigned char* rowp = base + (size_t)(row0 + ai * HALF + m * 16) * 768;
#pragma unroll
                for (int bj = 0; bj < 2; ++bj) { const f32x4 v0 = acc[ai][bj][m][0] * QK_Q, v1 = acc[ai][bj][m][1] * QK_Q;
                    u32x2 w; w.x = pk4_fp8(v0[0], v0[1], v0[2], v0[3]); w.y = pk4_fp8(v1[0], v1[1], v1[2], v1[3]);
                    *(u32x2*)(rowp + bj * 192) = w; } }
    }
};
struct EpiVT {
    static constexpr bool PERM = true, BIAS_LDS = false; static constexpr int BIAS_OFF = 0;
    unsigned char* VT;
    __device__ __forceinline__ void operator()(const f32x4 (&acc)[2][2][4][2], const Unit& u, int wr, int wc, int fr, int fq) const {
        const int row0 = u.pm * BM + wr * 64 + fr, col0 = u.pn * BM + wc * 32 + 8 * fq;
#pragma unroll
        for (int bj = 0; bj < 2; ++bj) {
            const int n = col0 + bj * HALF;
            const int b = (n < NCTX) ? (n >> 8) : ((n - NCTX) >> 13); const int key = (n < NCTX) ? (n & 255) : CTXL + ((n - NCTX) & 8191);
            const int tile = key >> 6, kk0 = key & 63; const int boff = (kk0 >> 5) * 16 + 4 * ((kk0 & 31) >> 3);
#pragma unroll
            for (int ai = 0; ai < 2; ++ai)
#pragma unroll
                for (int m = 0; m < 4; ++m) { const int vc = row0 + ai * HALF + m * 16; const int hh = vc >> 7, v = vc & 127;
                    unsigned char* p = VT + ((size_t)((b * 4 + hh) * (KEYS / 64) + tile)) * VT_TILE + v * VT_ROW + boff;
                    const f32x4 v0 = acc[ai][bj][m][0] * PV_Q, v1 = acc[ai][bj][m][1] * PV_Q;
                    *(unsigned*)p = pk4_fp8(v0[0], v0[1], v0[2], v0[3]); *(unsigned*)(p + 32) = pk4_fp8(v1[0], v1[1], v1[2], v1[3]); } }
    }
};
struct EpiSwiglu {
    static constexpr bool PERM = true, BIAS_LDS = true; static constexpr int BIAS_OFF = RING_BYTES + 12288;
    unsigned char* ACT; const float* bias;
    __device__ __forceinline__ const float* bias_src(const Unit& u) const { return bias + (u.pn >> 3) * 2048 + (u.pn & 7) * BM; }
    __device__ __forceinline__ void operator()(const f32x4 (&acc)[2][2][4][2], const Unit& u, int wr, int wc, int fr, int fq, const LAS float* bl) const {
        const int pnl = u.pn & 7;
        const int row0 = u.pm * BM + wr * 64 + fr, cl = wc * 32 + 8 * fq, col0 = pnl * BM + cl;
#pragma unroll
        for (int ai = 0; ai < 2; ++ai)
#pragma unroll
            for (int m = 0; m < 4; ++m) { unsigned char* rowp = ACT + (size_t)(row0 + ai * HALF + m * 16) * 1024 + (col0 >> 1);
#pragma unroll
                for (int bj = 0; bj < 2; ++bj) { const f32x4 v0 = acc[ai][bj][m][0] + *(const LAS f32x4*)(bl + cl + bj * HALF), v1 = acc[ai][bj][m][1] + *(const LAS f32x4*)(bl + cl + bj * HALF + 4);
                    float o[4];
#pragma unroll
                    for (int i = 0; i < 4; ++i) { const float hg = (i < 2) ? v0[2 * i] : v1[2 * i - 4], hl = (i < 2) ? v0[2 * i + 1] : v1[2 * i - 3];
                        const float glu = fminf(hg, 7.f), lin = fminf(fmaxf(hl, -7.f), 7.f);
                        o[i] = glu * sigmoidf_(1.702f * glu) * (lin + 1.f); }
                    *(unsigned*)(rowp + bj * (HALF / 2)) = pk4_fp8(o[0] * ACT_Q, o[1] * ACT_Q, o[2] * ACT_Q, o[3] * ACT_Q); } }
    }
};
struct EpiDown {
    static constexpr bool PERM = true, BIAS_LDS = true; static constexpr int BIAS_OFF = RING_BYTES + 12288;
    unsigned char* O; const float* bias;
    __device__ __forceinline__ const float* bias_src(const Unit& u) const { return bias + (u.pn >> 2) * 1024 + (u.pn & 3) * BM; }
    __device__ __forceinline__ void operator()(const f32x4 (&acc)[2][2][4][2], const Unit& u, int wr, int wc, int fr, int fq, const LAS float* bl) const {
        const int pnl = u.pn & 3;
        const int row0 = u.pm * BM + wr * 64 + fr, cl = wc * 32 + 8 * fq, col0 = pnl * BM + cl;
#pragma unroll
        for (int ai = 0; ai < 2; ++ai)
#pragma unroll
            for (int m = 0; m < 4; ++m) { unsigned char* rowp = O + (size_t)(row0 + ai * HALF + m * 16) * 1024 + col0;
#pragma unroll
                for (int bj = 0; bj < 2; ++bj) { const f32x4 v0 = (acc[ai][bj][m][0] + *(const LAS f32x4*)(bl + cl + bj * HALF)) * DO_Q, v1 = (acc[ai][bj][m][1] + *(const LAS f32x4*)(bl + cl + bj * HALF + 4)) * DO_Q;
                    u32x2 w; w.x = pk4_fp8(v0[0], v0[1], v0[2], v0[3]); w.y = pk4_fp8(v1[0], v1[1], v1[2], v1[3]);
                    *(u32x2*)(rowp + bj * HALF) = w; } }
    }
};
}

namespace att {
constexpr int DQK = 192, DV = 128, NW = 8, QBLK = 32, KVBLK = 64;
constexpr int LDQ = 768, LDK = 768, LDV = 512, LDO = 1024;
constexpr float THR = 4.f;
constexpr int KROWB = 208;
constexpr int SHM_V = VT_TILE, SHM_K = KVBLK * KROWB;
constexpr int SHM_QR = 2 * SHM_V + 2 * SHM_K + NW * 64 * 4;
constexpr int SHM_ATTN = SHM_QR + NW * 4096;
#define KSWZ192(row, colB) ((row) * KROWB + (colB))
#define SBAR() __builtin_amdgcn_sched_barrier(0)
__device__ __forceinline__ int crow(int r, int hi) { return (r & 3) + 8 * (r >> 2) + 4 * hi; }
__device__ __forceinline__ float max3f(float a, float b, float c) { return fmaxf(fmaxf(a, b), c); }
__device__ __forceinline__ unsigned cvtpk(float lo, float hi) { unsigned r; asm volatile("v_cvt_pk_bf16_f32 %0, %1, %2" : "=v"(r) : "v"(lo), "v"(hi)); return r; }
constexpr float PSH = 3.f, THR2 = THR * 1.4426950408889634f;
__device__ __forceinline__ void partialSM(f32x16& p0, f32x16& p1, float& m_reg, float& alpha, const bool first) {
    float ma = max3f(p0[0], p0[1], p0[2]), mb = max3f(p0[3], p0[4], p0[5]), mc = max3f(p0[6], p0[7], p0[8]), md = max3f(p0[9], p0[10], p0[11]);
    ma = max3f(ma, p0[12], p0[13]); mb = max3f(mb, p0[14], p0[15]); mc = max3f(mc, p1[0], p1[1]); md = max3f(md, p1[2], p1[3]);
    ma = max3f(ma, p1[4], p1[5]); mb = max3f(mb, p1[6], p1[7]); mc = max3f(mc, p1[8], p1[9]); md = max3f(md, p1[10], p1[11]);
    ma = max3f(ma, p1[12], p1[13]); mb = max3f(mb, p1[14], p1[15]);
    float pmax = fmaxf(max3f(ma, mb, mc), md);
    { auto rr = __builtin_amdgcn_permlane32_swap(__float_as_uint(pmax), __float_as_uint(pmax), false, false);
      pmax = fmaxf(__uint_as_float(rr[0]), __uint_as_float(rr[1])); }
    const float u = pmax - PSH;
    if (__builtin_expect(!first && __all(u <= THR2), 1)) { alpha = 1.f; }
    else { const float dl = first ? u : fmaxf(u, 0.f); alpha = __builtin_amdgcn_exp2f(-dl); m_reg += dl;
#pragma unroll
        for (int r = 0; r < 16; ++r) { p0[r] -= dl; p1[r] -= dl; } }
#pragma unroll
    for (int r = 0; r < 16; ++r) p0[r] = __builtin_amdgcn_exp2f(p0[r]);
}
__device__ __forceinline__ void finishSM(f32x16& p0, f32x16& p1, float alpha, float& l_reg, v8i& pa) {
#pragma unroll
    for (int r = 0; r < 16; ++r) p1[r] = __builtin_amdgcn_exp2f(p1[r]);
    float sa = p0[0] + p0[1], sb = p0[2] + p0[3], sc = p0[4] + p0[5], sd = p0[6] + p0[7];
    sa += p0[8]; sb += p0[9]; sc += p0[10]; sd += p0[11]; sa += p0[12]; sb += p0[13]; sc += p0[14]; sd += p0[15];
#pragma unroll
    for (int r = 0; r < 16; r += 4) { sa += p1[r]; sb += p1[r + 1]; sc += p1[r + 2]; sd += p1[r + 3]; }
    float ps = (sa + sb) + (sc + sd);
    { auto rr = __builtin_amdgcn_permlane32_swap(__float_as_uint(ps), __float_as_uint(ps), false, false);
      ps = __uint_as_float(rr[0]) + __uint_as_float(rr[1]); }
    l_reg = l_reg * alpha + ps;
#pragma unroll
    for (int c = 0; c < 4; ++c) { pa[c] = (int)pk4_fp8(p0[4 * c], p0[4 * c + 1], p0[4 * c + 2], p0[4 * c + 3]);
        pa[4 + c] = (int)pk4_fp8(p1[4 * c], p1[4 * c + 1], p1[4 * c + 2], p1[4 * c + 3]); }
}
__device__ __forceinline__ void qkt(f32x16& p0, f32x16& p1, const float m_reg, const char* Ks, const v8i* q8, int r32, int hi) {
    { const float ini = PSH - m_reg;
#pragma unroll
      for (int r = 0; r < 16; ++r) { p0[r] = ini; p1[r] = ini; } }
#pragma unroll
    for (int ks = 0; ks < 3; ++ks) { const char* kp = Ks + r32 * KROWB + ks * 64 + hi * 32;
        const v8i a0 = __builtin_shufflevector(*reinterpret_cast<const v4i*>(kp), *reinterpret_cast<const v4i*>(kp + 16), 0, 1, 2, 3, 4, 5, 6, 7);
        const v8i a1 = __builtin_shufflevector(*reinterpret_cast<const v4i*>(kp + 32 * KROWB), *reinterpret_cast<const v4i*>(kp + 32 * KROWB + 16), 0, 1, 2, 3, 4, 5, 6, 7);
        p0 = __builtin_amdgcn_mfma_scale_f32_32x32x64_f8f6f4(a0, q8[ks], p0, 0, 0, 0, QK_E, 0, QC_E);
        p1 = __builtin_amdgcn_mfma_scale_f32_32x32x64_f8f6f4(a1, q8[ks], p1, 0, 0, 0, QK_E, 0, QC_E); }
}
__device__ __forceinline__ void pv_d0(f32x16* o, const char* Vs, const v8i pa, int r32, int hi) {
#pragma unroll
    for (int d0 = 0; d0 < 4; ++d0) { const char* vp = Vs + (d0 * 32 + r32) * VT_ROW + hi * 32;
        const v8i bv = __builtin_shufflevector(*reinterpret_cast<const v4i*>(vp), *reinterpret_cast<const v4i*>(vp + 16), 0, 1, 2, 3, 4, 5, 6, 7);
        o[d0] = __builtin_amdgcn_mfma_scale_f32_32x32x64_f8f6f4(pa, bv, o[d0], 0, 0, 0, PV_E, 0, PV_E); }
}
constexpr int ABUF = SHM_K + SHM_V;
constexpr int SHM_ATTN3 = 3 * ABUF + NW * 64 * 4;
__device__ __forceinline__ void attn_unit(const bf16_t* Qb, const unsigned char* Kh, const unsigned char* Vh, bf16_t* Ob, int seq, int cbase, int lbase, int t0, const f32x2* atab, char* lds, const int wave_s) {
    int tid_ = wave_s * 64 + lane_id(); asm volatile("" : "+v"(tid_));
    const int tid = tid_, wid = wave_s, lane = tid & 63, r32 = lane & 31, hi = lane >> 5;
    float* ws = (float*)(lds + 3 * ABUF) + wid * 64; float* li_l = ws; float* al_l = ws + 32;
    float m_reg = 0.f, l_reg = 0; f32x16 o[4] = {}; v8i qr[3];
    const bf16_t* Qw = Qb + (long)(wid * QBLK + r32) * LDQ + hi * 32;
#pragma unroll
    for (int ks = 0; ks < 3; ++ks) {
        float x[32];
#pragma unroll
        for (int c4 = 0; c4 < 4; ++c4) { const u32x4 w = *reinterpret_cast<const u32x4*>(Qw + ks * 64 + c4 * 8);
            x[8 * c4 + 0] = bflo(w.x); x[8 * c4 + 1] = bfhi(w.x); x[8 * c4 + 2] = bflo(w.y); x[8 * c4 + 3] = bfhi(w.y); x[8 * c4 + 4] = bflo(w.z); x[8 * c4 + 5] = bfhi(w.z); x[8 * c4 + 6] = bflo(w.w); x[8 * c4 + 7] = bfhi(w.w); }
        if (ks == 2 && t0 >= 0) { const int t = t0 + wid * QBLK + r32; const int pos = hi ? (t & 63) : (t >> 6); const f32x2* tb = atab + pos * 16;
#pragma unroll
            for (int f = 0; f < 16; ++f) { const f32x2 cs = tb[f]; const float a = x[2 * f], b = x[2 * f + 1]; x[2 * f] = a * cs.x - b * cs.y; x[2 * f + 1] = b * cs.x + a * cs.y; } }
        v8i q;
#pragma unroll
        for (int c = 0; c < 8; ++c) q[c] = (int)pk4_fp8(x[4 * c] * QC_Q, x[4 * c + 1] * QC_Q, x[4 * c + 2] * QC_Q, x[4 * c + 3] * QC_Q);
        qr[ks] = q; }
    unsigned kq[2];
#pragma unroll
    for (int i = 0; i < 2; ++i) { const int c = (i * 8 + wid) * 64 + lane; const int r = c / 13, cc = c % 13; kq[i] = (unsigned)((r < 64 ? r : 63) * LDK + (cc < 12 ? cc : 11) * 16); }
    const unsigned vq0 = (unsigned)(wid * 1024 + lane * 16);
    LAS unsigned char* ldsl = (LAS unsigned char*)(uintptr_t)(unsigned)(uintptr_t)lds;
#define DMA_TILE(jt, buf) do { const int kr_ = ((jt) < 4) ? cbase + 64 * (jt) : lbase + 64 * ((jt) - 4); const char* kp_ = (const char*)Kh + (size_t)kr_ * LDK; const char* vp_ = (const char*)Vh + (size_t)(jt) * VT_TILE + vq0; \
    LAS unsigned char* kb_ = ldsl + (buf) * ABUF + wid * 1024; LAS unsigned char* vb_ = kb_ + SHM_K; \
    __builtin_amdgcn_global_load_lds((const unsigned*)(kp_ + kq[0]), (LAS unsigned*)(kb_), 16, 0, 0); \
    if (wid < 5) __builtin_amdgcn_global_load_lds((const unsigned*)(kp_ + kq[1]), (LAS unsigned*)(kb_ + 8192), 16, 0, 0); \
    __builtin_amdgcn_global_load_lds((const unsigned*)(vp_), (LAS unsigned*)(vb_), 16, 0, 0); \
    if (wid < 2) __builtin_amdgcn_global_load_lds((const unsigned*)(vp_ + 8192), (LAS unsigned*)(vb_ + 8192), 16, 0, 0); } while (0)
#define WAITBAR() do { asm volatile("s_waitcnt vmcnt(0)" ::: "memory"); __syncthreads(); } while (0)
#define RESC(a) do { if (__any((a) < 1.f)) { if (hi == 0) al_l[r32] = (a); asm volatile("s_waitcnt lgkmcnt(0)" ::: "memory"); \
    _Pragma("unroll") for (int d = 0; d < 4; ++d) _Pragma("unroll") for (int r = 0; r < 16; ++r) o[d][r] *= al_l[crow(r, hi)]; } } while (0)
#define KBUF(b) (lds + (b) * ABUF)
#define VBASE(b) (lds + (b) * ABUF + SHM_K)
    f32x16 pA0, pA1, pB0, pB1; float alA, alB; v8i pa; const int NT = seq / KVBLK;
    DMA_TILE(0, 0); DMA_TILE(1, 1); WAITBAR();
    qkt(pA0, pA1, m_reg, KBUF(0), qr, r32, hi); partialSM(pA0, pA1, m_reg, alA, true);
    int bprev = 0, bj = 1;
    for (int j = 1; j + 1 < NT; j += 2) {
        { const int bn = 3 - bprev - bj; DMA_TILE(j + 1, bn);
          SBAR(); qkt(pB0, pB1, m_reg, KBUF(bj), qr, r32, hi);
          finishSM(pA0, pA1, alA, l_reg, pa); SBAR();
          pv_d0(o, VBASE(bprev), pa, r32, hi); partialSM(pB0, pB1, m_reg, alB, false);
          RESC(alB); WAITBAR(); bprev = bj; bj = bn; }
        { const int bn = 3 - bprev - bj; if (j + 2 < NT) DMA_TILE(j + 2, bn);
          SBAR(); qkt(pA0, pA1, m_reg, KBUF(bj), qr, r32, hi);
          finishSM(pB0, pB1, alB, l_reg, pa); SBAR();
          pv_d0(o, VBASE(bprev), pa, r32, hi); partialSM(pA0, pA1, m_reg, alA, false);
          RESC(alA); WAITBAR(); bprev = bj; bj = bn; }
    }
    SBAR(); qkt(pB0, pB1, m_reg, KBUF(bj), qr, r32, hi);
    finishSM(pA0, pA1, alA, l_reg, pa); SBAR();
    pv_d0(o, VBASE(bprev), pa, r32, hi); partialSM(pB0, pB1, m_reg, alB, false);
    RESC(alB);
    finishSM(pB0, pB1, alB, l_reg, pa); SBAR();
    pv_d0(o, VBASE(bj), pa, r32, hi);
    if (hi == 0) li_l[r32] = l_reg; asm volatile("s_waitcnt lgkmcnt(0)" ::: "memory");
    float rli[16];
#pragma unroll
    for (int r = 0; r < 16; ++r) rli[r] = 8.f * __builtin_amdgcn_rcpf(li_l[crow(r, hi)]);
    bf16_t* Ow = Ob + (long)(wid * QBLK) * LDO;
#pragma unroll
    for (int r = 0; r < 16; ++r) { const int orow = crow(r, hi);
#pragma unroll
        for (int d0 = 0; d0 < 4; ++d0) Ow[(long)orow * LDO + d0 * 32 + r32] = (bf16_t)f2bf(o[d0][r] * rli[r]); }
    __syncthreads();
#undef DMA_TILE
#undef WAITBAR
#undef RESC
#undef KBUF
#undef VBASE
}
}

struct Args { const float* in[28]; float* out; unsigned char* ws; int ph_lo, ph_hi; };
enum { I_X = 0, I_C, I_CTX, I_CCTX, I_ADAW, I_ADAB, I_WIN, I_QNG, I_KVNG, I_WUQ, I_WUKV, I_SGNG, I_SGNB, I_SGW, I_SGB, I_RDF, I_RDB, I_WO, I_LN1G, I_LN1B, I_RW, I_RB, I_WGU, I_BGU, I_WDN, I_BDN, I_LN2G, I_LN2B };

template <int QPERM>
__device__ __forceinline__ void transpose_item(const float* W, int K, int N, bf16_t* WT, LAS float* scr, int item, int lane) {
    const int nblk = N / 32, kb = item / nblk, nb = item % nblk, k0 = 64 * kb, n0 = 32 * nb;
#pragma unroll 8
    for (int i = 0; i < 32; ++i) { const int kk = 2 * i + (lane >> 5); scr[kk * 33 + (lane & 31)] = W[(size_t)(k0 + kk) * N + n0 + (lane & 31)]; }
    asm volatile("s_waitcnt lgkmcnt(0)" ::: "memory");
    const int c = lane & 7;
#pragma unroll
    for (int j = 0; j < 4; ++j) { const int n = (lane >> 3) + 8 * j; const LAS float* s = scr + (8 * c) * 33 + n;
        u32x4 o; o.x = pk2(s[0 * 33], s[1 * 33]); o.y = pk2(s[2 * 33], s[3 * 33]); o.z = pk2(s[4 * 33], s[5 * 33]); o.w = pk2(s[6 * 33], s[7 * 33]);
        int dn = n0 + n;
        if (QPERM == 1) { const int h = dn / 192, d = dn % 192; if (d >= 128) { const int jj = d - 128, a = jj >> 5, p = (jj >> 4) & 1, f = jj & 15; dn = h * 192 + 128 + 2 * (a * 16 + f) + p; } }
        if (QPERM == 2) { const int h = dn >> 8, j = dn & 255; dn = (j < 128) ? h * 128 + j : 512 + h * 128 + (j - 128); }
        *(u32x4*)(WT + (size_t)dn * K + k0 + 8 * c) = o; }
    asm volatile("s_waitcnt lgkmcnt(0)" ::: "memory");
}

__device__ __forceinline__ void transpose_item_fp8(const float* W, int K, int N, unsigned char* WT, float q, LAS float* scr, int item, int lane) {
    const int nblk = N / 32, kb = item / nblk, nb = item % nblk, k0 = 64 * kb, n0 = 32 * nb;
#pragma unroll 8
    for (int i = 0; i < 32; ++i) { const int kk = 2 * i + (lane >> 5); scr[kk * 33 + (lane & 31)] = W[(size_t)(k0 + kk) * N + n0 + (lane & 31)]; }
    asm volatile("s_waitcnt lgkmcnt(0)" ::: "memory");
    const int c = lane & 7;
#pragma unroll
    for (int j = 0; j < 4; ++j) { const int n = (lane >> 3) + 8 * j; const LAS float* s = scr + (8 * c) * 33 + n;
        u32x2 o; o.x = pk4_fp8(s[0 * 33] * q, s[1 * 33] * q, s[2 * 33] * q, s[3 * 33] * q); o.y = pk4_fp8(s[4 * 33] * q, s[5 * 33] * q, s[6 * 33] * q, s[7 * 33] * q);
        *(u32x2*)(WT + (size_t)(n0 + n) * K + k0 + 8 * c) = o; }
    asm volatile("s_waitcnt lgkmcnt(0)" ::: "memory");
}

__device__ __forceinline__ void transpose_item_fp8w(const float* W, int K, int N, unsigned char* WT, float q, LAS unsigned char* scr, int item, int lane) {
    const int nblk = N / 128, kb = item / nblk, nb = item % nblk, k0 = 64 * kb, n0 = 128 * nb;
    const int l5 = lane & 31, h = lane >> 5;
    const float* src = W + (size_t)(k0 + 16 * h) * N + n0 + 4 * l5;
#pragma unroll
    for (int b = 0; b < 2; ++b) {
        f32x4 x[16];
#pragma unroll
        for (int s_ = 0; s_ < 16; ++s_) x[s_] = *(const f32x4*)(src + (size_t)(32 * b + s_) * N);
#pragma unroll
        for (int i = 0; i < 4; ++i) {
            u32x4 o;
            o.x = pk4_fp8(x[0][i] * q, x[1][i] * q, x[2][i] * q, x[3][i] * q); o.y = pk4_fp8(x[4][i] * q, x[5][i] * q, x[6][i] * q, x[7][i] * q);
            o.z = pk4_fp8(x[8][i] * q, x[9][i] * q, x[10][i] * q, x[11][i] * q); o.w = pk4_fp8(x[12][i] * q, x[13][i] * q, x[14][i] * q, x[15][i] * q);
            *(LAS u32x4*)(scr + (l5 + 32 * i) * 80 + (2 * b + h) * 16) = o; }
    }
    asm volatile("s_waitcnt lgkmcnt(0)" ::: "memory");
#pragma unroll
    for (int qd = 0; qd < 8; ++qd) {
        const int rho = 16 * qd + (lane >> 2), piece = lane & 3;
        const u32x4 o = *(const LAS u32x4*)(scr + rho * 80 + piece * 16);
        const int nl = 4 * (rho & 31) + (rho >> 5);
        *(u32x4*)(WT + (size_t)(n0 + nl) * K + k0 + piece * 16) = o; }
    asm volatile("s_waitcnt lgkmcnt(0)" ::: "memory");
}

__global__ void __launch_bounds__(512, 2) mega(Args a) {
    extern __shared__ __attribute__((aligned(16))) unsigned char lds_raw[];
    LAS unsigned char* lds = (LAS unsigned char*)lds_raw;
    const int G = gridDim.x, bx = blockIdx.x;
    const int wave_s = __builtin_amdgcn_readfirstlane(threadIdx.x >> 6);
    const int vcu = (G % 8 == 0) ? (bx % 8) * (G / 8) + bx / 8 : bx;
    const int NGW = G * 8;
#define PH_IDS() int lane_ = lane_id(); asm volatile("" : "+v"(lane_)); const int lane = lane_; const int wave = wave_s; const int tid = wave * 64 + lane; const int gw = vcu * 8 + wave; (void)lane; (void)gw; (void)tid
    unsigned char* ws = a.ws;
    unsigned* ctl = (unsigned*)(ws + WS_CTL);
    volatile LAS unsigned* MISC = (volatile LAS unsigned*)(lds + MISC_OFF);
    for (int u = threadIdx.x; u < (LDS_BYTES - RING_BYTES) / 4; u += 512) ((LAS unsigned*)(lds + RING_BYTES))[u] = 0u;
    __syncthreads();
    const int lo = a.ph_lo, hi = a.ph_hi;
    XcdBarrier bar; bar.bar = ctl + CW_BAR; bar.x = 0; bar.st = MISC + 8;
    if (hi - lo > 1) bar = xcd_barrier_post(ctl + CW_BAR, MISC + 8);
    bar.wave = wave_s;
#ifndef MK_ONLY
#define MK_ONLY -1
#endif
#ifndef MK_MASK
#define MK_MASK 0xFFF
#endif
#define EN(q) ((MK_ONLY < 0 || MK_ONLY == (q)) && ((MK_MASK >> (q)) & 1))
#ifndef MK_REP_PHASE
#define MK_REP_PHASE -1
#endif
#ifndef MK_REP_N
#define MK_REP_N 1
#endif
#define REPS(q) ((MK_REP_PHASE == (q)) ? MK_REP_N : 1)
#ifndef MK_SUB
#define MK_SUB 15
#endif
#define SUB(m) ((MK_SUB & (m)) != 0)
#define XROW0(n_) (((n_) < NCTX) ? a.in[I_CTX] + (size_t)(n_) * DM : a.in[I_X] + (size_t)((n_) - NCTX) * DM)
#define XLOAD(dst_, l_, n_, j_) do { if ((l_) == 0) dst_ = *((const f32x4*)XROW0(n_) + lane + 64 * (j_)); else { const u32x2 w_ = *((const u32x2*)(XRB + (size_t)(n_) * DM) + lane + 64 * (j_)); dst_ = (f32x4){__uint_as_float(w_.x), __uint_as_float(w_.y), 0.f, 0.f}; } } while (0)
#define XVAL(src_, l_) (((l_) == 0) ? (src_) : (f32x4){bflo(__float_as_uint((src_).x)), bfhi(__float_as_uint((src_).x)), bflo(__float_as_uint((src_).y)), bfhi(__float_as_uint((src_).y))})
#define IN(k) (lo <= (k) && (k) < hi)
#define SEAM(k) do { if (IN(k) && IN((k) + 1)) xcd_barrier(bar); } while (0)

    float* MOD = (float*)(ws + WS_MOD);
    f32x2* ATAB = (f32x2*)(ws + WS_ATAB);
    f32x2* RTAB = (f32x2*)(ws + WS_RTAB);
    unsigned char* WIN8 = ws + WS_WIN; bf16_t* WUQ = (bf16_t*)(ws + WS_WUQ); bf16_t* WUKV = (bf16_t*)(ws + WS_WUKV); bf16_t* WOT = (bf16_t*)(ws + WS_WO);
    unsigned char* WGU = ws + WS_WGU; unsigned char* WDN = ws + WS_WDN; unsigned char* XH8 = ws + WS_XH8; bf16_t* SGWB = (bf16_t*)(ws + WS_SGWB);
    bf16_t* XRB = (bf16_t*)(ws + WS_XRES); unsigned char* XHF = ws + WS_XH; bf16_t* PROJ = (bf16_t*)(ws + WS_PROJ);
    bf16_t* CQN = (bf16_t*)(ws + WS_CQN); bf16_t* CKVN = (bf16_t*)(ws + WS_CKVN);
    bf16_t* QB = (bf16_t*)(ws + WS_QB); unsigned char* KB = ws + WS_KB; unsigned char* VT8 = ws + WS_VB;
    float* SLOC = (float*)(ws + WS_SGU); float* SIN = (float*)(ws + WS_SGV);
    float* RQ = (float*)(ws + WS_RQ); float* RK = (float*)(ws + WS_RK); float* OF = (float*)(ws + WS_OF); float* OB = (float*)(ws + WS_OB);
    bf16_t* MIX = (bf16_t*)(ws + WS_MIX); bf16_t* YB = (bf16_t*)(ws + WS_Y);
    int* TOPI = (int*)(ws + WS_TOPI); float* GATE = (float*)(ws + WS_GATE); int* DEST = (int*)(ws + WS_DEST); int* ROWTOK = (int*)(ws + WS_ROWTOK);
    unsigned char* ACT = ws + WS_ACT; unsigned char* DOUT = ws + WS_DOUT;

    constexpr int IT_IN = 16 * 62, IT_UQ = 6 * 24, IT_UKV = 4 * 32, IT_O = 16 * 32, IT_SMALL = IT_IN + IT_UQ + IT_UKV + IT_O, IT_GU = 16 * 16, IT_DN = 16 * 8;
    constexpr int IT_LAYER = IT_SMALL + 32 * IT_GU + 32 * IT_DN;
#define CONVERT_ITEM(L_, it_) do { int r_ = (it_); const int cl_ = (L_); \
        if (r_ < IT_IN) { transpose_item_fp8(a.in[I_WIN] + (size_t)cl_ * 1024 * 1984, 1024, 1984, WIN8 + (size_t)cl_ * 2048 * 1024, WGU_Q, scr, r_, lane); break; } r_ -= IT_IN; \
        if (r_ < IT_UQ) { transpose_item<1>(a.in[I_WUQ] + (size_t)cl_ * 384 * 768, 384, 768, WUQ + (size_t)cl_ * 768 * 384, scr, r_, lane); break; } r_ -= IT_UQ; \
        if (r_ < IT_UKV) { transpose_item<2>(a.in[I_WUKV] + (size_t)cl_ * 256 * 1024, 256, 1024, WUKV + (size_t)cl_ * 1024 * 256, scr, r_, lane); break; } r_ -= IT_UKV; \
        if (r_ < IT_O) { transpose_item<0>(a.in[I_WO] + (size_t)cl_ * 1024 * 1024, 1024, 1024, WOT + (size_t)cl_ * 1024 * 1024, scr, r_, lane); break; } r_ -= IT_O; \
        if (r_ < 32 * IT_GU) { const int mtx_ = cl_ * 32 + r_ / IT_GU; r_ %= IT_GU; transpose_item_fp8w(a.in[I_WGU] + (size_t)mtx_ * 1024 * 2048, 1024, 2048, WGU + (size_t)mtx_ * 2048 * 1024, WGU_Q, (LAS unsigned char*)scr, r_, lane); break; } r_ -= 32 * IT_GU; \
        { const int mtx_ = cl_ * 32 + r_ / IT_DN; r_ %= IT_DN; transpose_item_fp8w(a.in[I_WDN] + (size_t)mtx_ * 1024 * 1024, 1024, 1024, WDN + (size_t)mtx_ * 1024 * 1024, WDN_Q, (LAS unsigned char*)scr, r_, lane); } } while (0)

    for (int rep_ = 0; rep_ < REPS(10); ++rep_) if (EN(10) && IN(0)) { PH_IDS();
        {
            LAS float* sc = (LAS float*)lds;
            LAS float* red = (LAS float*)(lds + 20480);
            { float cv_[10];
#pragma unroll
              for (int u_ = 0; u_ < 10; ++u_) { const int i = tid + 512 * u_; const int s = i >> 10, k = i & 1023; cv_[u_] = (s < 4) ? a.in[I_C][s * 1024 + k] : a.in[I_CCTX][k]; }
#pragma unroll
              for (int u_ = 0; u_ < 10; ++u_) sc[tid + 512 * u_] = cv_[u_] * sigmoidf_(cv_[u_]); }
            __syncthreads();
            for (int it = bx; it < 4 * 96; it += G) {
                const int l = it / 96, j0 = (it % 96) * 64;
                const float* wp = a.in[I_ADAW] + (size_t)l * 1024 * 6144 + j0 + lane;
                float s0 = 0, s1 = 0, s2 = 0, s3 = 0, s4 = 0;
#pragma unroll 8
                for (int kk = 0; kk < 128; ++kk) { const int k = wave * 128 + kk; const float w = wp[(size_t)k * 6144];
                    s0 += sc[k] * w; s1 += sc[1024 + k] * w; s2 += sc[2048 + k] * w; s3 += sc[3072 + k] * w; s4 += sc[4096 + k] * w; }
                red[(wave * 5 + 0) * 64 + lane] = s0; red[(wave * 5 + 1) * 64 + lane] = s1; red[(wave * 5 + 2) * 64 + lane] = s2; red[(wave * 5 + 3) * 64 + lane] = s3; red[(wave * 5 + 4) * 64 + lane] = s4;
                __syncthreads();
                if (tid < 320) { const int s = tid >> 6, jl = tid & 63; float v = 0;
#pragma unroll
                    for (int w = 0; w < 8; ++w) v += red[(w * 5 + s) * 64 + jl];
                    MOD[((size_t)l * 5 + s) * 6144 + j0 + jl] = v + a.in[I_ADAB][l * 6144 + j0 + jl]; }
                __syncthreads();
            }
        }
        for (int i = bx * 512 + tid; i < 128 * 16; i += G * 512) { float s, c; sincos_d((double)(i >> 4) * INV_A[i & 15], s, c); ATAB[i] = (f32x2){c, s}; }
        for (int i = bx * 512 + tid; i < KEYS * 16; i += G * 512) { float s, c; sincos_d((double)(i >> 4) * INV_R[i & 15], s, c); RTAB[i] = (f32x2){c, s}; }
        for (int i = bx * 512 + tid; i < 4 * 4 * 128 * 128 / 4; i += G * 512) { const f32x4 w = *((const f32x4*)a.in[I_SGW] + i); u32x2 o; o.x = pk2(w.x, w.y); o.y = pk2(w.z, w.w); *((u32x2*)SGWB + i) = o; }
        for (int i = bx * 512 + tid; i < 4 * 64 * 1024 / 16; i += G * 512) { const int l = i / (64 * 1024 / 16), r = i % (64 * 1024 / 16);
            *(u32x4*)(WIN8 + ((size_t)l * 2048 + 1984) * 1024 + (size_t)r * 16) = (u32x4){0u, 0u, 0u, 0u}; }
        {
            __syncthreads();
            LAS float* scr = (LAS float*)(lds + wave * 16384);
            for (int it = gw; it < IT_LAYER; it += NGW) CONVERT_ITEM(0, it);
            __syncthreads();
        }
    }
    SEAM(0);
    if (EN(11) && IN(1)) { PH_IDS();
        for (int n = gw; n < NTOK; n += 2 * NGW) {
            const int nn[2] = {n, (n + NGW < NTOK) ? n + NGW : n};
            f32x4 xv_[2][4], sh_[2][4], sc_[2][4];
#pragma unroll
            for (int t = 0; t < 2; ++t) { const float* md = MOD + (size_t)modset(nn[t]) * 6144; const f32x4* xr = (const f32x4*)XROW0(nn[t]) + lane;
#pragma unroll
                for (int j = 0; j < 4; ++j) { xv_[t][j] = xr[64 * j]; sh_[t][j] = *((const f32x4*)(md) + lane + 64 * j); sc_[t][j] = *((const f32x4*)(md + 1024) + lane + 64 * j); } }
#pragma unroll
            for (int t = 0; t < 2; ++t) { unsigned* o8 = (unsigned*)(XHF + (size_t)nn[t] * DM) + lane;
#pragma unroll
                for (int j = 0; j < 4; ++j) { const f32x4 v = xv_[t][j], sh = sh_[t][j], scl = sc_[t][j];
                    o8[64 * j] = pk4_fp8((v.x * (1.f + scl.x) + sh.x) * ACT_Q, (v.y * (1.f + scl.y) + sh.y) * ACT_Q, (v.z * (1.f + scl.z) + sh.z) * ACT_Q, (v.w * (1.f + scl.w) + sh.w) * ACT_Q); } }
        }
    }
    SEAM(1);

#pragma unroll 1
    for (int l = 0; l < NLAYER; ++l) {
        const int pb = 2 + 10 * l;
        const float* MODL = MOD + (size_t)l * 5 * 6144;
        for (int rep_ = 0; rep_ < REPS(0); ++rep_) if (EN(0) && IN(pb + 0)) { PH_IDS();
            pg8::Gemm g{XHF, WIN8 + (size_t)l * 2048 * 1024, 1024, 1024, nullptr, ACT_E, WGU_E};
            pg8::StaticOrder S; S.init(NTOK / 256, PROJW / 256, G, bx);
            pg8::EpiBf16 E{PROJ, PROJW};
            pg8::gemm_phase<pg8::EpiBf16, pg8::StaticOrder, false, true>(lds, g, S, E, wave_s);
        }
        SEAM(pb + 0);
        for (int rep_ = 0; rep_ < REPS(1); ++rep_) if (EN(1) && IN(pb + 1)) { PH_IDS();
            const float* qg = a.in[I_QNG] + l * 384; const float* kvg = a.in[I_KVNG] + l * 256;
            const float* sgg = a.in[I_SGNG] + l * 256; const float* sgb = a.in[I_SGNB] + l * 256;
            const float* sb = a.in[I_SGB] + l * 4 * 128;
            LAS float* ksr = (LAS float*)lds;
            LAS bf16_t* vsT = (LAS bf16_t*)(lds + 65536);
            constexpr int VST = 136;
            for (int T = vcu; T < NTOK / 128; T += G) {
                const int n0 = T * 128;
                float qgv[6];
#pragma unroll
                for (int j = 0; j < 3; ++j) { qgv[2 * j] = qg[lane * 2 + 128 * j]; qgv[2 * j + 1] = qg[lane * 2 + 128 * j + 1]; }
                const f32x4 kvgv = *(const f32x4*)(kvg + lane * 4), sggv = *(const f32x4*)(sgg + lane * 4), sgbv = *(const f32x4*)(sgb + lane * 4);
                const bool kvonly = (l == NLAYER - 1) && (n0 < NCTX);
                __syncthreads();
                for (int hb = 0; hb < 2; ++hb) {
                    unsigned cqw[8][3]; u32x2 ckw[8], sgw[8]; unsigned short krw[8], q1w[8], q2w[8], k1w[8], k2w[8]; f32x2 rcs[8], acs[8];
#pragma unroll
                    for (int k = 0; k < 8; ++k) {
                        const int n = n0 + wave * 16 + hb * 8 + k;
                        const bf16_t* pr = PROJ + (size_t)n * PROJW;
                        const bool lat = n >= NCTX; const int t = (n - NCTX) & 8191; const int upos = lat ? CTXL + t : (n & 255);
#pragma unroll
                        for (int j = 0; j < 3; ++j) cqw[k][j] = *(const unsigned*)(pr + C_CQ + lane * 2 + 128 * j);
                        ckw[k] = *(const u32x2*)(pr + C_CKV + lane * 4); sgw[k] = *(const u32x2*)(pr + C_SGV + lane * 4);
                        krw[k] = pr[C_KR + lane];
                        { const int h = lane >> 4, i = lane & 15; q1w[k] = pr[C_RQ + h * 32 + i]; q2w[k] = pr[C_RQ + h * 32 + 16 + i]; k1w[k] = pr[C_RK + h * 32 + i]; k2w[k] = pr[C_RK + h * 32 + 16 + i]; rcs[k] = RTAB[upos * 16 + i]; }
                        { const int aa = lane >> 5, f = lane & 15; const int pos = lat ? (aa ? (t & 63) : (t >> 6)) : 0; acs[k] = ATAB[pos * 16 + f]; }
                    }
                    __builtin_amdgcn_sched_barrier(0);
#pragma unroll
                    for (int k = 0; k < 8; ++k) {
                        __builtin_amdgcn_sched_barrier(0);
                        const int tl = wave * 16 + hb * 8 + k, n = n0 + tl;
                        if (!kvonly) {
                            float v[6]; float ss = 0;
#pragma unroll
                            for (int j = 0; j < 3; ++j) { const unsigned w = cqw[k][j]; v[2 * j] = bflo(w); v[2 * j + 1] = bfhi(w); ss += v[2 * j] * v[2 * j] + v[2 * j + 1] * v[2 * j + 1]; }
                            const float rs = rsqrtf(wave_sum(ss) * (1.f / 384.f) + RMS_EPS);
#pragma unroll
                            for (int j = 0; j < 3; ++j) { const int c = lane * 2 + 128 * j; *(unsigned*)(CQN + (size_t)n * 384 + c) = pk2(v[2 * j] * rs * qgv[2 * j], v[2 * j + 1] * rs * qgv[2 * j + 1]); }
                        }
                        {
                            const u32x2 w = ckw[k];
                            const float v0 = bflo(w.x), v1 = bfhi(w.x), v2 = bflo(w.y), v3 = bfhi(w.y);
                            const float rs = rsqrtf(wave_sum(v0 * v0 + v1 * v1 + v2 * v2 + v3 * v3) * (1.f / 256.f) + RMS_EPS);
                            const f32x4 gg = kvgv;
                            u32x2 o; o.x = pk2(v0 * rs * gg.x, v1 * rs * gg.y); o.y = pk2(v2 * rs * gg.z, v3 * rs * gg.w);
                            *(u32x2*)(CKVN + (size_t)n * 256 + lane * 4) = o;
                        }
                        {
                            const float x = bf2f(krw[k]); const float xp = __shfl_xor(x, 16);
                            const int aa = lane >> 5, p = (lane >> 4) & 1, f = lane & 15; const f32x2 cs = acs[k];
                            const float o = p ? (x * cs.x + xp * cs.y) : (x * cs.x - xp * cs.y);
                            const int dd = 128 + 2 * (aa * 16 + f) + p; const unsigned char ob = (unsigned char)(pk4_fp8(o * QK_Q, 0.f, 0.f, 0.f) & 0xffu);
                            unsigned char* kd = KB + (size_t)n * 768 + dd;
                            kd[0] = ob; kd[192] = ob; kd[384] = ob; kd[576] = ob;
                        }
                        if (!kvonly) {
                            const u32x2 w = sgw[k];
                            float v0 = gelu1(bflo(w.x)), v1 = gelu1(bfhi(w.x)), v2 = gelu1(bflo(w.y)), v3 = gelu1(bfhi(w.y));
                            const float mean = wave_sum(v0 + v1 + v2 + v3) * (1.f / 256.f);
                            v0 -= mean; v1 -= mean; v2 -= mean; v3 -= mean;
                            const float rs = rsqrtf(wave_sum(v0 * v0 + v1 * v1 + v2 * v2 + v3 * v3) * (1.f / 256.f) + LN_EPS);
                            const f32x4 gg = sggv, bb = sgbv;
                            LAS bf16_t* vd = vsT + (lane * 4) * VST + tl;
                            vd[0] = (bf16_t)f2bf(v0 * rs * gg.x + bb.x); vd[VST] = (bf16_t)f2bf(v1 * rs * gg.y + bb.y); vd[2 * VST] = (bf16_t)f2bf(v2 * rs * gg.z + bb.z); vd[3 * VST] = (bf16_t)f2bf(v3 * rs * gg.w + bb.w);
                        }
                        {
                            const int h = lane >> 4, i = lane & 15; const f32x2 cs = rcs[k];
                            if (!kvonly) { const float q1 = bf2f(q1w[k]), q2 = bf2f(q2w[k]);
                                RQ[(size_t)n * 128 + h * 32 + i] = (q1 * cs.x - q2 * cs.y) * RET_QSCALE; RQ[(size_t)n * 128 + h * 32 + 16 + i] = (q2 * cs.x + q1 * cs.y) * RET_QSCALE; }
                            const float k1 = bf2f(k1w[k]), k2 = bf2f(k2w[k]);
                            const float ka = k1 * cs.x - k2 * cs.y, kb = k2 * cs.x + k1 * cs.y;
                            RK[(size_t)n * 128 + h * 32 + i] = ka; RK[(size_t)n * 128 + h * 32 + 16 + i] = kb;
                            ksr[tl * 128 + h * 32 + i] = ka; ksr[tl * 128 + h * 32 + 16 + i] = kb;
                        }
                    }
                }
                __syncthreads();
                {
                    const int h = wave >> 1, dir = wave & 1, hi = lane >> 5, il = lane & 31;
                    const float logit = a.in[dir ? I_RDB : I_RDF][l * 4 + h];
                    const float lg2 = log2f(1.f / (1.f + expf(-logit)));
                    f32x16 acc0 = {}, acc1 = {};
                    const bf16_t* vp = PROJ + (size_t)n0 * PROJW + C_RV + h * 64 + 2 * il;
                    for (int sb = 0; sb < 4; ++sb) {
                        unsigned bw[16];
#pragma unroll
                        for (int s = 0; s < 16; ++s) { const int tok = 2 * (sb * 16 + s) + hi; bw[s] = *(const unsigned*)(vp + (size_t)tok * PROJW); }
#pragma unroll
                        for (int s = 0; s < 16; ++s) { const int tok = 2 * (sb * 16 + s) + hi;
                            const float fac = __builtin_amdgcn_exp2f(lg2 * (float)(dir ? tok : 127 - tok));
                            const float av = ksr[tok * 128 + h * 32 + il] * fac;
                            acc0 = __builtin_amdgcn_mfma_f32_32x32x2f32(av, bflo(bw[s]), acc0, 0, 0, 0);
                            acc1 = __builtin_amdgcn_mfma_f32_32x32x2f32(av, bfhi(bw[s]), acc1, 0, 0, 0); }
                    }
                    float* so = SLOC + ((size_t)(T * 2 + dir) * 4 + h) * 2048 + 2 * il;
#pragma unroll
                    for (int r = 0; r < 16; ++r) { const int d = (r & 3) + 8 * (r >> 2) + 4 * hi; *(f32x2*)(so + d * 64) = (f32x2){acc0[r], acc1[r]}; }
                }
                if (!kvonly) {
                    const int g = wave >> 1, mh = wave & 1, hi = lane >> 5, il = lane & 31, c0 = g * 64 + 2 * il;
                    bf16x8 bfr[2][8];
#pragma unroll
                    for (int e = 0; e < 2; ++e)
#pragma unroll
                        for (int kk = 0; kk < 8; ++kk) bfr[e][kk] = *(const LAS bf16x8*)(vsT + (c0 + e) * VST + kk * 16 + hi * 8);
                    const bf16_t* wg = SGWB + ((size_t)(l * 4 + g) * 128) * 128;
                    for (int mt = 2 * mh; mt < 2 * mh + 2; ++mt) {
                        f32x16 acc0 = {}, acc1 = {};
                        const bf16_t* wr = wg + (size_t)(mt * 32 + il) * 128 + hi * 8;
                        bf16x8 af_[8];
#pragma unroll
                        for (int kk = 0; kk < 8; ++kk) af_[kk] = *(const bf16x8*)(wr + kk * 16);
                        __builtin_amdgcn_sched_barrier(0);
#pragma unroll
                        for (int kk = 0; kk < 8; ++kk) { acc0 = __builtin_amdgcn_mfma_f32_32x32x16_bf16(af_[kk], bfr[0][kk], acc0, 0, 0, 0); acc1 = __builtin_amdgcn_mfma_f32_32x32x16_bf16(af_[kk], bfr[1][kk], acc1, 0, 0, 0); }
#pragma unroll
                        for (int rb = 0; rb < 16; rb += 8) {
                            unsigned uw_[8];
#pragma unroll
                            for (int r8 = 0; r8 < 8; ++r8) { const int r = rb + r8; const int p = mt * 32 + (r & 3) + 8 * (r >> 2) + 4 * hi; uw_[r8] = *(const unsigned*)(PROJ + (size_t)(n0 + p) * PROJW + C_SGU + c0); }
#pragma unroll
                            for (int r8 = 0; r8 < 8; ++r8) { const int r = rb + r8; const int p = mt * 32 + (r & 3) + 8 * (r >> 2) + 4 * hi; const float sbp = sb[g * 128 + p];
                                *(unsigned*)(MIX + (size_t)(n0 + p) * DM + 512 + c0) = pk2(gelu1(bflo(uw_[r8])) * (acc0[r] + sbp), gelu1(bfhi(uw_[r8])) * (acc1[r] + sbp)); }
                        }
                    }
                }
            }
            __syncthreads();
            if (l + 1 < NLAYER && vcu >= 8) {
                LAS float* scr = (LAS float*)(lds + wave * 16384);
                for (int it = (vcu - 8) * 8 + wave; it < IT_LAYER / 2; it += (G - 8) * 8) CONVERT_ITEM(l + 1, it);
            }
            __syncthreads();
        }
        SEAM(pb + 1);
        for (int rep_ = 0; rep_ < REPS(2); ++rep_) if (EN(2) && IN(pb + 2)) { PH_IDS();
            if (tid < 256) {
                for (int E = bx * 256 + tid; E < 65536; E += G * 256) {
                    const int v = E & 63, d = (E >> 6) & 31, h = (E >> 11) & 3, dir = (E >> 13) & 1, b = E >> 14;
                    const float logit = a.in[dir ? I_RDB : I_RDF][l * 4 + h];
                    const float g128 = __builtin_amdgcn_exp2f(128.f * log2f(1.f / (1.f + expf(-logit))));
                    float S = 0.f;
                    float xs_[66];
#pragma unroll
                    for (int c = 0; c < 66; ++c) {
                        int T;
                        if (dir == 0) T = (c < 2) ? b * 2 + c : 8 + b * 64 + (c - 2);
                        else T = (c < 2) ? b * 2 + (1 - c) : 8 + b * 64 + (63 - (c - 2));
                        xs_[c] = SLOC[((size_t)(T * 2 + dir) * 4 + h) * 2048 + d * 64 + v];
                    }
#pragma unroll
                    for (int c = 0; c < 66; ++c) {
                        int T;
                        if (dir == 0) T = (c < 2) ? b * 2 + c : 8 + b * 64 + (c - 2);
                        else T = (c < 2) ? b * 2 + (1 - c) : 8 + b * 64 + (63 - (c - 2));
                        SIN[((size_t)(T * 2 + dir) * 4 + h) * 2048 + d * 64 + v] = S; S = g128 * S + xs_[c];
                    }
                }
            }
            {
                pg8::Gemm g{CQN, WUQ + (size_t)l * 768 * 384, 384, 384, nullptr, 0, 0};
                pg8::StaticOrder S; S.init(NTOK / 256, 3, G, bx);
                pg8::EpiBf16 E{QB, 768};
                pg8::gemm_phase<pg8::EpiBf16, pg8::StaticOrder, false>(lds, g, S, E, wave_s);
            }
            {
                pg8::Gemm g{CKVN, WUKV + (size_t)l * 1024 * 256, 256, 256, nullptr, 0, 0};
                const int rot1 = (G * 9 / 16) & ~7;
                pg8::StaticOrder S; S.init(NTOK / 256, 2, G, (bx + G - rot1) % G);
                pg8::EpiK E{KB};
                pg8::gemm_phase<pg8::EpiK, pg8::StaticOrder, false>(lds, g, S, E, wave_s);
            }
            {
                pg8::Gemm g{WUKV + (size_t)l * 1024 * 256 + 512 * 256, CKVN, 256, 256, nullptr, 0, 0};
                const int rot2 = ((G * 9 / 16) & ~7) + 8;
                pg8::StaticOrder S; S.init(2, NTOK / 256, G, (bx + G - rot2) % G);
                pg8::EpiVT E{VT8};
                pg8::gemm_phase<pg8::EpiVT, pg8::StaticOrder, false>(lds, g, S, E, wave_s);
            }
        }
        SEAM(pb + 2);
#define ECTX_PUBLISH(rt_) do { asm volatile("s_waitcnt vmcnt(0)" ::: "memory"); __syncthreads(); \
        if (tid == 0) { __builtin_amdgcn_fence(__ATOMIC_RELEASE, "agent"); asm volatile("s_waitcnt vmcnt(0)" ::: "memory"); __hip_atomic_fetch_add(ctl + CW_ECTX + (l * 4 + (rt_)) * 64, 1u, RLX_AGENT); } } while (0)
        for (int rep_ = 0; rep_ < REPS(3); ++rep_) if (EN(3) && IN(pb + 3)) { PH_IDS();
            for (int rnd = 0; rnd < 3; ++rnd) {
                int b, h, qrow0, seq, t0;
                if (rnd < 2) { const int u = rnd * G + vcu; if (u >= 512) continue; const int bh = u >> 5, qb = u & 31; b = bh >> 2; h = bh & 3; qrow0 = NCTX + b * SEQ + qb * 256; seq = KEYS; t0 = qb * 256; }
                else { const int k = vcu - 16; if (k < 0 || k >= 16 || l == NLAYER - 1) continue; b = k >> 2; h = k & 3; qrow0 = b * CTXL; seq = CTXL; t0 = -1; }
                att::attn_unit(QB + ((size_t)qrow0 * 768 + h * 192), KB + h * 192, VT8 + (size_t)((b * 4 + h) * (KEYS / 64)) * VT_TILE, MIX + ((size_t)qrow0 * DM + h * 128), seq, b * CTXL, NCTX + b * SEQ, t0, ATAB, (char*)lds_raw, wave_s);
                if (rnd == 2) ECTX_PUBLISH(b);
            }
            {
                LAS float* qs = (LAS float*)lds;
                LAS float* ks = (LAS float*)(lds + 33792);
                LAS bf16_t* vs = (LAS bf16_t*)(lds + 67584);
                const int hl = wave >> 2, dir = (wave >> 1) & 1, half = wave & 1, hi = lane >> 5, il = lane & 31;
                for (int T = vcu; T < NTOK / 128; T += G) {
                    if (l == NLAYER - 1 && T < NCTX / 128) continue;
                    const int n0 = T * 128;
                    for (int pass = 0; pass < 2; ++pass) {
                        const int h = pass * 2 + hl;
                        __syncthreads();
                        {
                            f32x4 qv_[4], kv_[4]; u32x4 vv_[4];
#pragma unroll
                            for (int u_ = 0; u_ < 4; ++u_) { const int i = tid + 512 * u_; const int tok = i >> 4, part = i & 15;
                                qv_[u_] = *(const f32x4*)(RQ + (size_t)(n0 + tok) * 128 + pass * 64 + part * 4); kv_[u_] = *(const f32x4*)(RK + (size_t)(n0 + tok) * 128 + pass * 64 + part * 4);
                                vv_[u_] = *(const u32x4*)(PROJ + (size_t)(n0 + tok) * PROJW + C_RV + pass * 128 + part * 8); }
#pragma unroll
                            for (int u_ = 0; u_ < 4; ++u_) { const int i = tid + 512 * u_; const int tok = i >> 4, part = i & 15, hh = part >> 3, d0 = (part & 7) * 4;
                                const f32x4 qv = qv_[u_], kv = kv_[u_];
                                LAS float* qd = qs + (hh * 128 + tok) * 33 + d0; LAS float* kd = ks + (hh * 128 + tok) * 33 + d0;
                                qd[0] = qv.x; qd[1] = qv.y; qd[2] = qv.z; qd[3] = qv.w; kd[0] = kv.x; kd[1] = kv.y; kd[2] = kv.z; kd[3] = kv.w;
                                *(LAS u32x4*)(vs + tok * 128 + part * 8) = vv_[u_]; }
                        }
                        __syncthreads();
                        const float logit = a.in[dir ? I_RDB : I_RDF][l * 4 + h];
                        const float lg2 = log2f(1.f / (1.f + expf(-logit)));
                        float sinv0[16], sinv1[16];
                        { const float* sp = SIN + ((size_t)(T * 2 + dir) * 4 + h) * 2048 + il;
#pragma unroll
                          for (int s = 0; s < 16; ++s) { sinv0[s] = sp[(2 * s + hi) * 64]; sinv1[s] = sp[(2 * s + hi) * 64 + 32]; } }
                        float* OUT = dir ? OB : OF;
                        for (int ii = 0; ii < 2; ++ii) {
                            const int I = half ? (ii ? 2 : 1) : (ii ? 3 : 0);
                            const int ipos = 32 * I + il, itok = dir ? 127 - ipos : ipos;
                            const LAS float* qrow = qs + (hl * 128 + itok) * 33 + hi;
                            f32x16 acc0 = {}, acc1 = {};
#pragma unroll
                            for (int s = 0; s < 16; ++s) { const float bq = qrow[2 * s];
                                acc0 = __builtin_amdgcn_mfma_f32_32x32x2f32(sinv0[s], bq, acc0, 0, 0, 0);
                                acc1 = __builtin_amdgcn_mfma_f32_32x32x2f32(sinv1[s], bq, acc1, 0, 0, 0); }
                            { const float cf = __builtin_amdgcn_exp2f(lg2 * (float)(ipos + 1));
#pragma unroll
                              for (int r = 0; r < 16; ++r) { acc0[r] *= cf; acc1[r] *= cf; } }
                            for (int J = 0; J <= I; ++J) {
                                const int jposA = 32 * J + il, jtokA = dir ? 127 - jposA : jposA;
                                const LAS float* krow = ks + (hl * 128 + jtokA) * 33 + hi;
                                f32x16 pt = {};
#pragma unroll
                                for (int s = 0; s < 16; ++s) pt = __builtin_amdgcn_mfma_f32_32x32x2f32(krow[2 * s], qrow[2 * s], pt, 0, 0, 0);
#pragma unroll
                                for (int r = 0; r < 16; ++r) { const int jl = (r & 3) + 8 * (r >> 2) + 4 * hi;
                                    const bool keep = (J < I) || (dir ? (il > jl) : (il >= jl));
                                    const float fac = __builtin_amdgcn_exp2f(lg2 * (float)(32 * (I - J) + il - jl));
                                    pt[r] = keep ? pt[r] * fac : 0.f; }
#pragma unroll
                                for (int r = 0; r < 16; ++r) { const int jpos = 32 * J + (r & 3) + 8 * (r >> 2) + 4 * hi, jtok = dir ? 127 - jpos : jpos;
                                    const float a0 = bf2f(vs[jtok * 128 + hl * 64 + il]), a1 = bf2f(vs[jtok * 128 + hl * 64 + 32 + il]);
                                    acc0 = __builtin_amdgcn_mfma_f32_32x32x2f32(a0, pt[r], acc0, 0, 0, 0);
                                    acc1 = __builtin_amdgcn_mfma_f32_32x32x2f32(a1, pt[r], acc1, 0, 0, 0); }
                            }
                            float* op = OUT + (size_t)(n0 + itok) * 256 + h * 64;
#pragma unroll
                            for (int rq = 0; rq < 4; ++rq) {
                                *(f32x4*)(op + 8 * rq + 4 * hi) = (f32x4){acc0[4 * rq], acc0[4 * rq + 1], acc0[4 * rq + 2], acc0[4 * rq + 3]};
                                *(f32x4*)(op + 32 + 8 * rq + 4 * hi) = (f32x4){acc1[4 * rq], acc1[4 * rq + 1], acc1[4 * rq + 2], acc1[4 * rq + 3]}; }
                        }
                    }
                    asm volatile("s_waitcnt vmcnt(0)" ::: "memory");
                    __syncthreads();
                    for (int ib = 0; ib < 2; ++ib) {
                        f32x4 fF[8], fB[8]; u32x2 gW[8];
#pragma unroll
                        for (int it = 0; it < 8; ++it) { const int n = n0 + wave * 16 + ib * 8 + it;
                            fF[it] = *((const f32x4*)(OF + (size_t)n * 256) + lane); fB[it] = *((const f32x4*)(OB + (size_t)n * 256) + lane); gW[it] = *(const u32x2*)(PROJ + (size_t)n * PROJW + C_RG + lane * 4); }
#pragma unroll
                        for (int it = 0; it < 8; ++it) { const int n = n0 + wave * 16 + ib * 8 + it;
                            float v0 = fF[it].x + fB[it].x, v1 = fF[it].y + fB[it].y, v2 = fF[it].z + fB[it].z, v3 = fF[it].w + fB[it].w;
                            float s = v0 + v1 + v2 + v3; s += dpp_f<0xB1>(s); s += dpp_f<0x4E>(s); s += dpp_f<0x141>(s); s += dpp_f<0x140>(s);
                            const float mean = s * (1.f / 64.f); v0 -= mean; v1 -= mean; v2 -= mean; v3 -= mean;
                            float q = v0 * v0 + v1 * v1 + v2 * v2 + v3 * v3; q += dpp_f<0xB1>(q); q += dpp_f<0x4E>(q); q += dpp_f<0x141>(q); q += dpp_f<0x140>(q);
                            const float rs = rsqrtf(q * (1.f / 64.f) + LN_EPS);
                            const float g0 = bflo(gW[it].x), g1 = bfhi(gW[it].x), g2 = bflo(gW[it].y), g3 = bfhi(gW[it].y);
                            u32x2 o; o.x = pk2(v0 * rs * g0 * sigmoidf_(g0), v1 * rs * g1 * sigmoidf_(g1)); o.y = pk2(v2 * rs * g2 * sigmoidf_(g2), v3 * rs * g3 * sigmoidf_(g3));
                            *(u32x2*)(MIX + (size_t)n * DM + 768 + lane * 4) = o; }
                    }
                    if (T < NCTX / 128 && l + 1 < NLAYER) ECTX_PUBLISH(T >> 1);
                }
                __syncthreads();
            }
            if (l + 1 < NLAYER && vcu >= 16 && vcu < 32) {
                const int rt = (vcu - 16) >> 2, ct = (vcu - 16) & 3;
                if (tid == 0) { unsigned spins = 0; while (__hip_atomic_load(ctl + CW_ECTX + (l * 4 + rt) * 64, RLX_AGENT) < 6u && ++spins < (1u << 22)) __builtin_amdgcn_s_sleep(2);
                    __builtin_amdgcn_fence(__ATOMIC_ACQUIRE, "agent"); }
                asm volatile("s_waitcnt vmcnt(0)" ::: "memory"); __syncthreads();
                pg8::Gemm g{MIX, WOT + (size_t)l * 1024 * 1024, 1024, 1024, nullptr, 0, 0};
                pg8::OneUnit S1{rt, ct};
                pg8::EpiBf16 E1{YB, DM};
                pg8::gemm_phase<pg8::EpiBf16, pg8::OneUnit, false>(lds, g, S1, E1, wave_s);
            }
            if (l + 1 < NLAYER && vcu >= 32) {
                LAS float* scr = (LAS float*)(lds + wave * 16384);
                for (int it = IT_LAYER / 2 + (vcu - 32) * 8 + wave; it < IT_LAYER; it += (G - 32) * 8) CONVERT_ITEM(l + 1, it);
                __syncthreads();
            }
        }
        SEAM(pb + 3);
        for (int rep_ = 0; rep_ < REPS(4); ++rep_) if (EN(4) && IN(pb + 4)) { PH_IDS();
            const int skipr = NCTX;
            pg8::Gemm g{MIX + (size_t)skipr * DM, WOT + (size_t)l * 1024 * 1024, 1024, 1024, nullptr, 0, 0};
            pg8::StaticOrder S; S.init((NTOK - skipr) / 256, 4, G, bx);
            pg8::EpiBf16 E{YB + (size_t)skipr * DM, DM};
            pg8::gemm_phase<pg8::EpiBf16, pg8::StaticOrder, false>(lds, g, S, E, wave_s);
        }
        SEAM(pb + 4);
        if (EN(5) && IN(pb + 5)) { PH_IDS();
            LAS f32x4* rwl4 = (LAS f32x4*)lds;
            LAS unsigned* cnt = (LAS unsigned*)(lds + RING_BYTES);
            { const f32x4* src = (const f32x4*)(a.in[I_RW] + (size_t)l * 1024 * 32);
              f32x4 wv_[16];
#pragma unroll
              for (int u_ = 0; u_ < 16; ++u_) wv_[u_] = src[tid + 512 * u_];
#pragma unroll
              for (int u_ = 0; u_ < 16; ++u_) { const int i = tid + 512 * u_; const int d = i >> 3, cq = i & 7; const int rho = ((d & 3) * 4 + (d >> 8)) * 64 + ((d >> 2) & 63); rwl4[rho * 8 + (cq ^ (rho & 7))] = wv_[u_]; } }
            if (tid < 32) cnt[tid] = 0u;
            __syncthreads();
            const float* ln1g = a.in[I_LN1G] + l * DM; const float* ln1b = a.in[I_LN1B] + l * DM; const float* rb = a.in[I_RB] + l * 32;
            const int per = ((NTOK + G - 1) / G + 1) & ~1; const int n0 = bx * per, n1 = (n0 + per < NTOK) ? n0 + per : NTOK;
            const int myE = ((lane >> 5) & 1) * 16 + ((lane >> 4) & 1) * 8 + ((lane >> 3) & 1) * 4 + ((lane >> 2) & 1) * 2 + ((lane >> 1) & 1);
            const float myRb = rb[myE];
            f32x4 xB[2][4] = {}; u32x2 yB[2][4] = {};
            const int npair = (n1 - n0) >> 1;
            if (wave < npair) {
#pragma unroll
                for (int t = 0; t < 2; ++t)
#pragma unroll
                    for (int j = 0; j < 4; ++j) { XLOAD(xB[t][j], l, n0 + 2 * wave + t, j); yB[t][j] = *((const u32x2*)(YB + (size_t)(n0 + 2 * wave + t) * DM) + lane + 64 * j); } }
            for (int p = wave; p < npair; p += 8) {
                const int nb = n0 + 2 * p;
                f32x4 v[2][4];
                const float* md = MODL + (size_t)modset(nb) * 6144;
                float sm[2];
                {
                    f32x4 g1v[4];
#pragma unroll
                    for (int j = 0; j < 4; ++j) g1v[j] = *((const f32x4*)(md + 2048) + lane + 64 * j);
#pragma unroll
                    for (int t = 0; t < 2; ++t) { float s = 0.f;
#pragma unroll
                        for (int j = 0; j < 4; ++j) { const f32x4 yv = (f32x4){bflo(yB[t][j].x), bfhi(yB[t][j].x), bflo(yB[t][j].y), bfhi(yB[t][j].y)}; v[t][j] = XVAL(xB[t][j], l) * DN_ALPHA + g1v[j] * yv; s += (v[t][j].x + v[t][j].y) + (v[t][j].z + v[t][j].w); }
                        sm[t] = s; }
                }
                __builtin_amdgcn_sched_barrier(0);
                f32x4 pg[4], pb_[4], psh[4], psc[4];
#pragma unroll
                for (int j = 0; j < 4; ++j) { pg[j] = *((const f32x4*)ln1g + lane + 64 * j); pb_[j] = *((const f32x4*)ln1b + lane + 64 * j); psh[j] = *((const f32x4*)(md + 3072) + lane + 64 * j); psc[j] = *((const f32x4*)(md + 4096) + lane + 64 * j); }
                float rstd[2];
                { const float mean0 = wave_sum(sm[0]) * (1.f / DM), mean1 = wave_sum(sm[1]) * (1.f / DM); float q0 = 0.f, q1 = 0.f;
#pragma unroll
                  for (int j = 0; j < 4; ++j) { v[0][j] = v[0][j] - mean0; q0 += (v[0][j].x * v[0][j].x + v[0][j].y * v[0][j].y) + (v[0][j].z * v[0][j].z + v[0][j].w * v[0][j].w);
                      v[1][j] = v[1][j] - mean1; q1 += (v[1][j].x * v[1][j].x + v[1][j].y * v[1][j].y) + (v[1][j].z * v[1][j].z + v[1][j].w * v[1][j].w); }
                  rstd[0] = rsqrtf(wave_sum(q0) * (1.f / DM) + LN_EPS); rstd[1] = rsqrtf(wave_sum(q1) * (1.f / DM) + LN_EPS); }
                __builtin_amdgcn_sched_barrier(0);
#pragma unroll
                for (int j = 0; j < 4; ++j)
#pragma unroll
                    for (int t = 0; t < 2; ++t) { const int n = nb + t;
                        v[t][j] = v[t][j] * rstd[t] * pg[j] + pb_[j]; { u32x2 xw_; xw_.x = pk2(v[t][j].x, v[t][j].y); xw_.y = pk2(v[t][j].z, v[t][j].w); *((u32x2*)(XRB + (size_t)n * DM) + lane + 64 * j) = xw_; }
                        v[t][j] = v[t][j] * (psc[j] + 1.f) + psh[j];
                        *((unsigned*)(XH8 + (size_t)n * DM) + lane + 64 * j) = pk4_fp8(v[t][j].x * ACT_Q, v[t][j].y * ACT_Q, v[t][j].z * ACT_Q, v[t][j].w * ACT_Q); }
                __builtin_amdgcn_sched_barrier(0);
                if (p + 8 < npair) {
#pragma unroll
                    for (int j = 0; j < 4; ++j) { XLOAD(xB[0][j], l, nb + 16, j); yB[0][j] = *((const u32x2*)(YB + (size_t)(nb + 16) * DM) + lane + 64 * j); } }
                __builtin_amdgcn_sched_barrier(0);
                f32x4 ac[2][8];
#pragma unroll
                for (int t = 0; t < 2; ++t)
#pragma unroll
                    for (int q = 0; q < 8; ++q) ac[t][q] = (f32x4){0.f, 0.f, 0.f, 0.f};
                int lq_ = lane; asm volatile("" : "+v"(lq_));
#pragma unroll
                for (int j = 0; j < 4; ++j)
#pragma unroll
                    for (int i = 0; i < 4; ++i) { __builtin_amdgcn_sched_barrier(0); const float hv0 = v[0][j][i], hv1 = v[1][j][i]; const LAS f32x4* rp = rwl4 + ((i * 4 + j) * 64 + lq_) * 8;
#pragma unroll
                        for (int q = 0; q < 8; ++q) { const f32x4 w = rp[q ^ (lq_ & 7)]; ac[0][q] += w * hv0; ac[1][q] += w * hv1; }
#pragma unroll
                        for (int t = 0; t < 2; ++t)
                            asm volatile("" : "+v"(ac[t][0]), "+v"(ac[t][1]), "+v"(ac[t][2]), "+v"(ac[t][3]), "+v"(ac[t][4]), "+v"(ac[t][5]), "+v"(ac[t][6]), "+v"(ac[t][7])); }
                __builtin_amdgcn_sched_barrier(0);
                if (p + 8 < npair) {
#pragma unroll
                    for (int j = 0; j < 4; ++j) { XLOAD(xB[1][j], l, nb + 17, j); yB[1][j] = *((const u32x2*)(YB + (size_t)(nb + 17) * DM) + lane + 64 * j); } }
                __builtin_amdgcn_sched_barrier(0);
                float tv[2][4]; int ti[2][4];
#pragma unroll
                for (int t = 0; t < 2; ++t) {
                    float r16[16], r8[8], r4[4], r2[2], val;
                    { const bool up = (lane & 32) != 0;
#pragma unroll
                      for (int k = 0; k < 16; ++k) { const float lo_ = ac[t][k >> 2][k & 3], hi_ = ac[t][(k + 16) >> 2][k & 3]; r16[k] = (up ? hi_ : lo_) + __shfl_xor(up ? lo_ : hi_, 32); } }
                    { const bool up = (lane & 16) != 0;
#pragma unroll
                      for (int k = 0; k < 8; ++k) r8[k] = (up ? r16[k + 8] : r16[k]) + __shfl_xor(up ? r16[k] : r16[k + 8], 16); }
                    { const bool up = (lane & 8) != 0;
#pragma unroll
                      for (int k = 0; k < 4; ++k) r4[k] = (up ? r8[k + 4] : r8[k]) + dpp_f<0x128>(up ? r8[k] : r8[k + 4]); }
                    { const bool up = (lane & 4) != 0;
#pragma unroll
                      for (int k = 0; k < 2; ++k) r2[k] = (up ? r4[k + 2] : r4[k]) + dpp_f<0x1B>(dpp_f<0x141>(up ? r4[k] : r4[k + 2])); }
                    { const bool up = (lane & 2) != 0; val = (up ? r2[1] : r2[0]) + dpp_f<0x4E>(up ? r2[0] : r2[1]); }
                    val += dpp_f<0xB1>(val);
                    val += myRb;
#pragma unroll
                    for (int k = 0; k < 4; ++k) {
                        float bv = val; int bi = myE;
#pragma unroll
                        for (int o = 32; o >= 16; o >>= 1) { const float ov = __shfl_xor(bv, o); const int oi = __shfl_xor(bi, o); if (ov > bv || (ov == bv && oi < bi)) { bv = ov; bi = oi; } }
#define AMX_STEP(C_) { const float ov = dpp_f<C_>(bv); const int oi = dpp_i<C_>(bi); if (ov > bv || (ov == bv && oi < bi)) { bv = ov; bi = oi; } }
                        AMX_STEP(0x140) AMX_STEP(0x141) AMX_STEP(0x4E) AMX_STEP(0xB1)
#undef AMX_STEP
                        tv[t][k] = bv; ti[t][k] = bi; if (myE == bi) val = -3.0e38f;
                    }
                }
#pragma unroll
                for (int t = 0; t < 2; ++t) {
                    const int n = nb + t;
                    const bool routed = !(l == NLAYER - 1 && n < NCTX);
                    const float e1 = __expf(tv[t][1] - tv[t][0]), e2 = __expf(tv[t][2] - tv[t][0]), e3 = __expf(tv[t][3] - tv[t][0]);
                    const float inv = 1.f / (1.f + e1 + e2 + e3);
                    if (lane < 4) {
                        const int ee = lane == 0 ? ti[t][0] : lane == 1 ? ti[t][1] : lane == 2 ? ti[t][2] : ti[t][3];
                        const float gg = (lane == 0 ? 1.f : lane == 1 ? e1 : lane == 2 ? e2 : e3) * inv;
                        TOPI[n * 4 + lane] = routed ? ee : -1; GATE[n * 4 + lane] = gg;
                        if (routed) __hip_atomic_fetch_add(&cnt[ee], 1u, __ATOMIC_RELAXED, __HIP_MEMORY_SCOPE_WORKGROUP);
                    }
                }
                __builtin_amdgcn_sched_barrier(0);
            }
            __syncthreads();
            if (tid < 32) __hip_atomic_store(ctl + CW_BLKCNT + bx * 32 + tid, cnt[tid], RLX_AGENT);
            __syncthreads();
        }
        SEAM(pb + 5);
        for (int rep_ = 0; rep_ < REPS(6); ++rep_) if (EN(6) && IN(pb + 6)) { PH_IDS();
            LAS int* bc = (LAS int*)lds;
            LAS int* part = (LAS int*)(lds + 65536);
            LAS int* tot = part + 1024; LAS int* base = tot + 32; LAS int* seg = base + 32; LAS int* tiv = seg + 40;
            { unsigned cv_[16];
#pragma unroll
              for (int u_ = 0; u_ < 16; ++u_) { const int i = tid + 512 * u_; cv_[u_] = (i < G * 32) ? ctl[CW_BLKCNT + i] : 0u; }
#pragma unroll
              for (int u_ = 0; u_ < 16; ++u_) { const int i = tid + 512 * u_; if (i < G * 32) bc[i] = (int)cv_[u_]; }
              for (int i = tid + 8192; i < G * 32; i += 512) bc[i] = (int)ctl[CW_BLKCNT + i]; }
            const int per = ((NTOK + G - 1) / G + 1) & ~1; const int n0 = bx * per, n1 = (n0 + per < NTOK) ? n0 + per : NTOK; const int na = (n1 - n0) * 4;
            { const int i0 = tid, i1 = tid + 512; const int t0_ = (i0 < na) ? TOPI[n0 * 4 + i0] : 0, t1_ = (i1 < na) ? TOPI[n0 * 4 + i1] : 0;
              if (i0 < na) tiv[i0] = t0_; if (i1 < na) tiv[i1] = t1_;
              for (int i = tid + 1024; i < na; i += 512) tiv[i] = TOPI[n0 * 4 + i]; }
            __syncthreads();
            { const int e = tid & 31, pt = tid >> 5; const int bpp = (G + 15) / 16; int t = 0, bs = 0;
              for (int b = pt * bpp; b < (pt + 1) * bpp && b < G; ++b) { const int c = bc[b * 32 + e]; t += c; if (b < bx) bs += c; }
              part[pt * 32 + e] = t; part[512 + pt * 32 + e] = bs; }
            __syncthreads();
            if (tid < 32) { int t = 0, bs = 0;
#pragma unroll
              for (int p = 0; p < 16; ++p) { t += part[p * 32 + tid]; bs += part[512 + p * 32 + tid]; }
              tot[tid] = t; base[tid] = bs; }
            __syncthreads();
            if (tid == 0) { int off = 0; for (int e = 0; e < 32; ++e) { seg[e] = off; off += (tot[e] + 255) & ~255; } seg[32] = off; }
            __syncthreads();
            if (bx == 0) {
                const int ntl = seg[32] >> 8;
                if (tid == 0) __hip_atomic_store(ctl + CW_NT, (unsigned)ntl, RLX_AGENT);
                for (int t = tid; t < ntl; t += 512) { int e = 0; for (int k = 0; k < 32; ++k) if (seg[k] <= t * 256) e = k; __hip_atomic_store(ctl + CW_TILE_E + t, (unsigned)e, RLX_AGENT); }
            }
            for (int e = wave; e < 32; e += 8) {
                if ((e % G) == bx) for (int r = seg[e] + tot[e] + lane; r < seg[e + 1]; r += 64) ROWTOK[r] = 0;
            }
            for (int i = tid; i < na; i += 512) { const int e = tiv[i];
                if (e >= 0) { int rk = 0; for (int j = 0; j < i; ++j) rk += (tiv[j] == e) ? 1 : 0;
                    const int pos = seg[e] + base[e] + rk; DEST[n0 * 4 + i] = pos; ROWTOK[pos] = n0 + (i >> 2); } }
            __syncthreads();
        }
        SEAM(pb + 6);
        for (int rep_ = 0; rep_ < REPS(7); ++rep_) if (EN(7) && IN(pb + 7)) { PH_IDS();
            const int ntl = __builtin_amdgcn_readfirstlane(ld_ctl(ctl + CW_NT));
            LAS unsigned char* te = (LAS unsigned char*)(lds + RING_BYTES);
            LAS unsigned short* rows = (LAS unsigned short*)(lds + RING_BYTES + 1024);
            pg8::MoeOrder S; S.so.init(ntl, 8, G, bx); S.tile_e = te;
            {
                const unsigned e0_ = (tid < ntl) ? ctl[CW_TILE_E + tid] : 0u, e1_ = (tid + 512 < ntl) ? ctl[CW_TILE_E + tid + 512] : 0u;
                int rv_[18];
#pragma unroll
                for (int i = 0; i < 18; ++i) { pg8::Unit u; const bool ok = S.so.next(i, u); rv_[i] = (ok && tid < 256) ? ROWTOK[u.pm * 256 + tid] : 0; }
                if (tid < ntl) te[tid] = (unsigned char)e0_; if (tid + 512 < ntl) te[tid + 512] = (unsigned char)e1_;
                for (int t = tid + 1024; t < ntl; t += 512) te[t] = (unsigned char)ctl[CW_TILE_E + t];
#pragma unroll
                for (int i = 0; i < 18; ++i) if (tid < 256) rows[i * 256 + tid] = (unsigned short)rv_[i];
            }
            __syncthreads();
            pg8::Gemm g{XH8, WGU + (size_t)l * 32 * 2048 * 1024, 1024, 1024, rows, ACT_E, WGU_E};
            pg8::EpiSwiglu E{ACT, a.in[I_BGU] + (size_t)l * 32 * 2048};
            pg8::gemm_phase<pg8::EpiSwiglu, pg8::MoeOrder, true, true>(lds, g, S, E, wave_s);
        }
        SEAM(pb + 7);
        for (int rep_ = 0; rep_ < REPS(8); ++rep_) if (EN(8) && IN(pb + 8)) { PH_IDS();
            const int ntl = __builtin_amdgcn_readfirstlane(ld_ctl(ctl + CW_NT));
            LAS unsigned char* te = (LAS unsigned char*)(lds + RING_BYTES);
            { const unsigned e0_ = (tid < ntl) ? ctl[CW_TILE_E + tid] : 0u, e1_ = (tid + 512 < ntl) ? ctl[CW_TILE_E + tid + 512] : 0u;
              if (tid < ntl) te[tid] = (unsigned char)e0_; if (tid + 512 < ntl) te[tid + 512] = (unsigned char)e1_;
              for (int t = tid + 1024; t < ntl; t += 512) te[t] = (unsigned char)ctl[CW_TILE_E + t]; }
            __syncthreads();
            pg8::Gemm g{ACT, WDN + (size_t)l * 32 * 1024 * 1024, 1024, 1024, nullptr, ACT_E, WDN_E};
            pg8::MoeOrder S; S.so.init(ntl, 4, G, bx); S.tile_e = te;
            pg8::EpiDown E{DOUT, a.in[I_BDN] + (size_t)l * 32 * 1024};
            pg8::gemm_phase<pg8::EpiDown, pg8::MoeOrder, false, true>(lds, g, S, E, wave_s);
        }
        SEAM(pb + 8);
        if (EN(9) && IN(pb + 9)) { PH_IDS();
            const float* ln2g = a.in[I_LN2G] + l * DM; const float* ln2b = a.in[I_LN2B] + l * DM;
            const bool lastl = (l == NLAYER - 1);
            const int nbeg = lastl ? NCTX : 0;
            int dA[2][4] = {}; float gA[2][4] = {};
            unsigned rB[2][4][4] = {}; u32x2 xB[2][4] = {}; float gB[2][4] = {};
            const int PSTEP = 2 * NGW;
            const int nA = nbeg + 2 * gw;
            if (nA < NTOK) {
#pragma unroll
                for (int t = 0; t < 2; ++t)
#pragma unroll
                    for (int k = 0; k < 4; ++k) { dA[t][k] = DEST[(nA + t) * 4 + k]; gA[t][k] = GATE[(nA + t) * 4 + k]; }
#pragma unroll
                for (int t = 0; t < 2; ++t)
#pragma unroll
                    for (int j = 0; j < 4; ++j) {
#pragma unroll
                        for (int k = 0; k < 4; ++k) rB[t][j][k] = *((const unsigned*)(DOUT + (size_t)dA[t][k] * DM) + lane + 64 * j);
                        xB[t][j] = *((const u32x2*)(XRB + (size_t)(nA + t) * DM) + lane + 64 * j); }
#pragma unroll
                for (int t = 0; t < 2; ++t)
#pragma unroll
                    for (int k = 0; k < 4; ++k) gB[t][k] = gA[t][k];
                if (nA + PSTEP < NTOK) {
#pragma unroll
                    for (int t = 0; t < 2; ++t)
#pragma unroll
                        for (int k = 0; k < 4; ++k) { dA[t][k] = DEST[(nA + PSTEP + t) * 4 + k]; gA[t][k] = GATE[(nA + PSTEP + t) * 4 + k]; } }
            }
            for (int n = nbeg + 2 * gw; n < NTOK; n += PSTEP) {
                const float* md = MODL + (size_t)modset(n) * 6144;
                f32x4 v[2][4]; float sm[2];
                {
                    f32x4 g2[4];
#pragma unroll
                    for (int j = 0; j < 4; ++j) g2[j] = *((const f32x4*)(md + 5120) + lane + 64 * j);
#pragma unroll
                    for (int t = 0; t < 2; ++t) { float s = 0.f;
#pragma unroll
                        for (int j = 0; j < 4; ++j) {
                            f32x4 f = (f32x4){0.f, 0.f, 0.f, 0.f};
#pragma unroll
                            for (int k = 0; k < 4; ++k) { const unsigned w = rB[t][j][k]; const f32x2 lo_ = __builtin_amdgcn_cvt_pk_f32_fp8((int)w, false), hi_ = __builtin_amdgcn_cvt_pk_f32_fp8((int)w, true); const float gk = gB[t][k] * (1.f / DO_Q);
                                f.x += gk * lo_.x; f.y += gk * lo_.y; f.z += gk * hi_.x; f.w += gk * hi_.y; }
                            const f32x4 xv = (f32x4){bflo(xB[t][j].x), bfhi(xB[t][j].x), bflo(xB[t][j].y), bfhi(xB[t][j].y)};
                            v[t][j] = xv * DN_ALPHA + g2[j] * f; s += (v[t][j].x + v[t][j].y) + (v[t][j].z + v[t][j].w); }
                        sm[t] = s; }
                }
                __builtin_amdgcn_sched_barrier(0);
                if (n + PSTEP < NTOK) {
#pragma unroll
                    for (int t = 0; t < 2; ++t)
#pragma unroll
                        for (int j = 0; j < 4; ++j) {
#pragma unroll
                            for (int k = 0; k < 4; ++k) rB[t][j][k] = *((const unsigned*)(DOUT + (size_t)dA[t][k] * DM) + lane + 64 * j);
                            xB[t][j] = *((const u32x2*)(XRB + (size_t)(n + PSTEP + t) * DM) + lane + 64 * j); }
#pragma unroll
                    for (int t = 0; t < 2; ++t)
#pragma unroll
                        for (int k = 0; k < 4; ++k) gB[t][k] = gA[t][k];
                    if (n + 2 * PSTEP < NTOK) {
#pragma unroll
                        for (int t = 0; t < 2; ++t)
#pragma unroll
                            for (int k = 0; k < 4; ++k) { dA[t][k] = DEST[(n + 2 * PSTEP + t) * 4 + k]; gA[t][k] = GATE[(n + 2 * PSTEP + t) * 4 + k]; } }
                }
                __builtin_amdgcn_sched_barrier(0);
                const float* mdn = MODL + 5 * 6144 + (size_t)modset(n) * 6144;
                f32x4 pg[4], pb_[4];
#pragma unroll
                for (int j = 0; j < 4; ++j) { pg[j] = *((const f32x4*)ln2g + lane + 64 * j); pb_[j] = *((const f32x4*)ln2b + lane + 64 * j); }
                float rstd[2];
                { const float mean0 = wave_sum(sm[0]) * (1.f / DM), mean1 = wave_sum(sm[1]) * (1.f / DM); float q0 = 0.f, q1 = 0.f;
#pragma unroll
                  for (int j = 0; j < 4; ++j) { v[0][j] = v[0][j] - mean0; q0 += (v[0][j].x * v[0][j].x + v[0][j].y * v[0][j].y) + (v[0][j].z * v[0][j].z + v[0][j].w * v[0][j].w);
                      v[1][j] = v[1][j] - mean1; q1 += (v[1][j].x * v[1][j].x + v[1][j].y * v[1][j].y) + (v[1][j].z * v[1][j].z + v[1][j].w * v[1][j].w); }
                  rstd[0] = rsqrtf(wave_sum(q0) * (1.f / DM) + LN_EPS); rstd[1] = rsqrtf(wave_sum(q1) * (1.f / DM) + LN_EPS); }
                __builtin_amdgcn_sched_barrier(0);
#pragma unroll
                for (int j = 0; j < 4; ++j) { __builtin_amdgcn_sched_barrier(0);
                    f32x4 psh = (f32x4){0.f, 0.f, 0.f, 0.f}, psc = psh;
                    if (!lastl) { psh = *((const f32x4*)(mdn) + lane + 64 * j); psc = *((const f32x4*)(mdn + 1024) + lane + 64 * j); }
#pragma unroll
                    for (int t = 0; t < 2; ++t) { const int nn = n + t;
                        v[t][j] = v[t][j] * rstd[t] * pg[j] + pb_[j];
                        if (lastl) *((f32x4*)(a.out + (size_t)(nn - NCTX) * DM) + lane + 64 * j) = v[t][j];
                        else { u32x2 xw_; xw_.x = pk2(v[t][j].x, v[t][j].y); xw_.y = pk2(v[t][j].z, v[t][j].w); *((u32x2*)(XRB + (size_t)nn * DM) + lane + 64 * j) = xw_;
                            const f32x4 hh = (v[t][j] * (psc + 1.f) + psh) * ACT_Q; *((unsigned*)(XHF + (size_t)nn * DM) + lane + 64 * j) = pk4_fp8(hh.x, hh.y, hh.z, hh.w); } } }
                __builtin_amdgcn_sched_barrier(0);
            }
        }
        SEAM(pb + 9);
    }
#undef IN
#undef SEAM
}

extern "C" void kernel_launch(void* const* d_in, const int* in_sizes, int n_in, void* d_out, int out_size, void* d_ws, size_t ws_size, hipStream_t stream) {
    static int grid = 0;
    if (grid == 0) {
        if (n_in != 28 || ws_size < WS_END) { fprintf(stderr, "kernel_launch: need 28 inputs and %zu bytes of workspace (got %d, %zu)\n", (size_t)WS_END, n_in, ws_size); grid = -1; return; }
        int dev = 0, cus = 0, per_cu = 0;
        if (hipGetDevice(&dev) != hipSuccess || hipDeviceGetAttribute(&cus, hipDeviceAttributeMultiprocessorCount, dev) != hipSuccess) { grid = -1; return; }
        if (hipFuncSetAttribute((const void*)mega, hipFuncAttributeMaxDynamicSharedMemorySize, LDS_BYTES) != hipSuccess) { fprintf(stderr, "kernel_launch: hipFuncSetAttribute failed\n"); grid = -1; return; }
        if (hipOccupancyMaxActiveBlocksPerMultiprocessor(&per_cu, (const void*)mega, 512, LDS_BYTES) != hipSuccess || per_cu < 1) { fprintf(stderr, "kernel_launch: occupancy query says %d\n", per_cu); }
        (void)hipGetLastError();
        grid = cus;
        if (grid > 256) grid = 256;
    }
    if (grid < 0) return;
    (void)hipMemsetAsync((char*)d_ws + WS_CTL, 0, CTL_ZERO_BYTES, stream);
    Args a{};
    for (int i = 0; i < 28; ++i) a.in[i] = (const float*)d_in[i];
    a.out = (float*)d_out; a.ws = (unsigned char*)d_ws;
    constexpr int NPH = 2 + 10 * NLAYER;
#if MK_PER_PHASE
    for (int p = 0; p < NPH; ++p) { a.ph_lo = p; a.ph_hi = p + 1; hipLaunchKernelGGL(mega, dim3(grid), dim3(512), LDS_BYTES, stream, a); }
#else
    a.ph_lo = 0; a.ph_hi = NPH;
    hipLaunchKernelGGL(mega, dim3(grid), dim3(512), LDS_BYTES, stream, a);
#endif
    const hipError_t le = hipPeekAtLastError();
    if (le != hipSuccess) fprintf(stderr, "kernel_launch: launch failed: %s\n", hipGetErrorName(le));
}
```

```cpp
#include <hip/hip_runtime.h>
#include <cstdio>
#include <cstdint>

#ifndef MK_PER_PHASE
#define MK_PER_PHASE 0
#endif

#define GAS __attribute__((address_space(1)))
#define LAS __attribute__((address_space(3)))
typedef unsigned short bf16_t;
typedef short bf16x8 __attribute__((ext_vector_type(8)));
typedef short s16x4 __attribute__((ext_vector_type(4)));
typedef float f32x2 __attribute__((ext_vector_type(2)));
typedef float f32x4 __attribute__((ext_vector_type(4)));
typedef float f32x16 __attribute__((ext_vector_type(16)));
typedef unsigned u32x2 __attribute__((ext_vector_type(2)));
typedef unsigned u32x4 __attribute__((ext_vector_type(4)));
typedef int v8i __attribute__((ext_vector_type(8)));
typedef int v4i __attribute__((ext_vector_type(4)));

constexpr int DM = 1024, NB = 4, SEQ = 8192, NLAYER = 4, CTXL = 256;
constexpr int NCTX = NB * CTXL;
constexpr int NTOK = NCTX + NB * SEQ;
constexpr int KEYS = CTXL + SEQ;
constexpr int PROJW = 2048;
constexpr int NEXP = 32, TOPK = 4;
constexpr int CAP_TILES = 560, CAP_ROWS = CAP_TILES * 256;
constexpr float LN_EPS = 1e-5f, RMS_EPS = 1e-6f;
constexpr float DN_ALPHA = 1.681792830507429f;
constexpr float MLA_SCALE = 0.07216878364870322f;
constexpr float RET_QSCALE = 0.1767766952966369f;
constexpr float ACT_Q = 4.f;      constexpr int ACT_E = 0x7d7d7d7d;
constexpr float WGU_Q = 128.f;    constexpr int WGU_E = 0x78787878;
constexpr float WDN_Q = 256.f;    constexpr int WDN_E = 0x77777777;
constexpr float QK_Q = 8.f;       constexpr int QK_E = 0x7c7c7c7c;
constexpr float QC_Q = 16.f * 0.07216878364870322f * 1.4426950408889634f;   constexpr int QC_E = 0x7b7b7b7b;
constexpr float PV_Q = 8.f;       constexpr int PV_E = 0x7c7c7c7c;
constexpr int VT_ROW = 80, VT_TILE = 128 * VT_ROW;
constexpr float DO_Q = 64.f;
constexpr int C_CQ = 0, C_CKV = 384, C_KR = 640, C_SGU = 704, C_SGV = 960, C_RQ = 1216, C_RK = 1344, C_RV = 1472, C_RG = 1728;

constexpr size_t MiB = 1u << 20;
constexpr size_t WS_CTL = 0, CTL_ZERO_BYTES = 1 * MiB;
constexpr size_t WS_MOD = 1 * MiB;
constexpr size_t WS_ATAB = 2 * MiB;
constexpr size_t WS_RTAB = 2 * MiB + 65536;
constexpr size_t WS_WIN = 4 * MiB;
constexpr size_t WS_WUQ = 20 * MiB;
constexpr size_t WS_WUKV = 23 * MiB;
constexpr size_t WS_WO = 25 * MiB;
constexpr size_t WS_SGWB = 34 * MiB;
constexpr size_t WS_WGU = 64 * MiB;
constexpr size_t WS_WDN = 576 * MiB;
constexpr size_t WS_XRES = 832 * MiB;
constexpr size_t WS_XH = 964 * MiB;
constexpr size_t WS_PROJ = 1030 * MiB;
constexpr size_t WS_CQN = 1162 * MiB;
constexpr size_t WS_CKVN = 1187 * MiB;
constexpr size_t WS_QB = 1204 * MiB;
constexpr size_t WS_KB = 1254 * MiB;
constexpr size_t WS_VB = 1304 * MiB;
constexpr size_t WS_SGU = 1337 * MiB;
constexpr size_t WS_SGV = 1354 * MiB;
constexpr size_t WS_RQ = 1371 * MiB;
constexpr size_t WS_RK = 1388 * MiB;
constexpr size_t WS_OF = 1405 * MiB;
constexpr size_t WS_OB = 1438 * MiB;
constexpr size_t WS_MIX = 1471 * MiB;
constexpr size_t WS_Y = 1537 * MiB;
constexpr size_t WS_TOPI = 1669 * MiB;
constexpr size_t WS_GATE = 1670 * MiB;
constexpr size_t WS_DEST = 1671 * MiB;
constexpr size_t WS_ROWTOK = 1672 * MiB;
constexpr size_t WS_ACT = 1673 * MiB;
constexpr size_t WS_XH8 = 1830 * MiB;
constexpr size_t WS_DOUT = 1953 * MiB;
constexpr size_t WS_END = 2233 * MiB;
constexpr int CW_BAR = 4096;
constexpr int CW_BLKCNT = 16384;
constexpr int CW_NT = 32768;
constexpr int CW_TILE_E = 32832;
constexpr int CW_ECTX = 40960;

constexpr int LDS_BYTES = 147456;
constexpr int RING_BYTES = 131072;
constexpr int MISC_OFF = LDS_BYTES - 256;

#define RLX_AGENT __ATOMIC_RELAXED, __HIP_MEMORY_SCOPE_AGENT
__device__ __forceinline__ unsigned f2bf(float f) { unsigned u = __builtin_bit_cast(unsigned, f); return (u + 0x7fffu + ((u >> 16) & 1u)) >> 16; }
__device__ __forceinline__ unsigned pk2(float lo, float hi) { return f2bf(lo) | (f2bf(hi) << 16); }
__device__ __forceinline__ float bf2f(unsigned short h) { return __builtin_bit_cast(float, (unsigned)h << 16); }
__device__ __forceinline__ float bflo(unsigned w) { return __builtin_bit_cast(float, w << 16); }
__device__ __forceinline__ float bfhi(unsigned w) { return __builtin_bit_cast(float, w & 0xffff0000u); }
__device__ __forceinline__ unsigned cvt_pk_bf16(float lo, float hi) { unsigned r; asm volatile("v_cvt_pk_bf16_f32 %0, %1, %2" : "=v"(r) : "v"(lo), "v"(hi)); return r; }
__device__ __forceinline__ unsigned pk4_fp8(float x0, float x1, float x2, float x3) { int w = 0; w = __builtin_amdgcn_cvt_pk_fp8_f32(x0, x1, w, false); w = __builtin_amdgcn_cvt_pk_fp8_f32(x2, x3, w, true); return (unsigned)w; }
template <int CTRL> __device__ __forceinline__ float dpp_f(float v) { return __builtin_bit_cast(float, __builtin_amdgcn_update_dpp(0, __builtin_bit_cast(int, v), CTRL, 0xf, 0xf, true)); }
template <int CTRL> __device__ __forceinline__ int dpp_i(int v) { return __builtin_amdgcn_update_dpp(0, v, CTRL, 0xf, 0xf, true); }
__device__ __forceinline__ float wave_sum(float v) {
    v += dpp_f<0xB1>(v);
    v += dpp_f<0x4E>(v);
    v += dpp_f<0x141>(v);
    v += dpp_f<0x140>(v);
    { const int b_ = __builtin_bit_cast(int, v);
      const float r0 = __builtin_bit_cast(float, __builtin_amdgcn_readlane(b_, 0)), r1 = __builtin_bit_cast(float, __builtin_amdgcn_readlane(b_, 16)), r2 = __builtin_bit_cast(float, __builtin_amdgcn_readlane(b_, 32)), r3 = __builtin_bit_cast(float, __builtin_amdgcn_readlane(b_, 48));
      v = (r0 + r1) + (r2 + r3); }
    return v;
}
__device__ __forceinline__ int lane_id() { int l; asm volatile("v_mbcnt_lo_u32_b32 %0, -1, 0\n\tv_mbcnt_hi_u32_b32 %0, -1, %0" : "=v"(l)); return l; }
__device__ __forceinline__ int ld_ctl(const unsigned* p) { return (int)__hip_atomic_load(p, RLX_AGENT); }
__device__ __forceinline__ float gelu1(float v) {
    const float av = fabsf(v), d = av * 0.2316418882f + 1.0f, t = __builtin_amdgcn_rcpf(d);
    float q = t * 0.5307027145f + (-0.7265760135f); q = q * t + 0.7107068705f; q = q * t + (-0.142248368f); q = q * t + 0.127414796f; q = q * t;
    const float e = __builtin_amdgcn_exp2f((v * v) * (-0.72134752044f));
    const float m = v * (q * e), r = v - m;
    return v < 0.f ? m : r;
}
__device__ __forceinline__ float sigmoidf_(float x) { return __builtin_amdgcn_rcpf(1.f + __builtin_amdgcn_exp2f(-1.4426950408889634f * x)); }
__device__ __forceinline__ int modset(int n) { return (n < NCTX) ? 4 : ((n - NCTX) >> 13); }

__device__ const double INV_R[16] = {1.0, 0.5411695265464637, 0.2928644564625237, 0.15848931924611134, 0.08576958985908942, 0.046415888336127795, 0.025118864315095794, 0.013593563908785255,
                                     0.007356422544596414, 0.003981071705534973, 0.0021544346900318843, 0.0011659144011798323, 0.000630957344480193, 0.0003414548873833601, 0.00018478497974222906, 0.0001};
__device__ const double INV_A[16] = {1.0, 0.5623413251903491, 0.31622776601683794, 0.1778279410038923, 0.1, 0.05623413251903491, 0.03162277660168379, 0.01778279410038923,
                                     0.01, 0.005623413251903491, 0.0031622776601683794, 0.0017782794100389228, 0.001, 0.0005623413251903491, 0.00031622776601683794, 0.00017782794100389227};
__device__ __forceinline__ void sincos_d(double x, float& s, float& c) {
    const double k = rint(x * 0.15915494309189535);
    double r = fma(-k, 6.283185307179586, x); r = fma(-k, 2.4492935982947064e-16, r);
    const double r2 = r * r;
    double ps = -1.0 / 51090942171709440000.0;
    ps = fma(ps, r2, 1.0 / 121645100408832000.0);
    ps = fma(ps, r2, -1.0 / 355687428096000.0);
    ps = fma(ps, r2, 1.0 / 1307674368000.0);
    ps = fma(ps, r2, -1.0 / 6227020800.0);
    ps = fma(ps, r2, 1.0 / 39916800.0);
    ps = fma(ps, r2, -1.0 / 362880.0);
    ps = fma(ps, r2, 1.0 / 5040.0);
    ps = fma(ps, r2, -1.0 / 120.0);
    ps = fma(ps, r2, 1.0 / 6.0);
    ps = fma(ps, r2, -1.0);
    ps = -ps * r;
    double pc = 1.0 / 2432902008176640000.0;
    pc = fma(pc, r2, -1.0 / 6402373705728000.0);
    pc = fma(pc, r2, 1.0 / 20922789888000.0);
    pc = fma(pc, r2, -1.0 / 87178291200.0);
    pc = fma(pc, r2, 1.0 / 479001600.0);
    pc = fma(pc, r2, -1.0 / 3628800.0);
    pc = fma(pc, r2, 1.0 / 40320.0);
    pc = fma(pc, r2, -1.0 / 720.0);
    pc = fma(pc, r2, 1.0 / 24.0);
    pc = fma(pc, r2, -0.5);
    pc = fma(pc, r2, 1.0);
    s = (float)ps; c = (float)pc;
}

#define XB_TMO      128
#define XB_XCNT(j)  (256  + 64 * (j))
#define XB_XSUB(j)  (1280 + 64 * (j))
#define XB_XGEN(j)  (2304 + 64 * (j))
#define XB_TOP      3328
#define XB_TOPGEN   3392
#define XCD_BAR_WORDS 3456
#define XB_SPIN_CAP (1u << 24)
__device__ __forceinline__ unsigned xb_ld(unsigned* p)              { return __hip_atomic_load(p, __ATOMIC_RELAXED, __HIP_MEMORY_SCOPE_AGENT); }
__device__ __forceinline__ unsigned xb_add(unsigned* p, unsigned v) { return __hip_atomic_fetch_add(p, v, __ATOMIC_RELAXED, __HIP_MEMORY_SCOPE_AGENT); }
__device__ __forceinline__ unsigned xb_xcc_id() { return (unsigned)__builtin_amdgcn_s_getreg((3 << 11) | 20) & 0xFu; }
#define XB_SPIN(cond, bar) do { unsigned _sp = 0; while (cond) { __builtin_amdgcn_s_sleep(1); \
    if ((++_sp & 255u) == 0u) { if (xb_ld(&(bar)[XB_TMO])) break; if (_sp > XB_SPIN_CAP) { atomicAdd(&(bar)[XB_TMO], 1u); break; } } } } while (0)
struct XcdBarrier { unsigned* bar; unsigned x; volatile LAS unsigned* st; int wave; };
__device__ __forceinline__ XcdBarrier xcd_barrier_post(unsigned* bar, volatile LAS unsigned* st) {
    XcdBarrier b; b.bar = bar; b.x = xb_xcc_id(); b.st = st; b.wave = 0;
    if (threadIdx.x == 0) (void)xb_add(&bar[XB_XCNT(b.x)], 1u);
    return b;
}
__device__ __forceinline__ void xcd_barrier_complete(unsigned* bar, unsigned x, unsigned& nloc, unsigned& nx) {
    const unsigned G = gridDim.x * gridDim.y * gridDim.z;
    unsigned sum, cnt, mine, sp = 0u;
    for (;;) {
        sum = 0u; cnt = 0u; mine = 0u;
#pragma unroll
        for (unsigned j = 0; j < 16; ++j) { const unsigned c = xb_ld(&bar[XB_XCNT(j)]); sum += c; cnt += (c > 0u) ? 1u : 0u; mine = (j == x) ? c : mine; }
        if (sum == G) break;
        __builtin_amdgcn_s_sleep(1);
        if ((++sp & 255u) == 0u) { if (xb_ld(&bar[XB_TMO])) break; if (sp > XB_SPIN_CAP) { atomicAdd(&bar[XB_TMO], 1u); break; } }
    }
    nloc = mine > 0u ? mine : 1u; nx = cnt > 0u ? cnt : 1u;
}
__device__ __forceinline__ void xcd_barrier(const XcdBarrier& b) {
    asm volatile("s_waitcnt vmcnt(0)" ::: "memory");
    __syncthreads();
    if (b.wave == 0 && lane_id() == 0) {
        unsigned* bar = b.bar;
        __builtin_amdgcn_s_waitcnt(0);
        unsigned nloc = b.st[0], nx = b.st[1];
        if (nloc == 0u) { xcd_barrier_complete(bar, b.x, nloc, nx); b.st[0] = nloc; b.st[1] = nx; }
        const unsigned old = xb_add(&bar[XB_XSUB(b.x)], 1u);
        const unsigned gen = old / nloc;
        if (old + 1u == (gen + 1u) * nloc) {
            __builtin_amdgcn_fence(__ATOMIC_RELEASE, "agent");
            asm volatile("s_waitcnt vmcnt(0)" ::: "memory");
            const unsigned og = xb_add(&bar[XB_TOP], 1u);
            const unsigned tg = og / nx;
            if (og + 1u == (tg + 1u) * nx) xb_add(&bar[XB_TOPGEN], 1u);
            else XB_SPIN(xb_ld(&bar[XB_TOPGEN]) == tg, bar);
            __builtin_amdgcn_fence(__ATOMIC_ACQUIRE, "agent");
            xb_add(&bar[XB_XGEN(b.x)], 1u);
            asm volatile("s_waitcnt vmcnt(0)" ::: "memory");
        } else {
            XB_SPIN(xb_ld(&bar[XB_XGEN(b.x)]) == gen, bar);
            __builtin_amdgcn_fence(__ATOMIC_ACQUIRE, "agent");
            asm volatile("s_waitcnt vmcnt(0)" ::: "memory");
        }
    }
    __syncthreads();
}

namespace pg8 {
constexpr int BM = 256, BK = 64, HALF = 128, HTB = HALF * BK * 2, NXCD = 8, WGM = 8;
__host__ __device__ __forceinline__ int lds_byte(int r, int c) { const int st = (r >> 4) * 2 + (c >> 5), rr = r & 15, cc = c & 31, ob = rr * 64 + cc * 2; return st * 1024 + (ob ^ (((ob >> 9) & 1) << 5)); }
__host__ __device__ __forceinline__ void stage_rc(int b, int& R, int& C) { const int st = b / 1024, sb = b % 1024, swz = sb ^ (((sb >> 9) & 1) << 5); R = (st >> 1) * 16 + swz / 64; C = (st & 1) * 32 + (swz % 64) / 2; }
__host__ __device__ __forceinline__ int perm32(int rho) { const int n = rho >> 4, i = rho & 15; return 8 * (i >> 2) + 4 * n + (i & 3); }
struct Unit { int pm, pn; };
struct Gemm { const void* A; const void* Bt; int lda, K; const LAS unsigned short* rowlds; int scaleA, scaleB; };

struct StaticOrder {
    int nM, nN, nwg, G, c;
    __device__ __forceinline__ void init(int nM_, int nN_, int G_, int c_) { nM = nM_; nN = nN_; nwg = nM * nN; G = G_; c = c_; }
    __device__ __forceinline__ bool next(int i, Unit& u) const {
        const long L = (long)i * G + c; if (L >= nwg) return false;
        int wgid = (int)L; { const int q = nwg / NXCD, r = nwg % NXCD, xcd = wgid % NXCD, off = wgid / NXCD; wgid = (xcd < r ? xcd * (q + 1) : r * (q + 1) + (xcd - r) * q) + off; }
        const int nig = WGM * nN, gid = wgid / nig, fm = gid * WGM, gsz = (nM - fm) < WGM ? (nM - fm) : WGM;
        u.pm = fm + ((wgid % nig) % gsz); u.pn = (wgid % nig) / gsz; return true;
    }
};
struct OneUnit { int pm, pn; __device__ __forceinline__ bool next(int i, Unit& u) const { if (i != 0) return false; u.pm = pm; u.pn = pn; return true; } };
struct MoeOrder {
    StaticOrder so; const LAS unsigned char* tile_e;
    __device__ __forceinline__ bool next(int i, Unit& u) const {
        if (!so.next(i, u)) return false;
        const int e = __builtin_amdgcn_readfirstlane((int)tile_e[u.pm]);
        u.pn = e * so.nN + u.pn; return true;
    }
};

template <class Epi, class Sched, bool GATHER, bool FP8 = false>
__device__ __forceinline__ void gemm_phase(LAS unsigned char* lds, const Gemm g, const Sched& S, const Epi& E, const int wave_s) {
    int tid_ = wave_s * 64 + lane_id(); asm volatile("" : "+v"(tid_));
    const int tid = tid_, wid = __builtin_amdgcn_readfirstlane(tid >> 6), lane = tid & 63, wr = wid >> 2, wc = wid & 3, fr = lane & 15, fq = lane >> 4;
    constexpr int ESZ = FP8 ? 1 : 2;
    const int K = g.K, nt = K * ESZ / (BK * 2);
    int RA[2]; unsigned CA2[2], voffB[2];
#pragma unroll
    for (int i = 0; i < 2; ++i) { int R, C; stage_rc(tid * 16 + i * 8192, R, C); const int Rb = Epi::PERM ? ((R & ~31) + perm32(R & 31)) : R;
        RA[i] = R; CA2[i] = (unsigned)C * 2u; voffB[i] = (unsigned)(Rb * K * ESZ + C * 2); }
    const unsigned lda2 = (unsigned)g.lda * ESZ;
    const size_t kstep = (size_t)(BK * 2);
    const size_t hstepB = (size_t)HALF * K * ESZ, tstepB = 2 * hstepB;
    const unsigned ldsw = (unsigned)wid * 1024u;
    const int aoff = lds_byte(wr * 64 + fr, fq * 8), boff = lds_byte(wc * 32 + fr, fq * 8);
#define PG8_SA(b, h) (((b) * 2 + (h)) * HTB)
#define PG8_SB(b, h) ((4 + (b) * 2 + (h)) * HTB)
#define PG8_STAGE_B(bufoff, gbase) do { _Pragma("unroll") for (int _i = 0; _i < 2; ++_i) \
        __builtin_amdgcn_global_load_lds((const unsigned*)((const char*)(gbase) + voffB[_i]), (LAS unsigned*)(lds + (bufoff) + ldsw + _i * 8192), 16, 0, 0); } while (0)
#define PG8_STAGE_A(bufoff, gbase, UA) do { _Pragma("unroll") for (int _i = 0; _i < 2; ++_i) \
        __builtin_amdgcn_global_load_lds((const unsigned*)((const char*)(gbase) + (UA)[_i]), (LAS unsigned*)(lds + (bufoff) + ldsw + _i * 8192), 16, 0, 0); } while (0)
#define PG8_LD8(base) __builtin_shufflevector(*(const LAS v4i*)(base), *(const LAS v4i*)((base) + 1024), 0, 1, 2, 3, 4, 5, 6, 7)
#define PG8_LDA(dst, b, h) do { _Pragma("unroll") for (int m = 0; m < 4; ++m) dst[m] = PG8_LD8(lds + PG8_SA(b, h) + aoff + m * 2048); } while (0)
#define PG8_LDB(dst, b, h) do { _Pragma("unroll") for (int n = 0; n < 2; ++n) dst[n] = PG8_LD8(lds + PG8_SB(b, h) + boff + n * 2048); } while (0)
#define PG8_HALF(F, k) __builtin_bit_cast(bf16x8, (k) ? __builtin_shufflevector(F, F, 4, 5, 6, 7) : __builtin_shufflevector(F, F, 0, 1, 2, 3))
#define PG8_MMA(ai, bj, At, Bt) do { __builtin_amdgcn_s_setprio(1); \
        if constexpr (FP8) { _Pragma("unroll") for (int m = 0; m < 4; ++m) _Pragma("unroll") for (int n = 0; n < 2; ++n) \
            asm volatile("v_mfma_scale_f32_16x16x128_f8f6f4 %0, %1, %2, %0, %3, %4 op_sel_hi:[0,0,0]" : "+v"(acc[ai][bj][m][n]) : "v"(Bt[n]), "v"(At[m]), "v"(scB), "v"(scA)); } \
        else { _Pragma("unroll") for (int m = 0; m < 4; ++m) _Pragma("unroll") for (int n = 0; n < 2; ++n) _Pragma("unroll") for (int k = 0; k < 2; ++k) \
            acc[ai][bj][m][n] = __builtin_amdgcn_mfma_f32_16x16x32_bf16(PG8_HALF(Bt[n], k), PG8_HALF(At[m], k), acc[ai][bj][m][n], 0, 0, 0); } \
        __builtin_amdgcn_s_setprio(0); } while (0)
#define PG8_WAIT_V(n) asm volatile("s_waitcnt vmcnt(" #n ")" ::: "memory")
#define PG8_WAIT_L(n) asm volatile("s_waitcnt lgkmcnt(" #n ")" ::: "memory")
#define PG8_BAR __builtin_amdgcn_s_barrier()
#define PG8_SCHED __builtin_amdgcn_sched_barrier(0)
#define PG8_CALC_UA(dst, un, uord) do { _Pragma("unroll") for (int _h = 0; _h < 2; ++_h) _Pragma("unroll") for (int _i = 0; _i < 2; ++_i) { \
        int _rr = (un).pm * BM + _h * HALF + RA[_i]; if (GATHER) _rr = (int)g.rowlds[(uord) * 256 + _h * HALF + RA[_i]]; dst[_h][_i] = (unsigned)_rr * lda2 + CA2[_i]; } } while (0)
    Unit cur, nxt; int ui = 0;
    if (!S.next(0, cur)) return;
    const int scA = g.scaleA, scB = g.scaleB; (void)scA; (void)scB;
    if constexpr (Epi::BIAS_LDS) { if (wid == 0) __builtin_amdgcn_global_load_lds((const unsigned*)(E.bias_src(cur) + lane_id() * 4), (LAS unsigned*)(lds + Epi::BIAS_OFF), 16, 0, 0); }
    unsigned uAc[2][2], uAn[2][2];
    const size_t tstepA = (size_t)BM * lda2;
    if constexpr (GATHER) { PG8_CALC_UA(uAc, cur, 0); }
    else {
#pragma unroll
        for (int h = 0; h < 2; ++h)
#pragma unroll
            for (int i = 0; i < 2; ++i) { uAc[h][i] = (unsigned)(h * HALF + RA[i]) * lda2 + CA2[i]; uAn[h][i] = uAc[h][i]; } }
    f32x4 acc[2][2][4][2];
#pragma unroll
    for (int a = 0; a < 2; ++a)
#pragma unroll
        for (int b = 0; b < 2; ++b)
#pragma unroll
            for (int m = 0; m < 4; ++m)
#pragma unroll
                for (int n = 0; n < 2; ++n) acc[a][b][m][n] = (f32x4){0.f, 0.f, 0.f, 0.f};
    v8i At[4], B0[2], B1[2];
    const char* cA = GATHER ? (const char*)g.A : (const char*)g.A + (size_t)cur.pm * tstepA;
    const char* cB = (const char*)g.Bt + (size_t)cur.pn * tstepB;
    PG8_STAGE_B(PG8_SB(0, 0), cB); PG8_STAGE_B(PG8_SB(0, 1), cB + hstepB); PG8_STAGE_A(PG8_SA(0, 0), cA, uAc[0]); PG8_STAGE_A(PG8_SA(0, 1), cA, uAc[1]);
    if (wr == 1) PG8_BAR;
    PG8_WAIT_V(2); PG8_BAR;
    PG8_STAGE_B(PG8_SB(1, 0), cB + kstep); PG8_STAGE_A(PG8_SA(1, 0), cA + kstep, uAc[0]); PG8_STAGE_B(PG8_SB(1, 1), cB + hstepB + kstep);
    PG8_WAIT_V(6); PG8_BAR;
    for (;;) {
        const bool has_next = S.next(ui + 1, nxt);
        const char* nB = has_next ? (const char*)g.Bt + (size_t)nxt.pn * tstepB : cB;
        const char* nA = (GATHER || !has_next) ? cA : (const char*)g.A + (size_t)nxt.pm * tstepA;
        if constexpr (GATHER) {
            if (has_next) { PG8_CALC_UA(uAn, nxt, ui + 1); }
            else {
#pragma unroll
                for (int h = 0; h < 2; ++h)
#pragma unroll
                    for (int i = 0; i < 2; ++i) uAn[h][i] = uAc[h][i]; } }
#pragma unroll 1
        for (int t = 0; t < nt; t += 2) {
            const bool last = (t == nt - 2);
            const char* a1 = cA + (size_t)(t + 1) * kstep;
            const char* a2 = last ? nA : cA + (size_t)(t + 2) * kstep; const char* b2 = last ? nB : cB + (size_t)(t + 2) * kstep;
            const char* a3 = a2 + kstep; const char* b3 = b2 + kstep;
            unsigned u2[2][2];
#pragma unroll
            for (int h = 0; h < 2; ++h)
#pragma unroll
                for (int i = 0; i < 2; ++i) u2[h][i] = (GATHER && last) ? uAn[h][i] : uAc[h][i];
            PG8_LDB(B0, 0, 0); PG8_LDB(B1, 0, 1); PG8_SCHED; PG8_LDA(At, 0, 0); PG8_STAGE_A(PG8_SA(1, 1), a1, uAc[1]);
            PG8_WAIT_V(8); PG8_WAIT_L(0); PG8_BAR; PG8_MMA(0, 0, At, B0); PG8_MMA(0, 1, At, B1); PG8_BAR; PG8_SCHED;
            PG8_LDA(At, 0, 1); PG8_STAGE_B(PG8_SB(0, 0), b2); PG8_STAGE_B(PG8_SB(0, 1), b2 + hstepB); PG8_STAGE_A(PG8_SA(0, 0), a2, u2[0]);
            PG8_WAIT_V(8); PG8_WAIT_L(0); PG8_BAR; PG8_MMA(1, 0, At, B0); PG8_MMA(1, 1, At, B1); PG8_BAR; PG8_SCHED;
            PG8_LDB(B0, 1, 0); PG8_LDB(B1, 1, 1); PG8_SCHED; PG8_LDA(At, 1, 0); PG8_STAGE_A(PG8_SA(0, 1), a2, u2[1]);
            PG8_WAIT_V(8); PG8_WAIT_L(0); PG8_BAR; PG8_MMA(0, 0, At, B0); PG8_MMA(0, 1, At, B1); PG8_BAR; PG8_SCHED;
            PG8_LDA(At, 1, 1); PG8_STAGE_B(PG8_SB(1, 0), b3); PG8_STAGE_B(PG8_SB(1, 1), b3 + hstepB); PG8_STAGE_A(PG8_SA(1, 0), a3, u2[0]);
            PG8_WAIT_V(8); PG8_WAIT_L(0); PG8_BAR; PG8_MMA(1, 0, At, B0); PG8_MMA(1, 1, At, B1); PG8_BAR; PG8_SCHED;
        }
        if (wr == 0) PG8_BAR;
        if constexpr (FP8) { asm volatile("s_nop 15\n\ts_nop 15" ::: "memory"); PG8_SCHED; }
        if constexpr (Epi::BIAS_LDS) E(acc, cur, wr, wc, fr, fq, (const LAS float*)(lds + Epi::BIAS_OFF + (ui & 1) * 1024)); else E(acc, cur, wr, wc, fr, fq);
        if (!has_next) break;
#pragma unroll
        for (int a = 0; a < 2; ++a)
#pragma unroll
            for (int b = 0; b < 2; ++b)
#pragma unroll
                for (int m = 0; m < 4; ++m)
#pragma unroll
                    for (int n = 0; n < 2; ++n) acc[a][b][m][n] = (f32x4){0.f, 0.f, 0.f, 0.f};
        cur = nxt; cB = nB; cA = nA; ++ui;
        if constexpr (Epi::BIAS_LDS) { if (wid == 0) __builtin_amdgcn_global_load_lds((const unsigned*)(E.bias_src(cur) + lane_id() * 4), (LAS unsigned*)(lds + Epi::BIAS_OFF + (ui & 1) * 1024), 16, 0, 0); }
        if constexpr (GATHER) {
#pragma unroll
            for (int h = 0; h < 2; ++h)
#pragma unroll
                for (int i = 0; i < 2; ++i) uAc[h][i] = uAn[h][i]; }
        if (wr == 1) PG8_BAR;
    }
    PG8_WAIT_V(0);
    PG8_BAR;
#undef PG8_SA
#undef PG8_SB
#undef PG8_STAGE_A
#undef PG8_STAGE_B
#undef PG8_LDA
#undef PG8_LDB
#undef PG8_MMA
#undef PG8_LD8
#undef PG8_HALF
#undef PG8_WAIT_V
#undef PG8_WAIT_L
#undef PG8_BAR
#undef PG8_SCHED
#undef PG8_CALC_UA
}

struct EpiF32 { static constexpr bool BIAS_LDS = false; static constexpr int BIAS_OFF = 0;
    static constexpr bool PERM = false;
    float* C; int ldc;
    __device__ __forceinline__ void operator()(const f32x4 (&acc)[2][2][4][2], const Unit& u, int wr, int wc, int fr, int fq) const {
        const int row0 = u.pm * BM + wr * 64 + fr, col0 = u.pn * BM + wc * 32 + 4 * fq;
#pragma unroll
        for (int ai = 0; ai < 2; ++ai)
#pragma unroll
            for (int m = 0; m < 4; ++m) { float* rowp = C + (size_t)(row0 + ai * HALF + m * 16) * ldc + col0;
#pragma unroll
                for (int bj = 0; bj < 2; ++bj)
#pragma unroll
                    for (int n = 0; n < 2; ++n) *(f32x4*)(rowp + bj * HALF + n * 16) = acc[ai][bj][m][n]; }
    }
};
struct EpiBf16 {
    static constexpr bool PERM = true, BIAS_LDS = false; static constexpr int BIAS_OFF = 0;
    bf16_t* O; int ldc;
    __device__ __forceinline__ void operator()(const f32x4 (&acc)[2][2][4][2], const Unit& u, int wr, int wc, int fr, int fq) const {
        const int row0 = u.pm * BM + wr * 64 + fr, col0 = u.pn * BM + wc * 32 + 8 * fq;
#pragma unroll
        for (int ai = 0; ai < 2; ++ai)
#pragma unroll
            for (int m = 0; m < 4; ++m) { bf16_t* rowp = O + (size_t)(row0 + ai * HALF + m * 16) * ldc + col0;
#pragma unroll
                for (int bj = 0; bj < 2; ++bj) { const f32x4 v0 = acc[ai][bj][m][0], v1 = acc[ai][bj][m][1];
                    u32x4 w; w.x = cvt_pk_bf16(v0[0], v0[1]); w.y = cvt_pk_bf16(v0[2], v0[3]); w.z = cvt_pk_bf16(v1[0], v1[1]); w.w = cvt_pk_bf16(v1[2], v1[3]);
                    *(u32x4*)(rowp + bj * HALF) = w; } }
    }
};
struct EpiK {
    static constexpr bool PERM = true, BIAS_LDS = false; static constexpr int BIAS_OFF = 0;
    unsigned char* KB;
    __device__ __forceinline__ void operator()(const f32x4 (&acc)[2][2][4][2], const Unit& u, int wr, int wc, int fr, int fq) const {
        const int row0 = u.pm * BM + wr * 64 + fr, cw = wc * 32 + 8 * fq;
        unsigned char* base = KB + (u.pn * 2) * 192 + cw;
#pragma unroll
        for (int ai = 0; ai < 2; ++ai)
#pragma unroll
            for (int m = 0; m < 4; ++m) { unsigned char* rowp = base + (size_t)(row0 + ai * HALF + m * 16) * 768;
#pragma unroll
                for (int bj = 0; bj < 2; ++bj) { const f32x4 v0 = acc[ai][bj][m][0] * QK_Q, v1 = acc[ai][bj][m][1] * QK_Q;
                    u32x2 w; w.x = pk4_fp8(v0[0], v0[1], v0[2], v0[3]); w.y = pk4_fp8(v1[0], v1[1], v1[2], v1[3]);
                    *(u32x2*)(rowp + bj * 192) = w; } }
    }
};
struct EpiVT {
    static constexpr bool PERM = true, BIAS_LDS = false; static constexpr int BIAS_OFF = 0;
    unsigned char* VT;
    __device__ __forceinline__ void operator()(const f32x4 (&acc)[2][2][4][2], const Unit& u, int wr, int wc, int fr, int fq) const {
        const int row0 = u.pm * BM + wr * 64 + fr, col0 = u.pn * BM + wc * 32 + 8 * fq;
#pragma unroll
        for (int bj = 0; bj < 2; ++bj) {
            const int n = col0 + bj * HALF;
            const int b = (n < NCTX) ? (n >> 8) : ((n - NCTX) >> 13); const int key = (n < NCTX) ? (n & 255) : CTXL + ((n - NCTX) & 8191);
            const int tile = key >> 6, kk0 = key & 63; const int boff = (kk0 >> 5) * 16 + 4 * ((kk0 & 31) >> 3);
#pragma unroll
            for (int ai = 0; ai < 2; ++ai)
#pragma unroll
                for (int m = 0; m < 4; ++m) { const int vc = row0 + ai * HALF + m * 16; const int hh = vc >> 7, v = vc & 127;
                    unsigned char* p = VT + ((size_t)((b * 4 + hh) * (KEYS / 64) + tile)) * VT_TILE + v * VT_ROW + boff;
                    const f32x4 v0 = acc[ai][bj][m][0] * PV_Q, v1 = acc[ai][bj][m][1] * PV_Q;
                    *(unsigned*)p = pk4_fp8(v0[0], v0[1], v0[2], v0[3]); *(unsigned*)(p + 32) = pk4_fp8(v1[0], v1[1], v1[2], v1[3]); } }
    }
};
struct EpiSwiglu {
    static constexpr bool PERM = true, BIAS_LDS = true; static constexpr int BIAS_OFF = RING_BYTES + 12288;
    unsigned char* ACT; const float* bias;
    __device__ __forceinline__ const float* bias_src(const Unit& u) const { return bias + (u.pn >> 3) * 2048 + (u.pn & 7) * BM; }
    __device__ __forceinline__ void operator()(const f32x4 (&acc)[2][2][4][2], const Unit& u, int wr, int wc, int fr, int fq, const LAS float* bl) const {
        const int pnl = u.pn & 7;
        const int row0 = u.pm * BM + wr * 64 + fr, cl = wc * 32 + 8 * fq, col0 = pnl * BM + cl;
#pragma unroll
        for (int ai = 0; ai < 2; ++ai)
#pragma unroll
            for (int m = 0; m < 4; ++m) { unsigned char* rowp = ACT + (size_t)(row0 + ai * HALF + m * 16) * 1024 + (col0 >> 1);
#pragma unroll
                for (int bj = 0; bj < 2; ++bj) { const f32x4 v0 = acc[ai][bj][m][0] + *(const LAS f32x4*)(bl + cl + bj * HALF), v1 = acc[ai][bj][m][1] + *(const LAS f32x4*)(bl + cl + bj * HALF + 4);
                    float o[4];
#pragma unroll
                    for (int i = 0; i < 4; ++i) { const float hg = (i < 2) ? v0[2 * i] : v1[2 * i - 4], hl = (i < 2) ? v0[2 * i + 1] : v1[2 * i - 3];
                        const float glu = fminf(hg, 7.f), lin = fminf(fmaxf(hl, -7.f), 7.f);
                        o[i] = glu * sigmoidf_(1.702f * glu) * (lin + 1.f); }
                    *(unsigned*)(rowp + bj * (HALF / 2)) = pk4_fp8(o[0] * ACT_Q, o[1] * ACT_Q, o[2] * ACT_Q, o[3] * ACT_Q); } }
    }
};
struct EpiDown {
    static constexpr bool PERM = true, BIAS_LDS = true; static constexpr int BIAS_OFF = RING_BYTES + 12288;
    unsigned char* O; const float* bias;
    __device__ __forceinline__ const float* bias_src(const Unit& u) const { return bias + (u.pn >> 2) * 1024 + (u.pn & 3) * BM; }
    __device__ __forceinline__ void operator()(const f32x4 (&acc)[2][2][4][2], const Unit& u, int wr, int wc, int fr, int fq, const LAS float* bl) const {
        const int pnl = u.pn & 3;
        const int row0 = u.pm * BM + wr * 64 + fr, cl = wc * 32 + 8 * fq, col0 = pnl * BM + cl;
#pragma unroll
        for (int ai = 0; ai < 2; ++ai)
#pragma unroll
            for (int m = 0; m < 4; ++m) { unsigned char* rowp = O + (size_t)(row0 + ai * HALF + m * 16) * 1024 + col0;
#pragma unroll
                for (int bj = 0; bj < 2; ++bj) { const f32x4 v0 = (acc[ai][bj][m][0] + *(const LAS f32x4*)(bl + cl + bj * HALF)) * DO_Q, v1 = (acc[ai][bj][m][1] + *(const LAS f32x4*)(bl + cl + bj * HALF + 4)) * DO_Q;
                    u32x2 w; w.x = pk4_fp8(v0[0], v0[1], v0[2], v0[3]); w.y = pk4_fp8(v1[0], v1[1], v1[2], v1[3]);
                    *(u32x2*)(rowp + bj * HALF) = w; } }
    }
};
}

namespace att {
constexpr int DQK = 192, DV = 128, NW = 8, QBLK = 32, KVBLK = 64;
constexpr int LDQ = 768, LDK = 768, LDV = 512, LDO = 1024;
constexpr float THR = 4.f;
constexpr int KROWB = 208;
constexpr int SHM_V = VT_TILE, SHM_K = KVBLK * KROWB;
constexpr int SHM_QR = 2 * SHM_V + 2 * SHM_K + NW * 64 * 4;
constexpr int SHM_ATTN = SHM_QR + NW * 4096;
#define KSWZ192(row, colB) ((row) * KROWB + (colB))
#define SBAR() __builtin_amdgcn_sched_barrier(0)
__device__ __forceinline__ int crow(int r, int hi) { return (r & 3) + 8 * (r >> 2) + 4 * hi; }
__device__ __forceinline__ float max3f(float a, float b, float c) { return fmaxf(fmaxf(a, b), c); }
__device__ __forceinline__ unsigned cvtpk(float lo, float hi) { unsigned r; asm volatile("v_cvt_pk_bf16_f32 %0, %1, %2" : "=v"(r) : "v"(lo), "v"(hi)); return r; }
constexpr float PSH = 3.f, THR2 = THR * 1.4426950408889634f;
__device__ __forceinline__ void partialSM(f32x16& p0, f32x16& p1, float& m_reg, float& alpha, const bool first) {
    float ma = max3f(p0[0], p0[1], p0[2]), mb = max3f(p0[3], p0[4], p0[5]), mc = max3f(p0[6], p0[7], p0[8]), md = max3f(p0[9], p0[10], p0[11]);
    ma = max3f(ma, p0[12], p0[13]); mb = max3f(mb, p0[14], p0[15]); mc = max3f(mc, p1[0], p1[1]); md = max3f(md, p1[2], p1[3]);
    ma = max3f(ma, p1[4], p1[5]); mb = max3f(mb, p1[6], p1[7]); mc = max3f(mc, p1[8], p1[9]); md = max3f(md, p1[10], p1[11]);
    ma = max3f(ma, p1[12], p1[13]); mb = max3f(mb, p1[14], p1[15]);
    float pmax = fmaxf(max3f(ma, mb, mc), md);
    { auto rr = __builtin_amdgcn_permlane32_swap(__float_as_uint(pmax), __float_as_uint(pmax), false, false);
      pmax = fmaxf(__uint_as_float(rr[0]), __uint_as_float(rr[1])); }
    const float u = pmax - PSH;
    if (__builtin_expect(!first && __all(u <= THR2), 1)) { alpha = 1.f; }
    else { const float dl = first ? u : fmaxf(u, 0.f); alpha = __builtin_amdgcn_exp2f(-dl); m_reg += dl;
#pragma unroll
        for (int r = 0; r < 16; ++r) { p0[r] -= dl; p1[r] -= dl; } }
#pragma unroll
    for (int r = 0; r < 16; ++r) p0[r] = __builtin_amdgcn_exp2f(p0[r]);
}
__device__ __forceinline__ void finishSM(f32x16& p0, f32x16& p1, float alpha, float& l_reg, v8i& pa) {
#pragma unroll
    for (int r = 0; r < 16; ++r) p1[r] = __builtin_amdgcn_exp2f(p1[r]);
    float sa = p0[0] + p0[1], sb = p0[2] + p0[3], sc = p0[4] + p0[5], sd = p0[6] + p0[7];
    sa += p0[8]; sb += p0[9]; sc += p0[10]; sd += p0[11]; sa += p0[12]; sb += p0[13]; sc += p0[14]; sd += p0[15];
#pragma unroll
    for (int r = 0; r < 16; r += 4) { sa += p1[r]; sb += p1[r + 1]; sc += p1[r + 2]; sd += p1[r + 3]; }
    float ps = (sa + sb) + (sc + sd);
    { auto rr = __builtin_amdgcn_permlane32_swap(__float_as_uint(ps), __float_as_uint(ps), false, false);
      ps = __uint_as_float(rr[0]) + __uint_as_float(rr[1]); }
    l_reg = l_reg * alpha + ps;
#pragma unroll
    for (int c = 0; c < 4; ++c) { pa[c] = (int)pk4_fp8(p0[4 * c], p0[4 * c + 1], p0[4 * c + 2], p0[4 * c + 3]);
        pa[4 + c] = (int)pk4_fp8(p1[4 * c], p1[4 * c + 1], p1[4 * c + 2], p1[4 * c + 3]); }
}
__device__ __forceinline__ void qkt(f32x16& p0, f32x16& p1, const float m_reg, const char* Ks, const v8i* q8, int r32, int hi) {
    { const float ini = PSH - m_reg;
#pragma unroll
      for (int r = 0; r < 16; ++r) { p0[r] = ini; p1[r] = ini; } }
#pragma unroll
    for (int ks = 0; ks < 3; ++ks) { const char* kp = Ks + r32 * KROWB + ks * 64 + hi * 32;
        const v8i a0 = __builtin_shufflevector(*reinterpret_cast<const v4i*>(kp), *reinterpret_cast<const v4i*>(kp + 16), 0, 1, 2, 3, 4, 5, 6, 7);
        const v8i a1 = __builtin_shufflevector(*reinterpret_cast<const v4i*>(kp + 32 * KROWB), *reinterpret_cast<const v4i*>(kp + 32 * KROWB + 16), 0, 1, 2, 3, 4, 5, 6, 7);
        p0 = __builtin_amdgcn_mfma_scale_f32_32x32x64_f8f6f4(a0, q8[ks], p0, 0, 0, 0, QK_E, 0, QC_E);
        p1 = __builtin_amdgcn_mfma_scale_f32_32x32x64_f8f6f4(a1, q8[ks], p1, 0, 0, 0, QK_E, 0, QC_E); }
}
__device__ __forceinline__ void pv_d0(f32x16* o, const char* Vs, const v8i pa, int r32, int hi) {
#pragma unroll
    for (int d0 = 0; d0 < 4; ++d0) { const char* vp = Vs + (d0 * 32 + r32) * VT_ROW + hi * 32;
        const v8i bv = __builtin_shufflevector(*reinterpret_cast<const v4i*>(vp), *reinterpret_cast<const v4i*>(vp + 16), 0, 1, 2, 3, 4, 5, 6, 7);
        o[d0] = __builtin_amdgcn_mfma_scale_f32_32x32x64_f8f6f4(pa, bv, o[d0], 0, 0, 0, PV_E, 0, PV_E); }
}
constexpr int ABUF = SHM_K + SHM_V;
constexpr int SHM_ATTN3 = 3 * ABUF + NW * 64 * 4;
__device__ __forceinline__ void attn_unit(const bf16_t* Qb, const unsigned char* Kh, const unsigned char* Vh, bf16_t* Ob, int seq, int cbase, int lbase, int t0, const f32x2* atab, char* lds, const int wave_s) {
    int tid_ = wave_s * 64 + lane_id(); asm volatile("" : "+v"(tid_));
    const int tid = tid_, wid = wave_s, lane = tid & 63, r32 = lane & 31, hi = lane >> 5;
    float* ws = (float*)(lds + 3 * ABUF) + wid * 64; float* li_l = ws; float* al_l = ws + 32;
    float m_reg = 0.f, l_reg = 0; f32x16 o[4] = {}; v8i qr[3];
    const bf16_t* Qw = Qb + (long)(wid * QBLK + r32) * LDQ + hi * 32;
#pragma unroll
    for (int ks = 0; ks < 3; ++ks) {
        float x[32];
#pragma unroll
        for (int c4 = 0; c4 < 4; ++c4) { const u32x4 w = *reinterpret_cast<const u32x4*>(Qw + ks * 64 + c4 * 8);
            x[8 * c4 + 0] = bflo(w.x); x[8 * c4 + 1] = bfhi(w.x); x[8 * c4 + 2] = bflo(w.y); x[8 * c4 + 3] = bfhi(w.y); x[8 * c4 + 4] = bflo(w.z); x[8 * c4 + 5] = bfhi(w.z); x[8 * c4 + 6] = bflo(w.w); x[8 * c4 + 7] = bfhi(w.w); }
        if (ks == 2 && t0 >= 0) { const int t = t0 + wid * QBLK + r32; const int pos = hi ? (t & 63) : (t >> 6); const f32x2* tb = atab + pos * 16;
#pragma unroll
            for (int f = 0; f < 16; ++f) { const f32x2 cs = tb[f]; const float a = x[2 * f], b = x[2 * f + 1]; x[2 * f] = a * cs.x - b * cs.y; x[2 * f + 1] = b * cs.x + a * cs.y; } }
        v8i q;
#pragma unroll
        for (int c = 0; c < 8; ++c) q[c] = (int)pk4_fp8(x[4 * c] * QC_Q, x[4 * c + 1] * QC_Q, x[4 * c + 2] * QC_Q, x[4 * c + 3] * QC_Q);
        qr[ks] = q; }
    unsigned kq[2];
#pragma unroll
    for (int i = 0; i < 2; ++i) { const int c = (i * 8 + wid) * 64 + lane; const int r = c / 13, cc = c % 13; kq[i] = (unsigned)((r < 64 ? r : 63) * LDK + (cc < 12 ? cc : 11) * 16); }
    const unsigned vq0 = (unsigned)(wid * 1024 + lane * 16);
    LAS unsigned char* ldsl = (LAS unsigned char*)(uintptr_t)(unsigned)(uintptr_t)lds;
#define DMA_TILE(jt, buf) do { const int kr_ = ((jt) < 4) ? cbase + 64 * (jt) : lbase + 64 * ((jt) - 4); const char* kp_ = (const char*)Kh + (size_t)kr_ * LDK; const char* vp_ = (const char*)Vh + (size_t)(jt) * VT_TILE + vq0; \
    LAS unsigned char* kb_ = ldsl + (buf) * ABUF + wid * 1024; LAS unsigned char* vb_ = kb_ + SHM_K; \
    __builtin_amdgcn_global_load_lds((const unsigned*)(kp_ + kq[0]), (LAS unsigned*)(kb_), 16, 0, 0); \
    if (wid < 5) __builtin_amdgcn_global_load_lds((const unsigned*)(kp_ + kq[1]), (LAS unsigned*)(kb_ + 8192), 16, 0, 0); \
    __builtin_amdgcn_global_load_lds((const unsigned*)(vp_), (LAS unsigned*)(vb_), 16, 0, 0); \
    if (wid < 2) __builtin_amdgcn_global_load_lds((const unsigned*)(vp_ + 8192), (LAS unsigned*)(vb_ + 8192), 16, 0, 0); } while (0)
#define WAITBAR() do { asm volatile("s_waitcnt vmcnt(0)" ::: "memory"); __syncthreads(); } while (0)
#define RESC(a) do { if (__any((a) < 1.f)) { if (hi == 0) al_l[r32] = (a); asm volatile("s_waitcnt lgkmcnt(0)" ::: "memory"); \
    _Pragma("unroll") for (int d = 0; d < 4; ++d) _Pragma("unroll") for (int r = 0; r < 16; ++r) o[d][r] *= al_l[crow(r, hi)]; } } while (0)
#define KBUF(b) (lds + (b) * ABUF)
#define VBASE(b) (lds + (b) * ABUF + SHM_K)
    f32x16 pA0, pA1, pB0, pB1; float alA, alB; v8i pa; const int NT = seq / KVBLK;
    DMA_TILE(0, 0); DMA_TILE(1, 1); WAITBAR();
    qkt(pA0, pA1, m_reg, KBUF(0), qr, r32, hi); partialSM(pA0, pA1, m_reg, alA, true);
    int bprev = 0, bj = 1;
    for (int j = 1; j + 1 < NT; j += 2) {
        { const int bn = 3 - bprev - bj; DMA_TILE(j + 1, bn);
          SBAR(); qkt(pB0, pB1, m_reg, KBUF(bj), qr, r32, hi);
          finishSM(pA0, pA1, alA, l_reg, pa); SBAR();
          pv_d0(o, VBASE(bprev), pa, r32, hi); partialSM(pB0, pB1, m_reg, alB, false);
          RESC(alB); WAITBAR(); bprev = bj; bj = bn; }
        { const int bn = 3 - bprev - bj; if (j + 2 < NT) DMA_TILE(j + 2, bn);
          SBAR(); qkt(pA0, pA1, m_reg, KBUF(bj), qr, r32, hi);
          finishSM(pB0, pB1, alB, l_reg, pa); SBAR();
          pv_d0(o, VBASE(bprev), pa, r32, hi); partialSM(pA0, pA1, m_reg, alA, false);
          RESC(alA); WAITBAR(); bprev = bj; bj = bn; }
    }
    SBAR(); qkt(pB0, pB1, m_reg, KBUF(bj), qr, r32, hi);
    finishSM(pA0, pA1, alA, l_reg, pa); SBAR();
    pv_d0(o, VBASE(bprev), pa, r32, hi); partialSM(pB0, pB1, m_reg, alB, false);
    RESC(alB);
    finishSM(pB0, pB1, alB, l_reg, pa); SBAR();
    pv_d0(o, VBASE(bj), pa, r32, hi);
    if (hi == 0) li_l[r32] = l_reg; asm volatile("s_waitcnt lgkmcnt(0)" ::: "memory");
    float rli[16];
#pragma unroll
    for (int r = 0; r < 16; ++r) rli[r] = 8.f * __builtin_amdgcn_rcpf(li_l[crow(r, hi)]);
    bf16_t* Ow = Ob + (long)(wid * QBLK) * LDO;
#pragma unroll
    for (int r = 0; r < 16; ++r) { const int orow = crow(r, hi);
#pragma unroll
        for (int d0 = 0; d0 < 4; ++d0) Ow[(long)orow * LDO + d0 * 32 + r32] = (bf16_t)f2bf(o[d0][r] * rli[r]); }
    __syncthreads();
#undef DMA_TILE
#undef WAITBAR
#undef RESC
#undef KBUF
#undef VBASE
}
}

struct Args { const float* in[28]; float* out; unsigned char* ws; int ph_lo, ph_hi; };
enum { I_X = 0, I_C, I_CTX, I_CCTX, I_ADAW, I_ADAB, I_WIN, I_QNG, I_KVNG, I_WUQ, I_WUKV, I_SGNG, I_SGNB, I_SGW, I_SGB, I_RDF, I_RDB, I_WO, I_LN1G, I_LN1B, I_RW, I_RB, I_WGU, I_BGU, I_WDN, I_BDN, I_LN2G, I_LN2B };

template <int QPERM>
__device__ __forceinline__ void transpose_item(const float* W, int K, int N, bf16_t* WT, LAS float* scr, int item, int lane) {
    const int nblk = N / 32, kb = item / nblk, nb = item % nblk, k0 = 64 * kb, n0 = 32 * nb;
#pragma unroll 8
    for (int i = 0; i < 32; ++i) { const int kk = 2 * i + (lane >> 5); scr[kk * 33 + (lane & 31)] = W[(size_t)(k0 + kk) * N + n0 + (lane & 31)]; }
    asm volatile("s_waitcnt lgkmcnt(0)" ::: "memory");
    const int c = lane & 7;
#pragma unroll
    for (int j = 0; j < 4; ++j) { const int n = (lane >> 3) + 8 * j; const LAS float* s = scr + (8 * c) * 33 + n;
        u32x4 o; o.x = pk2(s[0 * 33], s[1 * 33]); o.y = pk2(s[2 * 33], s[3 * 33]); o.z = pk2(s[4 * 33], s[5 * 33]); o.w = pk2(s[6 * 33], s[7 * 33]);
        int dn = n0 + n;
        if (QPERM == 1) { const int h = dn / 192, d = dn % 192; if (d >= 128) { const int jj = d - 128, a = jj >> 5, p = (jj >> 4) & 1, f = jj & 15; dn = h * 192 + 128 + 2 * (a * 16 + f) + p; } }
        if (QPERM == 2) { const int h = dn >> 8, j = dn & 255; dn = (j < 128) ? h * 128 + j : 512 + h * 128 + (j - 128); }
        *(u32x4*)(WT + (size_t)dn * K + k0 + 8 * c) = o; }
    asm volatile("s_waitcnt lgkmcnt(0)" ::: "memory");
}

__device__ __forceinline__ void transpose_item_fp8(const float* W, int K, int N, unsigned char* WT, float q, LAS float* scr, int item, int lane) {
    const int nblk = N / 32, kb = item / nblk, nb = item % nblk, k0 = 64 * kb, n0 = 32 * nb;
#pragma unroll 8
    for (int i = 0; i < 32; ++i) { const int kk = 2 * i + (lane >> 5); scr[kk * 33 + (lane & 31)] = W[(size_t)(k0 + kk) * N + n0 + (lane & 31)]; }
    asm volatile("s_waitcnt lgkmcnt(0)" ::: "memory");
    const int c = lane & 7;
#pragma unroll
    for (int j = 0; j < 4; ++j) { const int n = (lane >> 3) + 8 * j; const LAS float* s = scr + (8 * c) * 33 + n;
        u32x2 o; o.x = pk4_fp8(s[0 * 33] * q, s[1 * 33] * q, s[2 * 33] * q, s[3 * 33] * q); o.y = pk4_fp8(s[4 * 33] * q, s[5 * 33] * q, s[6 * 33] * q, s[7 * 33] * q);
        *(u32x2*)(WT + (size_t)(n0 + n) * K + k0 + 8 * c) = o; }
    asm volatile("s_waitcnt lgkmcnt(0)" ::: "memory");
}

__device__ __forceinline__ void transpose_item_fp8w(const float* W, int K, int N, unsigned char* WT, float q, LAS unsigned char* scr, int item, int lane) {
    const int nblk = N / 128, kb = item / nblk, nb = item % nblk, k0 = 64 * kb, n0 = 128 * nb;
    const int l5 = lane & 31, h = lane >> 5;
    const float* src = W + (size_t)(k0 + 16 * h) * N + n0 + 4 * l5;
#pragma unroll
    for (int b = 0; b < 2; ++b) {
        f32x4 x[16];
#pragma unroll
        for (int s_ = 0; s_ < 16; ++s_) x[s_] = *(const f32x4*)(src + (size_t)(32 * b + s_) * N);
#pragma unroll
        for (int i = 0; i < 4; ++i) {
            u32x4 o;
            o.x = pk4_fp8(x[0][i] * q, x[1][i] * q, x[2][i] * q, x[3][i] * q); o.y = pk4_fp8(x[4][i] * q, x[5][i] * q, x[6][i] * q, x[7][i] * q);
            o.z = pk4_fp8(x[8][i] * q, x[9][i] * q, x[10][i] * q, x[11][i] * q); o.w = pk4_fp8(x[12][i] * q, x[13][i] * q, x[14][i] * q, x[15][i] * q);
            *(LAS u32x4*)(scr + (l5 + 32 * i) * 80 + (2 * b + h) * 16) = o; }
    }
    asm volatile("s_waitcnt lgkmcnt(0)" ::: "memory");
#pragma unroll
    for (int qd = 0; qd < 8; ++qd) {
        const int rho = 16 * qd + (lane >> 2), piece = lane & 3;
        const u32x4 o = *(const LAS u32x4*)(scr + rho * 80 + piece * 16);
        const int nl = 4 * (rho & 31) + (rho >> 5);
        *(u32x4*)(WT + (size_t)(n0 + nl) * K + k0 + piece * 16) = o; }
    asm volatile("s_waitcnt lgkmcnt(0)" ::: "memory");
}

__global__ void __launch_bounds__(512, 2) mega(Args a) {
    extern __shared__ __attribute__((aligned(16))) unsigned char lds_raw[];
    LAS unsigned char* lds = (LAS unsigned char*)lds_raw;
    const int G = gridDim.x, bx = blockIdx.x;
    const int wave_s = __builtin_amdgcn_readfirstlane(threadIdx.x >> 6);
    const int vcu = (G % 8 == 0) ? (bx % 8) * (G / 8) + bx / 8 : bx;
    const int NGW = G * 8;
#define PH_IDS() int lane_ = lane_id(); asm volatile("" : "+v"(lane_)); const int lane = lane_; const int wave = wave_s; const int tid = wave * 64 + lane; const int gw = vcu * 8 + wave; (void)lane; (void)gw; (void)tid
    unsigned char* ws = a.ws;
    unsigned* ctl = (unsigned*)(ws + WS_CTL);
    volatile LAS unsigned* MISC = (volatile LAS unsigned*)(lds + MISC_OFF);
    for (int u = threadIdx.x; u < (LDS_BYTES - RING_BYTES) / 4; u += 512) ((LAS unsigned*)(lds + RING_BYTES))[u] = 0u;
    __syncthreads();
    const int lo = a.ph_lo, hi = a.ph_hi;
    XcdBarrier bar; bar.bar = ctl + CW_BAR; bar.x = 0; bar.st = MISC + 8;
    if (hi - lo > 1) bar = xcd_barrier_post(ctl + CW_BAR, MISC + 8);
    bar.wave = wave_s;
#ifndef MK_ONLY
#define MK_ONLY -1
#endif
#ifndef MK_MASK
#define MK_MASK 0xFFF
#endif
#define EN(q) ((MK_ONLY < 0 || MK_ONLY == (q)) && ((MK_MASK >> (q)) & 1))
#ifndef MK_REP_PHASE
#define MK_REP_PHASE -1
#endif
#ifndef MK_REP_N
#define MK_REP_N 1
#endif
#define REPS(q) ((MK_REP_PHASE == (q)) ? MK_REP_N : 1)
#ifndef MK_SUB
#define MK_SUB 15
#endif
#define SUB(m) ((MK_SUB & (m)) != 0)
#define XROW0(n_) (((n_) < NCTX) ? a.in[I_CTX] + (size_t)(n_) * DM : a.in[I_X] + (size_t)((n_) - NCTX) * DM)
#define XLOAD(dst_, l_, n_, j_) do { if ((l_) == 0) dst_ = *((const f32x4*)XROW0(n_) + lane + 64 * (j_)); else { const u32x2 w_ = *((const u32x2*)(XRB + (size_t)(n_) * DM) + lane + 64 * (j_)); dst_ = (f32x4){__uint_as_float(w_.x), __uint_as_float(w_.y), 0.f, 0.f}; } } while (0)
#define XVAL(src_, l_) (((l_) == 0) ? (src_) : (f32x4){bflo(__float_as_uint((src_).x)), bfhi(__float_as_uint((src_).x)), bflo(__float_as_uint((src_).y)), bfhi(__float_as_uint((src_).y))})
#define IN(k) (lo <= (k) && (k) < hi)
#define SEAM(k) do { if (IN(k) && IN((k) + 1)) xcd_barrier(bar); } while (0)

    float* MOD = (float*)(ws + WS_MOD);
    f32x2* ATAB = (f32x2*)(ws + WS_ATAB);
    f32x2* RTAB = (f32x2*)(ws + WS_RTAB);
    unsigned char* WIN8 = ws + WS_WIN; bf16_t* WUQ = (bf16_t*)(ws + WS_WUQ); bf16_t* WUKV = (bf16_t*)(ws + WS_WUKV); bf16_t* WOT = (bf16_t*)(ws + WS_WO);
    unsigned char* WGU = ws + WS_WGU; unsigned char* WDN = ws + WS_WDN; unsigned char* XH8 = ws + WS_XH8; bf16_t* SGWB = (bf16_t*)(ws + WS_SGWB);
    bf16_t* XRB = (bf16_t*)(ws + WS_XRES); unsigned char* XHF = ws + WS_XH; bf16_t* PROJ = (bf16_t*)(ws + WS_PROJ);
    bf16_t* CQN = (bf16_t*)(ws + WS_CQN); bf16_t* CKVN = (bf16_t*)(ws + WS_CKVN);
    bf16_t* QB = (bf16_t*)(ws + WS_QB); unsigned char* KB = ws + WS_KB; unsigned char* VT8 = ws + WS_VB;
    float* SLOC = (float*)(ws + WS_SGU); float* SIN = (float*)(ws + WS_SGV);
    float* RQ = (float*)(ws + WS_RQ); float* RK = (float*)(ws + WS_RK); float* OF = (float*)(ws + WS_OF); float* OB = (float*)(ws + WS_OB);
    bf16_t* MIX = (bf16_t*)(ws + WS_MIX); bf16_t* YB = (bf16_t*)(ws + WS_Y);
    int* TOPI = (int*)(ws + WS_TOPI); float* GATE = (float*)(ws + WS_GATE); int* DEST = (int*)(ws + WS_DEST); int* ROWTOK = (int*)(ws + WS_ROWTOK);
    unsigned char* ACT = ws + WS_ACT; unsigned char* DOUT = ws + WS_DOUT;

    constexpr int IT_IN = 16 * 62, IT_UQ = 6 * 24, IT_UKV = 4 * 32, IT_O = 16 * 32, IT_SMALL = IT_IN + IT_UQ + IT_UKV + IT_O, IT_GU = 16 * 16, IT_DN = 16 * 8;
    constexpr int IT_LAYER = IT_SMALL + 32 * IT_GU + 32 * IT_DN;
#define CONVERT_ITEM(L_, it_) do { int r_ = (it_); const int cl_ = (L_); \
        if (r_ < IT_IN) { transpose_item_fp8(a.in[I_WIN] + (size_t)cl_ * 1024 * 1984, 1024, 1984, WIN8 + (size_t)cl_ * 2048 * 1024, WGU_Q, scr, r_, lane); break; } r_ -= IT_IN; \
        if (r_ < IT_UQ) { transpose_item<1>(a.in[I_WUQ] + (size_t)cl_ * 384 * 768, 384, 768, WUQ + (size_t)cl_ * 768 * 384, scr, r_, lane); break; } r_ -= IT_UQ; \
        if (r_ < IT_UKV) { transpose_item<2>(a.in[I_WUKV] + (size_t)cl_ * 256 * 1024, 256, 1024, WUKV + (size_t)cl_ * 1024 * 256, scr, r_, lane); break; } r_ -= IT_UKV; \
        if (r_ < IT_O) { transpose_item<0>(a.in[I_WO] + (size_t)cl_ * 1024 * 1024, 1024, 1024, WOT + (size_t)cl_ * 1024 * 1024, scr, r_, lane); break; } r_ -= IT_O; \
        if (r_ < 32 * IT_GU) { const int mtx_ = cl_ * 32 + r_ / IT_GU; r_ %= IT_GU; transpose_item_fp8w(a.in[I_WGU] + (size_t)mtx_ * 1024 * 2048, 1024, 2048, WGU + (size_t)mtx_ * 2048 * 1024, WGU_Q, (LAS unsigned char*)scr, r_, lane); break; } r_ -= 32 * IT_GU; \
        { const int mtx_ = cl_ * 32 + r_ / IT_DN; r_ %= IT_DN; transpose_item_fp8w(a.in[I_WDN] + (size_t)mtx_ * 1024 * 1024, 1024, 1024, WDN + (size_t)mtx_ * 1024 * 1024, WDN_Q, (LAS unsigned char*)scr, r_, lane); } } while (0)

    for (int rep_ = 0; rep_ < REPS(10); ++rep_) if (EN(10) && IN(0)) { PH_IDS();
        {
            LAS float* sc = (LAS float*)lds;
            LAS float* red = (LAS float*)(lds + 20480);
            { float cv_[10];
#pragma unroll
              for (int u_ = 0; u_ < 10; ++u_) { const int i = tid + 512 * u_; const int s = i >> 10, k = i & 1023; cv_[u_] = (s < 4) ? a.in[I_C][s * 1024 + k] : a.in[I_CCTX][k]; }
#pragma unroll
              for (int u_ = 0; u_ < 10; ++u_) sc[tid + 512 * u_] = cv_[u_] * sigmoidf_(cv_[u_]); }
            __syncthreads();
            for (int it = bx; it < 4 * 96; it += G) {
                const int l = it / 96, j0 = (it % 96) * 64;
                const float* wp = a.in[I_ADAW] + (size_t)l * 1024 * 6144 + j0 + lane;
                float s0 = 0, s1 = 0, s2 = 0, s3 = 0, s4 = 0;
#pragma unroll 8
                for (int kk = 0; kk < 128; ++kk) { const int k = wave * 128 + kk; const float w = wp[(size_t)k * 6144];
                    s0 += sc[k] * w; s1 += sc[1024 + k] * w; s2 += sc[2048 + k] * w; s3 += sc[3072 + k] * w; s4 += sc[4096 + k] * w; }
                red[(wave * 5 + 0) * 64 + lane] = s0; red[(wave * 5 + 1) * 64 + lane] = s1; red[(wave * 5 + 2) * 64 + lane] = s2; red[(wave * 5 + 3) * 64 + lane] = s3; red[(wave * 5 + 4) * 64 + lane] = s4;
                __syncthreads();
                if (tid < 320) { const int s = tid >> 6, jl = tid & 63; float v = 0;
#pragma unroll
                    for (int w = 0; w < 8; ++w) v += red[(w * 5 + s) * 64 + jl];
                    MOD[((size_t)l * 5 + s) * 6144 + j0 + jl] = v + a.in[I_ADAB][l * 6144 + j0 + jl]; }
                __syncthreads();
            }
        }
        for (int i = bx * 512 + tid; i < 128 * 16; i += G * 512) { float s, c; sincos_d((double)(i >> 4) * INV_A[i & 15], s, c); ATAB[i] = (f32x2){c, s}; }
        for (int i = bx * 512 + tid; i < KEYS * 16; i += G * 512) { float s, c; sincos_d((double)(i >> 4) * INV_R[i & 15], s, c); RTAB[i] = (f32x2){c, s}; }
        for (int i = bx * 512 + tid; i < 4 * 4 * 128 * 128 / 4; i += G * 512) { const f32x4 w = *((const f32x4*)a.in[I_SGW] + i); u32x2 o; o.x = pk2(w.x, w.y); o.y = pk2(w.z, w.w); *((u32x2*)SGWB + i) = o; }
        for (int i = bx * 512 + tid; i < 4 * 64 * 1024 / 16; i += G * 512) { const int l = i / (64 * 1024 / 16), r = i % (64 * 1024 / 16);
            *(u32x4*)(WIN8 + ((size_t)l * 2048 + 1984) * 1024 + (size_t)r * 16) = (u32x4){0u, 0u, 0u, 0u}; }
        {
            __syncthreads();
            LAS float* scr = (LAS float*)(lds + wave * 16384);
            for (int it = gw; it < IT_LAYER; it += NGW) CONVERT_ITEM(0, it);
            __syncthreads();
        }
    }
    SEAM(0);
    if (EN(11) && IN(1)) { PH_IDS();
        for (int n = gw; n < NTOK; n += 2 * NGW) {
            const int nn[2] = {n, (n + NGW < NTOK) ? n + NGW : n};
            f32x4 xv_[2][4], sh_[2][4], sc_[2][4];
#pragma unroll
            for (int t = 0; t < 2; ++t) { const float* md = MOD + (size_t)modset(nn[t]) * 6144; const f32x4* xr = (const f32x4*)XROW0(nn[t]) + lane;
#pragma unroll
                for (int j = 0; j < 4; ++j) { xv_[t][j] = xr[64 * j]; sh_[t][j] = *((const f32x4*)(md) + lane + 64 * j); sc_[t][j] = *((const f32x4*)(md + 1024) + lane + 64 * j); } }
#pragma unroll
            for (int t = 0; t < 2; ++t) { unsigned* o8 = (unsigned*)(XHF + (size_t)nn[t] * DM) + lane;
#pragma unroll
                for (int j = 0; j < 4; ++j) { const f32x4 v = xv_[t][j], sh = sh_[t][j], scl = sc_[t][j];
                    o8[64 * j] = pk4_fp8((v.x * (1.f + scl.x) + sh.x) * ACT_Q, (v.y * (1.f + scl.y) + sh.y) * ACT_Q, (v.z * (1.f + scl.z) + sh.z) * ACT_Q, (v.w * (1.f + scl.w) + sh.w) * ACT_Q); } }
        }
    }
    SEAM(1);

#pragma unroll 1
    for (int l = 0; l < NLAYER; ++l) {
        const int pb = 2 + 10 * l;
        const float* MODL = MOD + (size_t)l * 5 * 6144;
        for (int rep_ = 0; rep_ < REPS(0); ++rep_) if (EN(0) && IN(pb + 0)) { PH_IDS();
            pg8::Gemm g{XHF, WIN8 + (size_t)l * 2048 * 1024, 1024, 1024, nullptr, ACT_E, WGU_E};
            pg8::StaticOrder S; S.init(NTOK / 256, PROJW / 256, G, bx);
            pg8::EpiBf16 E{PROJ, PROJW};
            pg8::gemm_phase<pg8::EpiBf16, pg8::StaticOrder, false, true>(lds, g, S, E, wave_s);
        }
        SEAM(pb + 0);
        for (int rep_ = 0; rep_ < REPS(1); ++rep_) if (EN(1) && IN(pb + 1)) { PH_IDS();
            const float* qg = a.in[I_QNG] + l * 384; const float* kvg = a.in[I_KVNG] + l * 256;
            const float* sgg = a.in[I_SGNG] + l * 256; const float* sgb = a.in[I_SGNB] + l * 256;
            const float* sb = a.in[I_SGB] + l * 4 * 128;
            LAS float* ksr = (LAS float*)lds;
            LAS bf16_t* vsT = (LAS bf16_t*)(lds + 65536);
            constexpr int VST = 136;
            for (int T = vcu; T < NTOK / 128; T += G) {
                const int n0 = T * 128;
                float qgv[6];
#pragma unroll
                for (int j = 0; j < 3; ++j) { qgv[2 * j] = qg[lane * 2 + 128 * j]; qgv[2 * j + 1] = qg[lane * 2 + 128 * j + 1]; }
                const f32x4 kvgv = *(const f32x4*)(kvg + lane * 4), sggv = *(const f32x4*)(sgg + lane * 4), sgbv = *(const f32x4*)(sgb + lane * 4);
                const bool kvonly = (l == NLAYER - 1) && (n0 < NCTX);
                __syncthreads();
                for (int hb = 0; hb < 2; ++hb) {
                    unsigned cqw[8][3]; u32x2 ckw[8], sgw[8]; unsigned short krw[8], q1w[8], q2w[8], k1w[8], k2w[8]; f32x2 rcs[8], acs[8];
#pragma unroll
                    for (int k = 0; k < 8; ++k) {
                        const int n = n0 + wave * 16 + hb * 8 + k;
                        const bf16_t* pr = PROJ + (size_t)n * PROJW;
                        const bool lat = n >= NCTX; const int t = (n - NCTX) & 8191; const int upos = lat ? CTXL + t : (n & 255);
#pragma unroll
                        for (int j = 0; j < 3; ++j) cqw[k][j] = *(const unsigned*)(pr + C_CQ + lane * 2 + 128 * j);
                        ckw[k] = *(const u32x2*)(pr + C_CKV + lane * 4); sgw[k] = *(const u32x2*)(pr + C_SGV + lane * 4);
                        krw[k] = pr[C_KR + lane];
                        { const int h = lane >> 4, i = lane & 15; q1w[k] = pr[C_RQ + h * 32 + i]; q2w[k] = pr[C_RQ + h * 32 + 16 + i]; k1w[k] = pr[C_RK + h * 32 + i]; k2w[k] = pr[C_RK + h * 32 + 16 + i]; rcs[k] = RTAB[upos * 16 + i]; }
                        { const int aa = lane >> 5, f = lane & 15; const int pos = lat ? (aa ? (t & 63) : (t >> 6)) : 0; acs[k] = ATAB[pos * 16 + f]; }
                    }
                    __builtin_amdgcn_sched_barrier(0);
#pragma unroll
                    for (int k = 0; k < 8; ++k) {
                        __builtin_amdgcn_sched_barrier(0);
                        const int tl = wave * 16 + hb * 8 + k, n = n0 + tl;
                        if (!kvonly) {
                            float v[6]; float ss = 0;
#pragma unroll
                            for (int j = 0; j < 3; ++j) { const unsigned w = cqw[k][j]; v[2 * j] = bflo(w); v[2 * j + 1] = bfhi(w); ss += v[2 * j] * v[2 * j] + v[2 * j + 1] * v[2 * j + 1]; }
                            const float rs = rsqrtf(wave_sum(ss) * (1.f / 384.f) + RMS_EPS);
#pragma unroll
                            for (int j = 0; j < 3; ++j) { const int c = lane * 2 + 128 * j; *(unsigned*)(CQN + (size_t)n * 384 + c) = pk2(v[2 * j] * rs * qgv[2 * j], v[2 * j + 1] * rs * qgv[2 * j + 1]); }
                        }
                        {
                            const u32x2 w = ckw[k];
                            const float v0 = bflo(w.x), v1 = bfhi(w.x), v2 = bflo(w.y), v3 = bfhi(w.y);
                            const float rs = rsqrtf(wave_sum(v0 * v0 + v1 * v1 + v2 * v2 + v3 * v3) * (1.f / 256.f) + RMS_EPS);
                            const f32x4 gg = kvgv;
                            u32x2 o; o.x = pk2(v0 * rs * gg.x, v1 * rs * gg.y); o.y = pk2(v2 * rs * gg.z, v3 * rs * gg.w);
                            *(u32x2*)(CKVN + (size_t)n * 256 + lane * 4) = o;
                        }
                        {
                            const float x = bf2f(krw[k]); const float xp = __shfl_xor(x, 16);
                            const int aa = lane >> 5, p = (lane >> 4) & 1, f = lane & 15; const f32x2 cs = acs[k];
                            const float o = p ? (x * cs.x + xp * cs.y) : (x * cs.x - xp * cs.y);
                            const int dd = 128 + 2 * (aa * 16 + f) + p; const unsigned char ob = (unsigned char)(pk4_fp8(o * QK_Q, 0.f, 0.f, 0.f) & 0xffu);
                            unsigned char* kd = KB + (size_t)n * 768 + dd;
                            kd[0] = ob; kd[192] = ob; kd[384] = ob; kd[576] = ob;
                        }
                        if (!kvonly) {
                            const u32x2 w = sgw[k];
                            float v0 = gelu1(bflo(w.x)), v1 = gelu1(bfhi(w.x)), v2 = gelu1(bflo(w.y)), v3 = gelu1(bfhi(w.y));
                            const float mean = wave_sum(v0 + v1 + v2 + v3) * (1.f / 256.f);
                            v0 -= mean; v1 -= mean; v2 -= mean; v3 -= mean;
                            const float rs = rsqrtf(wave_sum(v0 * v0 + v1 * v1 + v2 * v2 + v3 * v3) * (1.f / 256.f) + LN_EPS);
                            const f32x4 gg = sggv, bb = sgbv;
                            LAS bf16_t* vd = vsT + (lane * 4) * VST + tl;
                            vd[0] = (bf16_t)f2bf(v0 * rs * gg.x + bb.x); vd[VST] = (bf16_t)f2bf(v1 * rs * gg.y + bb.y); vd[2 * VST] = (bf16_t)f2bf(v2 * rs * gg.z + bb.z); vd[3 * VST] = (bf16_t)f2bf(v3 * rs * gg.w + bb.w);
                        }
                        {
                            const int h = lane >> 4, i = lane & 15; const f32x2 cs = rcs[k];
                            if (!kvonly) { const float q1 = bf2f(q1w[k]), q2 = bf2f(q2w[k]);
                                RQ[(size_t)n * 128 + h * 32 + i] = (q1 * cs.x - q2 * cs.y) * RET_QSCALE; RQ[(size_t)n * 128 + h * 32 + 16 + i] = (q2 * cs.x + q1 * cs.y) * RET_QSCALE; }
                            const float k1 = bf2f(k1w[k]), k2 = bf2f(k2w[k]);
                            const float ka = k1 * cs.x - k2 * cs.y, kb = k2 * cs.x + k1 * cs.y;
                            RK[(size_t)n * 128 + h * 32 + i] = ka; RK[(size_t)n * 128 + h * 32 + 16 + i] = kb;
                            ksr[tl * 128 + h * 32 + i] = ka; ksr[tl * 128 + h * 32 + 16 + i] = kb;
                        }
                    }
                }
                __syncthreads();
                {
                    const int h = wave >> 1, dir = wave & 1, hi = lane >> 5, il = lane & 31;
                    const float logit = a.in[dir ? I_RDB : I_RDF][l * 4 + h];
                    const float lg2 = log2f(1.f / (1.f + expf(-logit)));
                    f32x16 acc0 = {}, acc1 = {};
                    const bf16_t* vp = PROJ + (size_t)n0 * PROJW + C_RV + h * 64 + 2 * il;
                    for (int sb = 0; sb < 4; ++sb) {
                        unsigned bw[16];
#pragma unroll
                        for (int s = 0; s < 16; ++s) { const int tok = 2 * (sb * 16 + s) + hi; bw[s] = *(const unsigned*)(vp + (size_t)tok * PROJW); }
#pragma unroll
                        for (int s = 0; s < 16; ++s) { const int tok = 2 * (sb * 16 + s) + hi;
                            const float fac = __builtin_amdgcn_exp2f(lg2 * (float)(dir ? tok : 127 - tok));
                            const float av = ksr[tok * 128 + h * 32 + il] * fac;
                            acc0 = __builtin_amdgcn_mfma_f32_32x32x2f32(av, bflo(bw[s]), acc0, 0, 0, 0);
                            acc1 = __builtin_amdgcn_mfma_f32_32x32x2f32(av, bfhi(bw[s]), acc1, 0, 0, 0); }
                    }
                    float* so = SLOC + ((size_t)(T * 2 + dir) * 4 + h) * 2048 + 2 * il;
#pragma unroll
                    for (int r = 0; r < 16; ++r) { const int d = (r & 3) + 8 * (r >> 2) + 4 * hi; *(f32x2*)(so + d * 64) = (f32x2){acc0[r], acc1[r]}; }
                }
                if (!kvonly) {
                    const int g = wave >> 1, mh = wave & 1, hi = lane >> 5, il = lane & 31, c0 = g * 64 + 2 * il;
                    bf16x8 bfr[2][8];
#pragma unroll
                    for (int e = 0; e < 2; ++e)
#pragma unroll
                        for (int kk = 0; kk < 8; ++kk) bfr[e][kk] = *(const LAS bf16x8*)(vsT + (c0 + e) * VST + kk * 16 + hi * 8);
                    const bf16_t* wg = SGWB + ((size_t)(l * 4 + g) * 128) * 128;
                    for (int mt = 2 * mh; mt < 2 * mh + 2; ++mt) {
                        f32x16 acc0 = {}, acc1 = {};
                        const bf16_t* wr = wg + (size_t)(mt * 32 + il) * 128 + hi * 8;
                        bf16x8 af_[8];
#pragma unroll
                        for (int kk = 0; kk < 8; ++kk) af_[kk] = *(const bf16x8*)(wr + kk * 16);
                        __builtin_amdgcn_sched_barrier(0);
#pragma unroll
                        for (int kk = 0; kk < 8; ++kk) { acc0 = __builtin_amdgcn_mfma_f32_32x32x16_bf16(af_[kk], bfr[0][kk], acc0, 0, 0, 0); acc1 = __builtin_amdgcn_mfma_f32_32x32x16_bf16(af_[kk], bfr[1][kk], acc1, 0, 0, 0); }
#pragma unroll
                        for (int rb = 0; rb < 16; rb += 8) {
                            unsigned uw_[8];
#pragma unroll
                            for (int r8 = 0; r8 < 8; ++r8) { const int r = rb + r8; const int p = mt * 32 + (r & 3) + 8 * (r >> 2) + 4 * hi; uw_[r8] = *(const unsigned*)(PROJ + (size_t)(n0 + p) * PROJW + C_SGU + c0); }
#pragma unroll
                            for (int r8 = 0; r8 < 8; ++r8) { const int r = rb + r8; const int p = mt * 32 + (r & 3) + 8 * (r >> 2) + 4 * hi; const float sbp = sb[g * 128 + p];
                                *(unsigned*)(MIX + (size_t)(n0 + p) * DM + 512 + c0) = pk2(gelu1(bflo(uw_[r8])) * (acc0[r] + sbp), gelu1(bfhi(uw_[r8])) * (acc1[r] + sbp)); }
                        }
                    }
                }
            }
            __syncthreads();
            if (l + 1 < NLAYER && vcu >= 8) {
                LAS float* scr = (LAS float*)(lds + wave * 16384);
                for (int it = (vcu - 8) * 8 + wave; it < IT_LAYER / 2; it += (G - 8) * 8) CONVERT_ITEM(l + 1, it);
            }
            __syncthreads();
        }
        SEAM(pb + 1);
        for (int rep_ = 0; rep_ < REPS(2); ++rep_) if (EN(2) && IN(pb + 2)) { PH_IDS();
            if (tid < 256) {
                for (int E = bx * 256 + tid; E < 65536; E += G * 256) {
                    const int v = E & 63, d = (E >> 6) & 31, h = (E >> 11) & 3, dir = (E >> 13) & 1, b = E >> 14;
                    const float logit = a.in[dir ? I_RDB : I_RDF][l * 4 + h];
                    const float g128 = __builtin_amdgcn_exp2f(128.f * log2f(1.f / (1.f + expf(-logit))));
                    float S = 0.f;
                    float xs_[66];
#pragma unroll
                    for (int c = 0; c < 66; ++c) {
                        int T;
                        if (dir == 0) T = (c < 2) ? b * 2 + c : 8 + b * 64 + (c - 2);
                        else T = (c < 2) ? b * 2 + (1 - c) : 8 + b * 64 + (63 - (c - 2));
                        xs_[c] = SLOC[((size_t)(T * 2 + dir) * 4 + h) * 2048 + d * 64 + v];
                    }
#pragma unroll
                    for (int c = 0; c < 66; ++c) {
                        int T;
                        if (dir == 0) T = (c < 2) ? b * 2 + c : 8 + b * 64 + (c - 2);
                        else T = (c < 2) ? b * 2 + (1 - c) : 8 + b * 64 + (63 - (c - 2));
                        SIN[((size_t)(T * 2 + dir) * 4 + h) * 2048 + d * 64 + v] = S; S = g128 * S + xs_[c];
                    }
                }
            }
            {
                pg8::Gemm g{CQN, WUQ + (size_t)l * 768 * 384, 384, 384, nullptr, 0, 0};
                pg8::StaticOrder S; S.init(NTOK / 256, 3, G, bx);
                pg8::EpiBf16 E{QB, 768};
                pg8::gemm_phase<pg8::EpiBf16, pg8::StaticOrder, false>(lds, g, S, E, wave_s);
            }
            {
                pg8::Gemm g{CKVN, WUKV + (size_t)l * 1024 * 256, 256, 256, nullptr, 0, 0};
                const int rot1 = (G * 9 / 16) & ~7;
                pg8::StaticOrder S; S.init(NTOK / 256, 2, G, (bx + G - rot1) % G);
                pg8::EpiK E{KB};
                pg8::gemm_phase<pg8::EpiK, pg8::StaticOrder, false>(lds, g, S, E, wave_s);
            }
            {
                pg8::Gemm g{WUKV + (size_t)l * 1024 * 256 + 512 * 256, CKVN, 256, 256, nullptr, 0, 0};
                const int rot2 = ((G * 9 / 16) & ~7) + 8;
                pg8::StaticOrder S; S.init(2, NTOK / 256, G, (bx + G - rot2) % G);
                pg8::EpiVT E{VT8};
                pg8::gemm_phase<pg8::EpiVT, pg8::StaticOrder, false>(lds, g, S, E, wave_s);
            }
        }
        SEAM(pb + 2);
#define ECTX_PUBLISH(rt_) do { asm volatile("s_waitcnt vmcnt(0)" ::: "memory"); __syncthreads(); \
        if (tid == 0) { __builtin_amdgcn_fence(__ATOMIC_RELEASE, "agent"); asm volatile("s_waitcnt vmcnt(0)" ::: "memory"); __hip_atomic_fetch_add(ctl + CW_ECTX + (l * 4 + (rt_)) * 64, 1u, RLX_AGENT); } } while (0)
        for (int rep_ = 0; rep_ < REPS(3); ++rep_) if (EN(3) && IN(pb + 3)) { PH_IDS();
            for (int rnd = 0; rnd < 3; ++rnd) {
                int b, h, qrow0, seq, t0;
                if (rnd < 2) { const int u = rnd * G + vcu; if (u >= 512) continue; const int bh = u >> 5, qb = u & 31; b = bh >> 2; h = bh & 3; qrow0 = NCTX + b * SEQ + qb * 256; seq = KEYS; t0 = qb * 256; }
                else { const int k = vcu - 16; if (k < 0 || k >= 16 || l == NLAYER - 1) continue; b = k >> 2; h = k & 3; qrow0 = b * CTXL; seq = CTXL; t0 = -1; }
                att::attn_unit(QB + ((size_t)qrow0 * 768 + h * 192), KB + h * 192, VT8 + (size_t)((b * 4 + h) * (KEYS / 64)) * VT_TILE, MIX + ((size_t)qrow0 * DM + h * 128), seq, b * CTXL, NCTX + b * SEQ, t0, ATAB, (char*)lds_raw, wave_s);
                if (rnd == 2) ECTX_PUBLISH(b);
            }
            {
                LAS float* qs = (LAS float*)lds;
                LAS float* ks = (LAS float*)(lds + 33792);
                LAS bf16_t* vs = (LAS bf16_t*)(lds + 67584);
                const int hl = wave >> 2, dir = (wave >> 1) & 1, half = wave & 1, hi = lane >> 5, il = lane & 31;
                for (int T = vcu; T < NTOK / 128; T += G) {
                    if (l == NLAYER - 1 && T < NCTX / 128) continue;
                    const int n0 = T * 128;
                    for (int pass = 0; pass < 2; ++pass) {
                        const int h = pass * 2 + hl;
                        __syncthreads();
                        {
                            f32x4 qv_[4], kv_[4]; u32x4 vv_[4];
#pragma unroll
                            for (int u_ = 0; u_ < 4; ++u_) { const int i = tid + 512 * u_; const int tok = i >> 4, part = i & 15;
                                qv_[u_] = *(const f32x4*)(RQ + (size_t)(n0 + tok) * 128 + pass * 64 + part * 4); kv_[u_] = *(const f32x4*)(RK + (size_t)(n0 + tok) * 128 + pass * 64 + part * 4);
                                vv_[u_] = *(const u32x4*)(PROJ + (size_t)(n0 + tok) * PROJW + C_RV + pass * 128 + part * 8); }
#pragma unroll
                            for (int u_ = 0; u_ < 4; ++u_) { const int i = tid + 512 * u_; const int tok = i >> 4, part = i & 15, hh = part >> 3, d0 = (part & 7) * 4;
                                const f32x4 qv = qv_[u_], kv = kv_[u_];
                                LAS float* qd = qs + (hh * 128 + tok) * 33 + d0; LAS float* kd = ks + (hh * 128 + tok) * 33 + d0;
                                qd[0] = qv.x; qd[1] = qv.y; qd[2] = qv.z; qd[3] = qv.w; kd[0] = kv.x; kd[1] = kv.y; kd[2] = kv.z; kd[3] = kv.w;
                                *(LAS u32x4*)(vs + tok * 128 + part * 8) = vv_[u_]; }
                        }
                        __syncthreads();
                        const float logit = a.in[dir ? I_RDB : I_RDF][l * 4 + h];
                        const float lg2 = log2f(1.f / (1.f + expf(-logit)));
                        float sinv0[16], sinv1[16];
                        { const float* sp = SIN + ((size_t)(T * 2 + dir) * 4 + h) * 2048 + il;
#pragma unroll
                          for (int s = 0; s < 16; ++s) { sinv0[s] = sp[(2 * s + hi) * 64]; sinv1[s] = sp[(2 * s + hi) * 64 + 32]; } }
                        float* OUT = dir ? OB : OF;
                        for (int ii = 0; ii < 2; ++ii) {
                            const int I = half ? (ii ? 2 : 1) : (ii ? 3 : 0);
                            const int ipos = 32 * I + il, itok = dir ? 127 - ipos : ipos;
                            const LAS float* qrow = qs + (hl * 128 + itok) * 33 + hi;
                            f32x16 acc0 = {}, acc1 = {};
#pragma unroll
                            for (int s = 0; s < 16; ++s) { const float bq = qrow[2 * s];
                                acc0 = __builtin_amdgcn_mfma_f32_32x32x2f32(sinv0[s], bq, acc0, 0, 0, 0);
                                acc1 = __builtin_amdgcn_mfma_f32_32x32x2f32(sinv1[s], bq, acc1, 0, 0, 0); }
                            { const float cf = __builtin_amdgcn_exp2f(lg2 * (float)(ipos + 1));
#pragma unroll
                              for (int r = 0; r < 16; ++r) { acc0[r] *= cf; acc1[r] *= cf; } }
                            for (int J = 0; J <= I; ++J) {
                                const int jposA = 32 * J + il, jtokA = dir ? 127 - jposA : jposA;
                                const LAS float* krow = ks + (hl * 128 + jtokA) * 33 + hi;
                                f32x16 pt = {};
#pragma unroll
                                for (int s = 0; s < 16; ++s) pt = __builtin_amdgcn_mfma_f32_32x32x2f32(krow[2 * s], qrow[2 * s], pt, 0, 0, 0);
#pragma unroll
                                for (int r = 0; r < 16; ++r) { const int jl = (r & 3) + 8 * (r >> 2) + 4 * hi;
                                    const bool keep = (J < I) || (dir ? (il > jl) : (il >= jl));
                                    const float fac = __builtin_amdgcn_exp2f(lg2 * (float)(32 * (I - J) + il - jl));
                                    pt[r] = keep ? pt[r] * fac : 0.f; }
#pragma unroll
                                for (int r = 0; r < 16; ++r) { const int jpos = 32 * J + (r & 3) + 8 * (r >> 2) + 4 * hi, jtok = dir ? 127 - jpos : jpos;
                                    const float a0 = bf2f(vs[jtok * 128 + hl * 64 + il]), a1 = bf2f(vs[jtok * 128 + hl * 64 + 32 + il]);
                                    acc0 = __builtin_amdgcn_mfma_f32_32x32x2f32(a0, pt[r], acc0, 0, 0, 0);
                                    acc1 = __builtin_amdgcn_mfma_f32_32x32x2f32(a1, pt[r], acc1, 0, 0, 0); }
                            }
                            float* op = OUT + (size_t)(n0 + itok) * 256 + h * 64;
#pragma unroll
                            for (int rq = 0; rq < 4; ++rq) {
                                *(f32x4*)(op + 8 * rq + 4 * hi) = (f32x4){acc0[4 * rq], acc0[4 * rq + 1], acc0[4 * rq + 2], acc0[4 * rq + 3]};
                                *(f32x4*)(op + 32 + 8 * rq + 4 * hi) = (f32x4){acc1[4 * rq], acc1[4 * rq + 1], acc1[4 * rq + 2], acc1[4 * rq + 3]}; }
                        }
                    }
                    asm volatile("s_waitcnt vmcnt(0)" ::: "memory");
                    __syncthreads();
                    for (int ib = 0; ib < 2; ++ib) {
                        f32x4 fF[8], fB[8]; u32x2 gW[8];
#pragma unroll
                        for (int it = 0; it < 8; ++it) { const int n = n0 + wave * 16 + ib * 8 + it;
                            fF[it] = *((const f32x4*)(OF + (size_t)n * 256) + lane); fB[it] = *((const f32x4*)(OB + (size_t)n * 256) + lane); gW[it] = *(const u32x2*)(PROJ + (size_t)n * PROJW + C_RG + lane * 4); }
#pragma unroll
                        for (int it = 0; it < 8; ++it) { const int n = n0 + wave * 16 + ib * 8 + it;
                            float v0 = fF[it].x + fB[it].x, v1 = fF[it].y + fB[it].y, v2 = fF[it].z + fB[it].z, v3 = fF[it].w + fB[it].w;
                            float s = v0 + v1 + v2 + v3; s += dpp_f<0xB1>(s); s += dpp_f<0x4E>(s); s += dpp_f<0x141>(s); s += dpp_f<0x140>(s);
                            const float mean = s * (1.f / 64.f); v0 -= mean; v1 -= mean; v2 -= mean; v3 -= mean;
                            float q = v0 * v0 + v1 * v1 + v2 * v2 + v3 * v3; q += dpp_f<0xB1>(q); q += dpp_f<0x4E>(q); q += dpp_f<0x141>(q); q += dpp_f<0x140>(q);
                            const float rs = rsqrtf(q * (1.f / 64.f) + LN_EPS);
                            const float g0 = bflo(gW[it].x), g1 = bfhi(gW[it].x), g2 = bflo(gW[it].y), g3 = bfhi(gW[it].y);
                            u32x2 o; o.x = pk2(v0 * rs * g0 * sigmoidf_(g0), v1 * rs * g1 * sigmoidf_(g1)); o.y = pk2(v2 * rs * g2 * sigmoidf_(g2), v3 * rs * g3 * sigmoidf_(g3));
                            *(u32x2*)(MIX + (size_t)n * DM + 768 + lane * 4) = o; }
                    }
                    if (T < NCTX / 128 && l + 1 < NLAYER) ECTX_PUBLISH(T >> 1);
                }
                __syncthreads();
            }
            if (l + 1 < NLAYER && vcu >= 16 && vcu < 32) {
                const int rt = (vcu - 16) >> 2, ct = (vcu - 16) & 3;
                if (tid == 0) { unsigned spins = 0; while (__hip_atomic_load(ctl + CW_ECTX + (l * 4 + rt) * 64, RLX_AGENT) < 6u && ++spins < (1u << 22)) __builtin_amdgcn_s_sleep(2);
                    __builtin_amdgcn_fence(__ATOMIC_ACQUIRE, "agent"); }
                asm volatile("s_waitcnt vmcnt(0)" ::: "memory"); __syncthreads();
                pg8::Gemm g{MIX, WOT + (size_t)l * 1024 * 1024, 1024, 1024, nullptr, 0, 0};
                pg8::OneUnit S1{rt, ct};
                pg8::EpiBf16 E1{YB, DM};
                pg8::gemm_phase<pg8::EpiBf16, pg8::OneUnit, false>(lds, g, S1, E1, wave_s);
            }
            if (l + 1 < NLAYER && vcu >= 32) {
                LAS float* scr = (LAS float*)(lds + wave * 16384);
                for (int it = IT_LAYER / 2 + (vcu - 32) * 8 + wave; it < IT_LAYER; it += (G - 32) * 8) CONVERT_ITEM(l + 1, it);
                __syncthreads();
            }
        }
        SEAM(pb + 3);
        for (int rep_ = 0; rep_ < REPS(4); ++rep_) if (EN(4) && IN(pb + 4)) { PH_IDS();
            const int skipr = NCTX;
            pg8::Gemm g{MIX + (size_t)skipr * DM, WOT + (size_t)l * 1024 * 1024, 1024, 1024, nullptr, 0, 0};
            pg8::StaticOrder S; S.init((NTOK - skipr) / 256, 4, G, bx);
            pg8::EpiBf16 E{YB + (size_t)skipr * DM, DM};
            pg8::gemm_phase<pg8::EpiBf16, pg8::StaticOrder, false>(lds, g, S, E, wave_s);
        }
        SEAM(pb + 4);
        if (EN(5) && IN(pb + 5)) { PH_IDS();
            LAS f32x4* rwl4 = (LAS f32x4*)lds;
            LAS unsigned* cnt = (LAS unsigned*)(lds + RING_BYTES);
            { const f32x4* src = (const f32x4*)(a.in[I_RW] + (size_t)l * 1024 * 32);
              f32x4 wv_[16];
#pragma unroll
              for (int u_ = 0; u_ < 16; ++u_) wv_[u_] = src[tid + 512 * u_];
#pragma unroll
              for (int u_ = 0; u_ < 16; ++u_) { const int i = tid + 512 * u_; const int d = i >> 3, cq = i & 7; const int rho = ((d & 3) * 4 + (d >> 8)) * 64 + ((d >> 2) & 63); rwl4[rho * 8 + (cq ^ (rho & 7))] = wv_[u_]; } }
            if (tid < 32) cnt[tid] = 0u;
            __syncthreads();
            const float* ln1g = a.in[I_LN1G] + l * DM; const float* ln1b = a.in[I_LN1B] + l * DM; const float* rb = a.in[I_RB] + l * 32;
            const int per = ((NTOK + G - 1) / G + 1) & ~1; const int n0 = bx * per, n1 = (n0 + per < NTOK) ? n0 + per : NTOK;
            const int myE = ((lane >> 5) & 1) * 16 + ((lane >> 4) & 1) * 8 + ((lane >> 3) & 1) * 4 + ((lane >> 2) & 1) * 2 + ((lane >> 1) & 1);
            const float myRb = rb[myE];
            f32x4 xB[2][4] = {}; u32x2 yB[2][4] = {};
            const int npair = (n1 - n0) >> 1;
            if (wave < npair) {
#pragma unroll
                for (int t = 0; t < 2; ++t)
#pragma unroll
                    for (int j = 0; j < 4; ++j) { XLOAD(xB[t][j], l, n0 + 2 * wave + t, j); yB[t][j] = *((const u32x2*)(YB + (size_t)(n0 + 2 * wave + t) * DM) + lane + 64 * j); } }
            for (int p = wave; p < npair; p += 8) {
                const int nb = n0 + 2 * p;
                f32x4 v[2][4];
                const float* md = MODL + (size_t)modset(nb) * 6144;
                float sm[2];
                {
                    f32x4 g1v[4];
#pragma unroll
                    for (int j = 0; j < 4; ++j) g1v[j] = *((const f32x4*)(md + 2048) + lane + 64 * j);
#pragma unroll
                    for (int t = 0; t < 2; ++t) { float s = 0.f;
#pragma unroll
                        for (int j = 0; j < 4; ++j) { const f32x4 yv = (f32x4){bflo(yB[t][j].x), bfhi(yB[t][j].x), bflo(yB[t][j].y), bfhi(yB[t][j].y)}; v[t][j] = XVAL(xB[t][j], l) * DN_ALPHA + g1v[j] * yv; s += (v[t][j].x + v[t][j].y) + (v[t][j].z + v[t][j].w); }
                        sm[t] = s; }
                }
                __builtin_amdgcn_sched_barrier(0);
                f32x4 pg[4], pb_[4], psh[4], psc[4];
#pragma unroll
                for (int j = 0; j < 4; ++j) { pg[j] = *((const f32x4*)ln1g + lane + 64 * j); pb_[j] = *((const f32x4*)ln1b + lane + 64 * j); psh[j] = *((const f32x4*)(md + 3072) + lane + 64 * j); psc[j] = *((const f32x4*)(md + 4096) + lane + 64 * j); }
                float rstd[2];
                { const float mean0 = wave_sum(sm[0]) * (1.f / DM), mean1 = wave_sum(sm[1]) * (1.f / DM); float q0 = 0.f, q1 = 0.f;
#pragma unroll
                  for (int j = 0; j < 4; ++j) { v[0][j] = v[0][j] - mean0; q0 += (v[0][j].x * v[0][j].x + v[0][j].y * v[0][j].y) + (v[0][j].z * v[0][j].z + v[0][j].w * v[0][j].w);
                      v[1][j] = v[1][j] - mean1; q1 += (v[1][j].x * v[1][j].x + v[1][j].y * v[1][j].y) + (v[1][j].z * v[1][j].z + v[1][j].w * v[1][j].w); }
                  rstd[0] = rsqrtf(wave_sum(q0) * (1.f / DM) + LN_EPS); rstd[1] = rsqrtf(wave_sum(q1) * (1.f / DM) + LN_EPS); }
                __builtin_amdgcn_sched_barrier(0);
#pragma unroll
                for (int j = 0; j < 4; ++j)
#pragma unroll
                    for (int t = 0; t < 2; ++t) { const int n = nb + t;
                        v[t][j] = v[t][j] * rstd[t] * pg[j] + pb_[j]; { u32x2 xw_; xw_.x = pk2(v[t][j].x, v[t][j].y); xw_.y = pk2(v[t][j].z, v[t][j].w); *((u32x2*)(XRB + (size_t)n * DM) + lane + 64 * j) = xw_; }
                        v[t][j] = v[t][j] * (psc[j] + 1.f) + psh[j];
                        *((unsigned*)(XH8 + (size_t)n * DM) + lane + 64 * j) = pk4_fp8(v[t][j].x * ACT_Q, v[t][j].y * ACT_Q, v[t][j].z * ACT_Q, v[t][j].w * ACT_Q); }
                __builtin_amdgcn_sched_barrier(0);
                if (p + 8 < npair) {
#pragma unroll
                    for (int j = 0; j < 4; ++j) { XLOAD(xB[0][j], l, nb + 16, j); yB[0][j] = *((const u32x2*)(YB + (size_t)(nb + 16) * DM) + lane + 64 * j); } }
                __builtin_amdgcn_sched_barrier(0);
                f32x4 ac[2][8];
#pragma unroll
                for (int t = 0; t < 2; ++t)
#pragma unroll
                    for (int q = 0; q < 8; ++q) ac[t][q] = (f32x4){0.f, 0.f, 0.f, 0.f};
                int lq_ = lane; asm volatile("" : "+v"(lq_));
#pragma unroll
                for (int j = 0; j < 4; ++j)
#pragma unroll
                    for (int i = 0; i < 4; ++i) { __builtin_amdgcn_sched_barrier(0); const float hv0 = v[0][j][i], hv1 = v[1][j][i]; const LAS f32x4* rp = rwl4 + ((i * 4 + j) * 64 + lq_) * 8;
#pragma unroll
                        for (int q = 0; q < 8; ++q) { const f32x4 w = rp[q ^ (lq_ & 7)]; ac[0][q] += w * hv0; ac[1][q] += w * hv1; }
#pragma unroll
                        for (int t = 0; t < 2; ++t)
                            asm volatile("" : "+v"(ac[t][0]), "+v"(ac[t][1]), "+v"(ac[t][2]), "+v"(ac[t][3]), "+v"(ac[t][4]), "+v"(ac[t][5]), "+v"(ac[t][6]), "+v"(ac[t][7])); }
                __builtin_amdgcn_sched_barrier(0);
                if (p + 8 < npair) {
#pragma unroll
                    for (int j = 0; j < 4; ++j) { XLOAD(xB[1][j], l, nb + 17, j); yB[1][j] = *((const u32x2*)(YB + (size_t)(nb + 17) * DM) + lane + 64 * j); } }
                __builtin_amdgcn_sched_barrier(0);
                float tv[2][4]; int ti[2][4];
#pragma unroll
                for (int t = 0; t < 2; ++t) {
                    float r16[16], r8[8], r4[4], r2[2], val;
                    { const bool up = (lane & 32) != 0;
#pragma unroll
                      for (int k = 0; k < 16; ++k) { const float lo_ = ac[t][k >> 2][k & 3], hi_ = ac[t][(k + 16) >> 2][k & 3]; r16[k] = (up ? hi_ : lo_) + __shfl_xor(up ? lo_ : hi_, 32); } }
                    { const bool up = (lane & 16) != 0;
#pragma unroll
                      for (int k = 0; k < 8; ++k) r8[k] = (up ? r16[k + 8] : r16[k]) + __shfl_xor(up ? r16[k] : r16[k + 8], 16); }
                    { const bool up = (lane & 8) != 0;
#pragma unroll
                      for (int k = 0; k < 4; ++k) r4[k] = (up ? r8[k + 4] : r8[k]) + dpp_f<0x128>(up ? r8[k] : r8[k + 4]); }
                    { const bool up = (lane & 4) != 0;
#pragma unroll
                      for (int k = 0; k < 2; ++k) r2[k] = (up ? r4[k + 2] : r4[k]) + dpp_f<0x1B>(dpp_f<0x141>(up ? r4[k] : r4[k + 2])); }
                    { const bool up = (lane & 2) != 0; val = (up ? r2[1] : r2[0]) + dpp_f<0x4E>(up ? r2[0] : r2[1]); }
                    val += dpp_f<0xB1>(val);
                    val += myRb;
#pragma unroll
                    for (int k = 0; k < 4; ++k) {
                        float bv = val; int bi = myE;
#pragma unroll
                        for (int o = 32; o >= 16; o >>= 1) { const float ov = __shfl_xor(bv, o); const int oi = __shfl_xor(bi, o); if (ov > bv || (ov == bv && oi < bi)) { bv = ov; bi = oi; } }
#define AMX_STEP(C_) { const float ov = dpp_f<C_>(bv); const int oi = dpp_i<C_>(bi); if (ov > bv || (ov == bv && oi < bi)) { bv = ov; bi = oi; } }
                        AMX_STEP(0x140) AMX_STEP(0x141) AMX_STEP(0x4E) AMX_STEP(0xB1)
#undef AMX_STEP
                        tv[t][k] = bv; ti[t][k] = bi; if (myE == bi) val = -3.0e38f;
                    }
                }
#pragma unroll
                for (int t = 0; t < 2; ++t) {
                    const int n = nb + t;
                    const bool routed = !(l == NLAYER - 1 && n < NCTX);
                    const float e1 = __expf(tv[t][1] - tv[t][0]), e2 = __expf(tv[t][2] - tv[t][0]), e3 = __expf(tv[t][3] - tv[t][0]);
                    const float inv = 1.f / (1.f + e1 + e2 + e3);
                    if (lane < 4) {
                        const int ee = lane == 0 ? ti[t][0] : lane == 1 ? ti[t][1] : lane == 2 ? ti[t][2] : ti[t][3];
                        const float gg = (lane == 0 ? 1.f : lane == 1 ? e1 : lane == 2 ? e2 : e3) * inv;
                        TOPI[n * 4 + lane] = routed ? ee : -1; GATE[n * 4 + lane] = gg;
                        if (routed) __hip_atomic_fetch_add(&cnt[ee], 1u, __ATOMIC_RELAXED, __HIP_MEMORY_SCOPE_WORKGROUP);
                    }
                }
                __builtin_amdgcn_sched_barrier(0);
            }
            __syncthreads();
            if (tid < 32) __hip_atomic_store(ctl + CW_BLKCNT + bx * 32 + tid, cnt[tid], RLX_AGENT);
            __syncthreads();
        }
        SEAM(pb + 5);
        for (int rep_ = 0; rep_ < REPS(6); ++rep_) if (EN(6) && IN(pb + 6)) { PH_IDS();
            LAS int* bc = (LAS int*)lds;
            LAS int* part = (LAS int*)(lds + 65536);
            LAS int* tot = part + 1024; LAS int* base = tot + 32; LAS int* seg = base + 32; LAS int* tiv = seg + 40;
            { unsigned cv_[16];
#pragma unroll
              for (int u_ = 0; u_ < 16; ++u_) { const int i = tid + 512 * u_; cv_[u_] = (i < G * 32) ? ctl[CW_BLKCNT + i] : 0u; }
#pragma unroll
              for (int u_ = 0; u_ < 16; ++u_) { const int i = tid + 512 * u_; if (i < G * 32) bc[i] = (int)cv_[u_]; }
              for (int i = tid + 8192; i < G * 32; i += 512) bc[i] = (int)ctl[CW_BLKCNT + i]; }
            const int per = ((NTOK + G - 1) / G + 1) & ~1; const int n0 = bx * per, n1 = (n0 + per < NTOK) ? n0 + per : NTOK; const int na = (n1 - n0) * 4;
            { const int i0 = tid, i1 = tid + 512; const int t0_ = (i0 < na) ? TOPI[n0 * 4 + i0] : 0, t1_ = (i1 < na) ? TOPI[n0 * 4 + i1] : 0;
              if (i0 < na) tiv[i0] = t0_; if (i1 < na) tiv[i1] = t1_;
              for (int i = tid + 1024; i < na; i += 512) tiv[i] = TOPI[n0 * 4 + i]; }
            __syncthreads();
            { const int e = tid & 31, pt = tid >> 5; const int bpp = (G + 15) / 16; int t = 0, bs = 0;
              for (int b = pt * bpp; b < (pt + 1) * bpp && b < G; ++b) { const int c = bc[b * 32 + e]; t += c; if (b < bx) bs += c; }
              part[pt * 32 + e] = t; part[512 + pt * 32 + e] = bs; }
            __syncthreads();
            if (tid < 32) { int t = 0, bs = 0;
#pragma unroll
              for (int p = 0; p < 16; ++p) { t += part[p * 32 + tid]; bs += part[512 + p * 32 + tid]; }
              tot[tid] = t; base[tid] = bs; }
            __syncthreads();
            if (tid == 0) { int off = 0; for (int e = 0; e < 32; ++e) { seg[e] = off; off += (tot[e] + 255) & ~255; } seg[32] = off; }
            __syncthreads();
            if (bx == 0) {
                const int ntl = seg[32] >> 8;
                if (tid == 0) __hip_atomic_store(ctl + CW_NT, (unsigned)ntl, RLX_AGENT);
                for (int t = tid; t < ntl; t += 512) { int e = 0; for (int k = 0; k < 32; ++k) if (seg[k] <= t * 256) e = k; __hip_atomic_store(ctl + CW_TILE_E + t, (unsigned)e, RLX_AGENT); }
            }
            for (int e = wave; e < 32; e += 8) {
                if ((e % G) == bx) for (int r = seg[e] + tot[e] + lane; r < seg[e + 1]; r += 64) ROWTOK[r] = 0;
            }
            {
                LAS int* ribs = tiv + per * 4;
                LAS int* cb = ribs + per * 4;
                const int nblk = (na + 63) >> 6;
                for (int blk = wave; blk < nblk; blk += 8) { const int i = blk * 64 + lane; const int ev = (i < na) ? tiv[i] : -1; int rib = 0, cnt = 0;
#pragma unroll 1
                    for (int e = 0; e < 32; ++e) { const unsigned long long m = __ballot(ev == e); if (ev == e) rib = __popcll(m & ((1ull << lane) - 1ull)); if (lane == e) cnt = __popcll(m); }
                    if (lane < 32) cb[blk * 32 + lane] = cnt;
                    if (i < na) ribs[i] = rib; }
                __syncthreads();
                for (int i = tid; i < na; i += 512) { const int e = tiv[i];
                    if (e >= 0) { const int blk = i >> 6; int rk = ribs[i]; for (int b2 = 0; b2 < blk; ++b2) rk += cb[b2 * 32 + e];
                        const int pos = seg[e] + base[e] + rk; DEST[n0 * 4 + i] = pos; ROWTOK[pos] = n0 + (i >> 2); } }
            }
            __syncthreads();
        }
        SEAM(pb + 6);
        for (int rep_ = 0; rep_ < REPS(7); ++rep_) if (EN(7) && IN(pb + 7)) { PH_IDS();
            const int ntl = __builtin_amdgcn_readfirstlane(ld_ctl(ctl + CW_NT));
            LAS unsigned char* te = (LAS unsigned char*)(lds + RING_BYTES);
            LAS unsigned short* rows = (LAS unsigned short*)(lds + RING_BYTES + 1024);
            pg8::MoeOrder S; S.so.init(ntl, 8, G, bx); S.tile_e = te;
            {
                const unsigned e0_ = (tid < ntl) ? ctl[CW_TILE_E + tid] : 0u, e1_ = (tid + 512 < ntl) ? ctl[CW_TILE_E + tid + 512] : 0u;
                int rv_[18];
#pragma unroll
                for (int i = 0; i < 18; ++i) { pg8::Unit u; const bool ok = S.so.next(i, u); rv_[i] = (ok && tid < 256) ? ROWTOK[u.pm * 256 + tid] : 0; }
                if (tid < ntl) te[tid] = (unsigned char)e0_; if (tid + 512 < ntl) te[tid + 512] = (unsigned char)e1_;
                for (int t = tid + 1024; t < ntl; t += 512) te[t] = (unsigned char)ctl[CW_TILE_E + t];
#pragma unroll
                for (int i = 0; i < 18; ++i) if (tid < 256) rows[i * 256 + tid] = (unsigned short)rv_[i];
            }
            __syncthreads();
            pg8::Gemm g{XH8, WGU + (size_t)l * 32 * 2048 * 1024, 1024, 1024, rows, ACT_E, WGU_E};
            pg8::EpiSwiglu E{ACT, a.in[I_BGU] + (size_t)l * 32 * 2048};
            pg8::gemm_phase<pg8::EpiSwiglu, pg8::MoeOrder, true, true>(lds, g, S, E, wave_s);
        }
        SEAM(pb + 7);
        for (int rep_ = 0; rep_ < REPS(8); ++rep_) if (EN(8) && IN(pb + 8)) { PH_IDS();
            const int ntl = __builtin_amdgcn_readfirstlane(ld_ctl(ctl + CW_NT));
            LAS unsigned char* te = (LAS unsigned char*)(lds + RING_BYTES);
            { const unsigned e0_ = (tid < ntl) ? ctl[CW_TILE_E + tid] : 0u, e1_ = (tid + 512 < ntl) ? ctl[CW_TILE_E + tid + 512] : 0u;
              if (tid < ntl) te[tid] = (unsigned char)e0_; if (tid + 512 < ntl) te[tid + 512] = (unsigned char)e1_;
              for (int t = tid + 1024; t < ntl; t += 512) te[t] = (unsigned char)ctl[CW_TILE_E + t]; }
            __syncthreads();
            pg8::Gemm g{ACT, WDN + (size_t)l * 32 * 1024 * 1024, 1024, 1024, nullptr, ACT_E, WDN_E};
            pg8::MoeOrder S; S.so.init(ntl, 4, G, bx); S.tile_e = te;
            pg8::EpiDown E{DOUT, a.in[I_BDN] + (size_t)l * 32 * 1024};
            pg8::gemm_phase<pg8::EpiDown, pg8::MoeOrder, false, true>(lds, g, S, E, wave_s);
        }
        SEAM(pb + 8);
        if (EN(9) && IN(pb + 9)) { PH_IDS();
            const float* ln2g = a.in[I_LN2G] + l * DM; const float* ln2b = a.in[I_LN2B] + l * DM;
            const bool lastl = (l == NLAYER - 1);
            const int nbeg = lastl ? NCTX : 0;
            int dA[2][4] = {}; float gA[2][4] = {};
            unsigned rB[2][4][4] = {}; u32x2 xB[2][4] = {}; float gB[2][4] = {};
            const int PSTEP = 2 * NGW;
            const int nA = nbeg + 2 * gw;
            if (nA < NTOK) {
#pragma unroll
                for (int t = 0; t < 2; ++t)
#pragma unroll
                    for (int k = 0; k < 4; ++k) { dA[t][k] = DEST[(nA + t) * 4 + k]; gA[t][k] = GATE[(nA + t) * 4 + k]; }
#pragma unroll
                for (int t = 0; t < 2; ++t)
#pragma unroll
                    for (int j = 0; j < 4; ++j) {
#pragma unroll
                        for (int k = 0; k < 4; ++k) rB[t][j][k] = *((const unsigned*)(DOUT + (size_t)dA[t][k] * DM) + lane + 64 * j);
                        xB[t][j] = *((const u32x2*)(XRB + (size_t)(nA + t) * DM) + lane + 64 * j); }
#pragma unroll
                for (int t = 0; t < 2; ++t)
#pragma unroll
                    for (int k = 0; k < 4; ++k) gB[t][k] = gA[t][k];
                if (nA + PSTEP < NTOK) {
#pragma unroll
                    for (int t = 0; t < 2; ++t)
#pragma unroll
                        for (int k = 0; k < 4; ++k) { dA[t][k] = DEST[(nA + PSTEP + t) * 4 + k]; gA[t][k] = GATE[(nA + PSTEP + t) * 4 + k]; } }
            }
            for (int n = nbeg + 2 * gw; n < NTOK; n += PSTEP) {
                const float* md = MODL + (size_t)modset(n) * 6144;
                f32x4 v[2][4]; float sm[2];
                {
                    f32x4 g2[4];
#pragma unroll
                    for (int j = 0; j < 4; ++j) g2[j] = *((const f32x4*)(md + 5120) + lane + 64 * j);
#pragma unroll
                    for (int t = 0; t < 2; ++t) { float s = 0.f;
#pragma unroll
                        for (int j = 0; j < 4; ++j) {
                            f32x4 f = (f32x4){0.f, 0.f, 0.f, 0.f};
#pragma unroll
                            for (int k = 0; k < 4; ++k) { const unsigned w = rB[t][j][k]; const f32x2 lo_ = __builtin_amdgcn_cvt_pk_f32_fp8((int)w, false), hi_ = __builtin_amdgcn_cvt_pk_f32_fp8((int)w, true); const float gk = gB[t][k] * (1.f / DO_Q);
                                f.x += gk * lo_.x; f.y += gk * lo_.y; f.z += gk * hi_.x; f.w += gk * hi_.y; }
                            const f32x4 xv = (f32x4){bflo(xB[t][j].x), bfhi(xB[t][j].x), bflo(xB[t][j].y), bfhi(xB[t][j].y)};
                            v[t][j] = xv * DN_ALPHA + g2[j] * f; s += (v[t][j].x + v[t][j].y) + (v[t][j].z + v[t][j].w); }
                        sm[t] = s; }
                }
                __builtin_amdgcn_sched_barrier(0);
                if (n + PSTEP < NTOK) {
#pragma unroll
                    for (int t = 0; t < 2; ++t)
#pragma unroll
                        for (int j = 0; j < 4; ++j) {
#pragma unroll
                            for (int k = 0; k < 4; ++k) rB[t][j][k] = *((const unsigned*)(DOUT + (size_t)dA[t][k] * DM) + lane + 64 * j);
                            xB[t][j] = *((const u32x2*)(XRB + (size_t)(n + PSTEP + t) * DM) + lane + 64 * j); }
#pragma unroll
                    for (int t = 0; t < 2; ++t)
#pragma unroll
                        for (int k = 0; k < 4; ++k) gB[t][k] = gA[t][k];
                    if (n + 2 * PSTEP < NTOK) {
#pragma unroll
                        for (int t = 0; t < 2; ++t)
#pragma unroll
                            for (int k = 0; k < 4; ++k) { dA[t][k] = DEST[(n + 2 * PSTEP + t) * 4 + k]; gA[t][k] = GATE[(n + 2 * PSTEP + t) * 4 + k]; } }
                }
                __builtin_amdgcn_sched_barrier(0);
                const float* mdn = MODL + 5 * 6144 + (size_t)modset(n) * 6144;
                f32x4 pg[4], pb_[4];
#pragma unroll
                for (int j = 0; j < 4; ++j) { pg[j] = *((const f32x4*)ln2g + lane + 64 * j); pb_[j] = *((const f32x4*)ln2b + lane + 64 * j); }
                float rstd[2];
                { const float mean0 = wave_sum(sm[0]) * (1.f / DM), mean1 = wave_sum(sm[1]) * (1.f / DM); float q0 = 0.f, q1 = 0.f;
#pragma unroll
                  for (int j = 0; j < 4; ++j) { v[0][j] = v[0][j] - mean0; q0 += (v[0][j].x * v[0][j].x + v[0][j].y * v[0][j].y) + (v[0][j].z * v[0][j].z + v[0][j].w * v[0][j].w);
                      v[1][j] = v[1][j] - mean1; q1 += (v[1][j].x * v[1][j].x + v[1][j].y * v[1][j].y) + (v[1][j].z * v[1][j].z + v[1][j].w * v[1][j].w); }
                  rstd[0] = rsqrtf(wave_sum(q0) * (1.f / DM) + LN_EPS); rstd[1] = rsqrtf(wave_sum(q1) * (1.f / DM) + LN_EPS); }
                __builtin_amdgcn_sched_barrier(0);
#pragma unroll
                for (int j = 0; j < 4; ++j) { __builtin_amdgcn_sched_barrier(0);
                    f32x4 psh = (f32x4){0.f, 0.f, 0.f, 0.f}, psc = psh;
                    if (!lastl) { psh = *((const f32x4*)(mdn) + lane + 64 * j); psc = *((const f32x4*)(mdn + 1024) + lane + 64 * j); }
#pragma unroll
                    for (int t = 0; t < 2; ++t) { const int nn = n + t;
                        v[t][j] = v[t][j] * rstd[t] * pg[j] + pb_[j];
                        if (lastl) *((f32x4*)(a.out + (size_t)(nn - NCTX) * DM) + lane + 64 * j) = v[t][j];
                        else { u32x2 xw_; xw_.x = pk2(v[t][j].x, v[t][j].y); xw_.y = pk2(v[t][j].z, v[t][j].w); *((u32x2*)(XRB + (size_t)nn * DM) + lane + 64 * j) = xw_;
                            const f32x4 hh = (v[t][j] * (psc + 1.f) + psh) * ACT_Q; *((unsigned*)(XHF + (size_t)nn * DM) + lane + 64 * j) = pk4_fp8(hh.x, hh.y, hh.z, hh.w); } } }
                __builtin_amdgcn_sched_barrier(0);
            }
        }
        SEAM(pb + 9);
    }
#undef IN
#undef SEAM
}

extern "C" void kernel_launch(void* const* d_in, const int* in_sizes, int n_in, void* d_out, int out_size, void* d_ws, size_t ws_size, hipStream_t stream) {
    static int grid = 0;
    if (grid == 0) {
        if (n_in != 28 || ws_size < WS_END) { fprintf(stderr, "kernel_launch: need 28 inputs and %zu bytes of workspace (got %d, %zu)\n", (size_t)WS_END, n_in, ws_size); grid = -1; return; }
        int dev = 0, cus = 0, per_cu = 0;
        if (hipGetDevice(&dev) != hipSuccess || hipDeviceGetAttribute(&cus, hipDeviceAttributeMultiprocessorCount, dev) != hipSuccess) { grid = -1; return; }
        if (hipFuncSetAttribute((const void*)mega, hipFuncAttributeMaxDynamicSharedMemorySize, LDS_BYTES) != hipSuccess) { fprintf(stderr, "kernel_launch: hipFuncSetAttribute failed\n"); grid = -1; return; }
        if (hipOccupancyMaxActiveBlocksPerMultiprocessor(&per_cu, (const void*)mega, 512, LDS_BYTES) != hipSuccess || per_cu < 1) { fprintf(stderr, "kernel_launch: occupancy query says %d\n", per_cu); }
        (void)hipGetLastError();
        grid = cus;
        if (grid > 256) grid = 256;
    }
    if (grid < 0) return;
    (void)hipMemsetAsync((char*)d_ws + WS_CTL, 0, CTL_ZERO_BYTES, stream);
    Args a{};
    for (int i = 0; i < 28; ++i) a.in[i] = (const float*)d_in[i];
    a.out = (float*)d_out; a.ws = (unsigned char*)d_ws;
    constexpr int NPH = 2 + 10 * NLAYER;
#if MK_PER_PHASE
    for (int p = 0; p < NPH; ++p) { a.ph_lo = p; a.ph_hi = p + 1; hipLaunchKernelGGL(mega, dim3(grid), dim3(512), LDS_BYTES, stream, a); }
#else
    a.ph_lo = 0; a.ph_hi = NPH;
    hipLaunchKernelGGL(mega, dim3(grid), dim3(512), LDS_BYTES, stream, a);
#endif
    const hipError_t le = hipPeekAtLastError();
    if (le != hipSuccess) fprintf(stderr, "kernel_launch: launch failed: %s\n", hipGetErrorName(le));
}
```
